# Optimizing an MI355X kernel written in HIP

```python
import jax
import jax.numpy as jnp
from jax import lax
import numpy as np

D_MODEL = 1024
BATCH = 4
SEQ = 4096
DEPTH = 2

GRID_W = 64
CTX_LEN = 256
EPS = 1e-6
ROPE_THETA = 10000.0
N_MOD = 6
GROUP_W = D_MODEL // 4
CONV_W = GROUP_W
CONV_KSIZE = 31
GLA_HEADS = GROUP_W // 64
GLA_DV = 64
GLA_DK = 32
GLA_RANK = 16
GLA_TAU = 16.0
ATT_HEADS = GROUP_W // 64
ATT_KV_HEADS = ATT_HEADS // 2
ATT_DH = 64
RET_HEADS = GROUP_W // 64
RET_DV = 64
RET_DK = 32
CHUNK = 64
Q_BLOCK = 128
D_FF = 4 * D_MODEL
IN_SPLITS = (CONV_W, CONV_W,
             GLA_HEADS * GLA_DK, GLA_HEADS * GLA_DK, GLA_HEADS * GLA_DV, GLA_HEADS * GLA_DV, GLA_RANK,
             ATT_HEADS * ATT_DH, ATT_KV_HEADS * ATT_DH, ATT_KV_HEADS * ATT_DH,
             RET_HEADS * RET_DK, RET_HEADS * RET_DK, RET_HEADS * RET_DV, RET_HEADS * RET_DV)
P_IN = sum(IN_SPLITS)
MIX_W = CONV_W + GLA_HEADS * GLA_DV + ATT_HEADS * ATT_DH + RET_HEADS * RET_DV

kernel_name = 'hybrid_parallel_groups_prefix_ctx_dit'


def rms_norm(x, g):
    xf = x.astype(jnp.float32)
    y = xf * lax.rsqrt(jnp.mean(xf * xf, axis=-1, keepdims=True) + EPS)
    return (y * g.astype(jnp.float32)).astype(x.dtype)


def layer_norm(x, g, b):
    xf = x.astype(jnp.float32)
    mu = jnp.mean(xf, axis=-1, keepdims=True)
    xc = xf - mu
    y = xc * lax.rsqrt(jnp.mean(xc * xc, axis=-1, keepdims=True) + EPS)
    return (y * g.astype(jnp.float32) + b.astype(jnp.float32)).astype(x.dtype)


def split_cols(h):
    out, start = [], 0
    for size in IN_SPLITS:
        out.append(h[..., start:start + size])
        start += size
    return out


def split_heads(t, n_heads):
    B, T, W = t.shape
    return t.reshape(B, T, n_heads, W // n_heads).transpose(0, 2, 1, 3)


def merge_heads(t):
    B, H, T, d = t.shape
    return t.transpose(0, 2, 1, 3).reshape(B, T, H * d)


def axial_rope_tables(row_ids, col_ids, head_dim):
    n_ax = head_dim // 4
    inv = ROPE_THETA ** (-jnp.arange(n_ax, dtype=jnp.float32) / n_ax)
    ang = jnp.concatenate([row_ids.astype(jnp.float32)[:, None] * inv,
                           col_ids.astype(jnp.float32)[:, None] * inv], axis=-1)
    return jnp.cos(ang), jnp.sin(ang)


def apply_rope(x, cos, sin):
    d2 = x.shape[-1] // 2
    x1, x2 = x[..., :d2], x[..., d2:]
    return jnp.concatenate([x1 * cos - x2 * sin, x2 * cos + x1 * sin], axis=-1).astype(x.dtype)


def chunked_gated_scan(q, k, v, log_a, s0):
    out_dtype = v.dtype
    B, H, T, dk = q.shape
    dv = v.shape[-1]
    n = T // CHUNK
    qc = q.astype(jnp.float32).reshape(B, H, n, CHUNK, dk)
    kc = k.astype(jnp.float32).reshape(B, H, n, CHUNK, dk)
    vc = v.astype(jnp.float32).reshape(B, H, n, CHUNK, dv)
    b = jnp.cumsum(log_a.astype(jnp.float32).reshape(B, H, n, CHUNK, dk), axis=3)
    b_last = b[:, :, :, -1:, :]
    q_dec = qc * jnp.exp(b)
    k_inv = kc * jnp.exp(-b)
    k_end = kc * jnp.exp(b_last - b)
    lower_tri = jnp.tril(jnp.ones((CHUNK, CHUNK), dtype=bool))
    scores = jnp.where(lower_tri, jnp.einsum('bhncd,bhnsd->bhncs', q_dec, k_inv), 0.0)
    o_intra = jnp.einsum('bhncs,bhnse->bhnce', scores, vc)
    kv = jnp.einsum('bhncd,bhnce->bhnde', k_end, vc)
    decay = jnp.exp(b_last[:, :, :, 0, :])

    def step(s, inp):
        qd_i, kv_i, dec_i = inp
        o_i = jnp.einsum('bhcd,bhde->bhce', qd_i, s)
        return dec_i[..., None] * s + kv_i, o_i

    xs = (jnp.moveaxis(q_dec, 2, 0), jnp.moveaxis(kv, 2, 0), jnp.moveaxis(decay, 2, 0))
    s_final, o_inter = lax.scan(step, s0, xs)
    o = o_intra + jnp.moveaxis(o_inter, 0, 2)
    return o.reshape(B, H, T, dv).astype(out_dtype), s_final


def bidirectional_scan(lat, ctx, need_ctx):
    q_l, k_l, v_l, af_l, ab_l = lat
    q_c, k_c, v_c, af_c, ab_c = ctx
    B, H, _, dk = q_l.shape
    dv = v_l.shape[-1]
    s0 = jnp.zeros((B, H, dk, dv), jnp.float32)
    flip = lambda t: jnp.flip(t, axis=2)
    o_cf, s_cf = chunked_gated_scan(q_c, k_c, v_c, af_c, s0)
    o_lf, _ = chunked_gated_scan(q_l, k_l, v_l, af_l, s_cf)
    o_cb, s_cb = chunked_gated_scan(flip(q_c), flip(k_c), flip(v_c), flip(ab_c), s0)
    o_lb, _ = chunked_gated_scan(flip(q_l), flip(k_l), flip(v_l), flip(ab_l), s_cb)
    o_l = o_lf + flip(o_lb)
    o_c = (o_cf + flip(o_cb)) if need_ctx else None
    return o_l, o_c


def conformer_conv(a, g, w_dw, b_dw, ln_g, ln_b, w_pw, b_pw):
    u = a * jax.nn.sigmoid(g)
    pad = (CONV_KSIZE - 1) // 2
    y = lax.conv_general_dilated(u, w_dw[:, None, :].astype(u.dtype), (1,), [(pad, pad)],
                                 dimension_numbers=('NWC', 'WIO', 'NWC'),
                                 feature_group_count=u.shape[-1]) + b_dw
    y = layer_norm(y, ln_g, ln_b)
    return jax.nn.silu(y) @ w_pw + b_pw


def conv_mixer(a_l, g_l, a_c, g_c, w_dw, b_dw, ln_g, ln_b, w_pw, b_pw, need_ctx):
    y_l = conformer_conv(a_l, g_l, w_dw, b_dw, ln_g, ln_b, w_pw, b_pw)
    y_c = conformer_conv(a_c, g_c, w_dw, b_dw, ln_g, ln_b, w_pw, b_pw) if need_ctx else None
    return y_l, y_c


def gla_mixer(p_l, p_c, w_a_f, b_a_f, w_a_b, b_a_b, norm_g, need_ctx):
    def prep(q, k, v, z):
        q = split_heads(q, GLA_HEADS) * GLA_DK ** -0.5
        k = split_heads(k, GLA_HEADS)
        v = split_heads(v, GLA_HEADS)
        la_f = split_heads(jax.nn.log_sigmoid(z @ w_a_f + b_a_f) / GLA_TAU, GLA_HEADS)
        la_b = split_heads(jax.nn.log_sigmoid(z @ w_a_b + b_a_b) / GLA_TAU, GLA_HEADS)
        return q, k, v, la_f, la_b

    q_l, k_l, v_l, r_l, z_l = p_l
    q_c, k_c, v_c, r_c, z_c = p_c
    o_l, o_c = bidirectional_scan(prep(q_l, k_l, v_l, z_l), prep(q_c, k_c, v_c, z_c), need_ctx)
    g = norm_g[:, None, :]
    y_l = merge_heads(rms_norm(o_l, g)) * jax.nn.silu(r_l)
    y_c = merge_heads(rms_norm(o_c, g)) * jax.nn.silu(r_c) if need_ctx else None
    return y_l, y_c


def retention_mixer(p_l, p_c, log_gamma, norm_g, cos, sin, need_ctx):
    def prep(q, k, v, rope):
        q = split_heads(q, RET_HEADS)
        k = split_heads(k, RET_HEADS) * RET_DK ** -0.5
        v = split_heads(v, RET_HEADS)
        if rope:
            q = apply_rope(q, cos, sin)
            k = apply_rope(k, cos, sin)
        la = jnp.broadcast_to(log_gamma[None, :, None, None], q.shape)
        return q, k, v, la, la

    q_l, k_l, v_l, g_l = p_l
    q_c, k_c, v_c, g_c = p_c
    o_l, o_c = bidirectional_scan(prep(q_l, k_l, v_l, True), prep(q_c, k_c, v_c, False), need_ctx)
    g = norm_g[:, None, :]
    y_l = merge_heads(rms_norm(o_l, g)) * jax.nn.silu(g_l)
    y_c = merge_heads(rms_norm(o_c, g)) * jax.nn.silu(g_c) if need_ctx else None
    return y_l, y_c


def gqa_attend(q, k, v):
    s = jnp.einsum('bkgqd,bksd->bkgqs', q, k, preferred_element_type=jnp.float32) * ATT_DH ** -0.5
    p = jax.nn.softmax(s, axis=-1).astype(v.dtype)
    return jnp.einsum('bkgqs,bksd->bkgqd', p, v)


def attention_mixer(p_l, p_c, qn_g, kn_g, cos, sin, need_ctx):
    G = ATT_HEADS // ATT_KV_HEADS

    def prep(q, k, v):
        q = rms_norm(split_heads(q, ATT_HEADS), qn_g)
        k = rms_norm(split_heads(k, ATT_KV_HEADS), kn_g)
        return q, k, split_heads(v, ATT_KV_HEADS)

    q_l, k_l, v_l = prep(*p_l)
    q_l = apply_rope(q_l, cos, sin)
    k_l = apply_rope(k_l, cos, sin)
    q_c, k_c, v_c = prep(*p_c)
    keys = jnp.concatenate([k_c, k_l], axis=2)
    vals = jnp.concatenate([v_c, v_l], axis=2)
    B, _, T, _ = q_l.shape
    nblk = T // Q_BLOCK
    qb = q_l.reshape(B, ATT_KV_HEADS, G, nblk, Q_BLOCK, ATT_DH).transpose(3, 0, 1, 2, 4, 5)
    ob = lax.map(lambda qi: gqa_attend(qi, keys, vals), qb)
    o_l = ob.transpose(1, 2, 3, 0, 4, 5).reshape(B, ATT_HEADS, T, ATT_DH)
    y_l = merge_heads(o_l)
    y_c = None
    if need_ctx:
        Tc = q_c.shape[2]
        o_c = gqa_attend(q_c.reshape(B, ATT_KV_HEADS, G, Tc, ATT_DH), k_c, v_c)
        y_c = merge_heads(o_c.reshape(B, ATT_HEADS, Tc, ATT_DH))
    return y_l, y_c


def sq_relu_mlp(h, w_up, w_down):
    return jnp.square(jax.nn.relu(h @ w_up)) @ w_down


def setup_inputs(seed: int = 0) -> dict:
    key = jax.random.key(seed)
    ks = jax.random.split(key, 32)
    nrm = lambda i, shape, scale: jax.random.normal(ks[i], shape, jnp.float32) * scale
    L = DEPTH
    return {
        'x': nrm(0, (BATCH, SEQ, D_MODEL), 1.0),
        'c': nrm(1, (BATCH, D_MODEL), 1.0),
        'ctx': nrm(2, (BATCH, CTX_LEN, D_MODEL), 1.0),
        'c_ctx': nrm(3, (D_MODEL,), 1.0),
        'w_mod': nrm(4, (L, D_MODEL, N_MOD * D_MODEL), 0.5 * D_MODEL ** -0.5),
        'b_mod': nrm(5, (L, N_MOD * D_MODEL), 0.02),
        'norm1_g': 1.0 + nrm(6, (L, D_MODEL), 0.02),
        'norm2_g': 1.0 + nrm(7, (L, D_MODEL), 0.02),
        'w_in': nrm(8, (L, D_MODEL, P_IN), D_MODEL ** -0.5),
        'conv_w_dw': nrm(9, (L, CONV_KSIZE, CONV_W), CONV_KSIZE ** -0.5),
        'conv_b_dw': nrm(10, (L, CONV_W), 0.02),
        'conv_ln_g': 1.0 + nrm(11, (L, CONV_W), 0.02),
        'conv_ln_b': nrm(12, (L, CONV_W), 0.02),
        'conv_w_pw': nrm(13, (L, CONV_W, CONV_W), CONV_W ** -0.5),
        'conv_b_pw': nrm(14, (L, CONV_W), 0.02),
        'gla_w_a_f': nrm(15, (L, GLA_RANK, GLA_HEADS * GLA_DK), GLA_RANK ** -0.5),
        'gla_b_a_f': nrm(16, (L, GLA_HEADS * GLA_DK), 0.02),
        'gla_w_a_b': nrm(17, (L, GLA_RANK, GLA_HEADS * GLA_DK), GLA_RANK ** -0.5),
        'gla_b_a_b': nrm(18, (L, GLA_HEADS * GLA_DK), 0.02),
        'gla_norm_g': 1.0 + nrm(19, (L, GLA_HEADS, GLA_DV), 0.02),
        'att_q_norm_g': 1.0 + nrm(20, (L, ATT_DH), 0.02),
        'att_k_norm_g': 1.0 + nrm(21, (L, ATT_DH), 0.02),
        'ret_norm_g': 1.0 + nrm(22, (L, RET_HEADS, RET_DV), 0.02),
        'w_out': nrm(23, (L, MIX_W, D_MODEL), MIX_W ** -0.5),
        'w_up': nrm(24, (L, D_MODEL, D_FF), D_MODEL ** -0.5),
        'w_down': nrm(25, (L, D_FF, D_MODEL), D_FF ** -0.5),
        'final_norm_g': 1.0 + nrm(26, (D_MODEL,), 0.02),
    }


def reference(x, c, ctx, c_ctx, w_mod, b_mod, norm1_g, norm2_g, w_in,
              conv_w_dw, conv_b_dw, conv_ln_g, conv_ln_b, conv_w_pw, conv_b_pw,
              gla_w_a_f, gla_b_a_f, gla_w_a_b, gla_b_a_b, gla_norm_g,
              att_q_norm_g, att_k_norm_g, ret_norm_g,
              w_out, w_up, w_down, final_norm_g):
    B, T, _ = x.shape
    rows = T // GRID_W
    row_ids = jnp.repeat(jnp.arange(rows), GRID_W)
    col_ids = jnp.tile(jnp.arange(GRID_W), rows)
    cos_att, sin_att = axial_rope_tables(row_ids, col_ids, ATT_DH)
    cos_ret, sin_ret = axial_rope_tables(row_ids, col_ids, RET_DK)
    log_gamma = jnp.log1p(-jnp.exp2(-5.0 - jnp.arange(RET_HEADS, dtype=jnp.float32)))
    silu_c = jax.nn.silu(c)
    silu_cc = jax.nn.silu(c_ctx)
    xc = ctx
    for l in range(DEPTH):
        need_ctx = l < DEPTH - 1
        mod_l = (silu_c @ w_mod[l] + b_mod[l])[:, None, :]
        mod_c = (silu_cc @ w_mod[l] + b_mod[l])[None, None, :]
        sh1_l, sc1_l, g1_l, sh2_l, sc2_l, g2_l = jnp.split(mod_l, N_MOD, axis=-1)
        sh1_c, sc1_c, g1_c, sh2_c, sc2_c, g2_c = jnp.split(mod_c, N_MOD, axis=-1)

        h_l = rms_norm(x, norm1_g[l]) * (1.0 + sc1_l) + sh1_l
        h_c = rms_norm(xc, norm1_g[l]) * (1.0 + sc1_c) + sh1_c
        pl = split_cols(h_l @ w_in[l])
        pc = split_cols(h_c @ w_in[l])
        y_conv_l, y_conv_c = conv_mixer(pl[0], pl[1], pc[0], pc[1], conv_w_dw[l], conv_b_dw[l],
                                        conv_ln_g[l], conv_ln_b[l], conv_w_pw[l], conv_b_pw[l],
                                        need_ctx)
        y_gla_l, y_gla_c = gla_mixer(pl[2:7], pc[2:7], gla_w_a_f[l], gla_b_a_f[l],
                                     gla_w_a_b[l], gla_b_a_b[l], gla_norm_g[l], need_ctx)
        y_att_l, y_att_c = attention_mixer(pl[7:10], pc[7:10], att_q_norm_g[l], att_k_norm_g[l],
                                           cos_att, sin_att, need_ctx)
        y_ret_l, y_ret_c = retention_mixer(pl[10:14], pc[10:14], log_gamma, ret_norm_g[l],
                                           cos_ret, sin_ret, need_ctx)
        o_l = jnp.concatenate([y_conv_l, y_gla_l, y_att_l, y_ret_l], axis=-1) @ w_out[l]
        x = x + g1_l * o_l
        h2_l = rms_norm(x, norm2_g[l]) * (1.0 + sc2_l) + sh2_l
        x = x + g2_l * sq_relu_mlp(h2_l, w_up[l], w_down[l])

        if need_ctx:
            o_c = jnp.concatenate([y_conv_c, y_gla_c, y_att_c, y_ret_c], axis=-1) @ w_out[l]
            xc = xc + g1_c * o_c
            h2_c = rms_norm(xc, norm2_g[l]) * (1.0 + sc2_c) + sh2_c
            xc = xc + g2_c * sq_relu_mlp(h2_c, w_up[l], w_down[l])
    return rms_norm(x, final_norm_g)
```

```cpp
#ifdef EMU
#include <cmath>
#include <cstdio>
#include <cstdlib>
#include <cstring>
#include <cstdint>
struct dim3e { unsigned x, y, z; };
static thread_local dim3e threadIdx, blockIdx, blockDim, gridDim;
#define __global__
#define __device__
#define __host__
#define __forceinline__ inline
#define __restrict__
#define __launch_bounds__(x)
typedef void* hipStream_t;
static inline float rsqrtf(float x) { return 1.0f / sqrtf(x); }
#define LAUNCH(k, n, ...) do { const long n_ = (long)(n); const int nb_ = (int)((n_ + 255) / 256); \
    _Pragma("omp parallel for schedule(dynamic, 4)") \
    for (int b_ = 0; b_ < nb_; ++b_) { blockDim.x = 256; gridDim.x = nb_; blockIdx.x = b_; for (int t_ = 0; t_ < 256; ++t_) { threadIdx.x = t_; k(__VA_ARGS__); } } } while (0)
typedef float act_t;
static inline float ldA(const act_t* p) { return *p; }
static inline void stA(act_t* p, float v) { *p = v; }
#else
#include <hip/hip_runtime.h>
#include <cstdio>
#include <cstdint>
#define LAUNCH(k, n, ...) do { const long n_ = (long)(n); const int nb_ = (int)((n_ + 255) / 256); \
    hipLaunchKernelGGL(k, dim3(nb_), dim3(256), 0, stream, __VA_ARGS__); } while (0)
typedef unsigned short act_t;
__device__ __forceinline__ float ldA(const act_t* p) { return __uint_as_float(((unsigned)*p) << 16); }
__device__ __forceinline__ void stA(act_t* p, float v) { unsigned u = __float_as_uint(v); *p = (act_t)((u + 0x7fffu + ((u >> 16) & 1u)) >> 16); }
#endif

#ifndef CFG_BATCH
#define CFG_BATCH 4
#endif
#ifndef CFG_SEQ
#define CFG_SEQ 4096
#endif
#ifndef CFG_CTX
#define CFG_CTX 256
#endif
#ifndef CFG_DFF
#define CFG_DFF 4096
#endif

constexpr int D = 1024, NB = CFG_BATCH, SEQ = CFG_SEQ, CTX = CFG_CTX, DFF = CFG_DFF, DEPTH = 2, GRIDW = 64;
constexpr int ML = NB * SEQ, MC = NB * CTX, M = ML + MC, NS = NB + 1, NMOD = 6 * D;
constexpr int PIN = 2576;
constexpr int OFF_CA = 0, OFF_CG = 256, OFF_GQ = 512, OFF_GK = 640, OFF_GV = 768, OFF_GR = 1024, OFF_Z = 1280, OFF_AQ = 1296, OFF_AK = 1552, OFF_AV = 1680,
              OFF_RQ = 1808, OFF_RK = 1936, OFF_RV = 2064, OFF_RG = 2320;
constexpr float EPS = 1e-6f;

#define GID ((long)blockIdx.x * blockDim.x + threadIdx.x)

__device__ __forceinline__ float sigmoidf_(float x) { return 1.0f / (1.0f + expf(-x)); }
__device__ __forceinline__ float siluf_(float x) { return x * sigmoidf_(x); }
__device__ __forceinline__ int row_slot(int r) { return r < ML ? r / SEQ : NB; }

__global__ void __launch_bounds__(256) k_mod(const float* c, const float* c_ctx, const float* w_mod, const float* b_mod, float* MOD) {
    const long i = GID; if (i >= (long)DEPTH * NS * NMOD) return;
    const int l = (int)(i / (NS * NMOD)), s = (int)((i / NMOD) % NS), j = (int)(i % NMOD);
    const float* v = s < NB ? c + (size_t)s * D : c_ctx;
    const float* w = w_mod + (size_t)l * D * NMOD + j;
    float acc = 0.f;
    for (int k = 0; k < D; ++k) acc += siluf_(v[k]) * w[(size_t)k * NMOD];
    MOD[i] = acc + b_mod[(size_t)l * NMOD + j];
}
__global__ void __launch_bounds__(256) k_rowss(const float* xl, const float* xc, float* SS, int nrows) {
    const long i = GID; if (i >= nrows) return;
    const float* p = i < ML ? xl + (size_t)i * D : xc + (size_t)(i - ML) * D;
    float s = 0.f;
    for (int k = 0; k < D; ++k) s += p[k] * p[k];
    SS[i] = s;
}
__global__ void __launch_bounds__(256) k_normmod(const float* xl, const float* xc, const float* SS, const float* g, const float* mod  , int i_shift, int i_scale, act_t* XN, int nrows) {
    const long i = GID; if (i >= (long)nrows * D) return;
    const int r = (int)(i / D), col = (int)(i % D);
    const float x = r < ML ? xl[(size_t)r * D + col] : xc[(size_t)(r - ML) * D + col];
    const float* m = mod + (size_t)row_slot(r) * NMOD;
    const float v = x * rsqrtf(SS[r] * (1.0f / D) + EPS) * g[col] * (1.0f + m[i_scale * D + col]) + m[i_shift * D + col];
    stA(XN + (size_t)r * D + col, v);
}
__global__ void __launch_bounds__(256) k_final(float* x, const float* SS, const float* g) {
    const long i = GID; if (i >= (long)ML * D) return;
    const int r = (int)(i / D), col = (int)(i % D);
    x[i] = x[i] * rsqrtf(SS[r] * (1.0f / D) + EPS) * g[col];
}
struct GemmArgs {
    const act_t* A; int lda; const float* W; int ldw; int K; int N; int nrows;
    act_t* C; int ldc; const float* bias;
    const float* xin_l; const float* xin_c; float* xout_l; float* xout_c; const float* gate;
};
template <int MODE> __global__ void __launch_bounds__(256) k_gemm(GemmArgs a) {
    const long i = GID; const long total = (long)(a.nrows / 8) * a.N; if (i >= total) return;
    const int rg = (int)(i / a.N), n = (int)(i % a.N), r0 = rg * 8;
    float acc[8];
#pragma unroll
    for (int j = 0; j < 8; ++j) acc[j] = 0.f;
    const act_t* Ap = a.A + (size_t)r0 * a.lda;
    const float* Wp = a.W + n;
    for (int k = 0; k < a.K; ++k) {
        const float w = Wp[(size_t)k * a.ldw];
#pragma unroll
        for (int j = 0; j < 8; ++j) acc[j] += ldA(Ap + (size_t)j * a.lda + k) * w;
    }
#pragma unroll
    for (int j = 0; j < 8; ++j) {
        const int r = r0 + j;
        if (MODE == 0) stA(a.C + (size_t)r * a.ldc + n, acc[j] + (a.bias ? a.bias[n] : 0.f));
        else if (MODE == 1) { const float v = acc[j] > 0.f ? acc[j] : 0.f; stA(a.C + (size_t)r * a.ldc + n, v * v); }
        else {
            const float gte = a.gate[(size_t)row_slot(r) * NMOD + n];
            if (r < ML) a.xout_l[(size_t)r * D + n] = a.xin_l[(size_t)r * D + n] + gte * acc[j];
            else a.xout_c[(size_t)(r - ML) * D + n] = a.xin_c[(size_t)(r - ML) * D + n] + gte * acc[j];
        }
    }
}
__global__ void __launch_bounds__(256) k_conv_dw(const act_t* P, const float* w_dw  , const float* b_dw, float* CY, int nrows) {
    const long i = GID; if (i >= (long)nrows * 256) return;
    const int r = (int)(i / 256), ch = (int)(i % 256);
    int base, t, T;
    if (r < ML) { base = (r / SEQ) * SEQ; t = r % SEQ; T = SEQ; } else { const int rc = r - ML; base = ML + (rc / CTX) * CTX; t = rc % CTX; T = CTX; }
    float acc = b_dw[ch];
    for (int j = 0; j < 31; ++j) {
        const int tt = t - 15 + j;
        if (tt >= 0 && tt < T) {
            const act_t* p = P + (size_t)(base + tt) * PIN;
            acc += ldA(p + OFF_CA + ch) * sigmoidf_(ldA(p + OFF_CG + ch)) * w_dw[j * 256 + ch];
        }
    }
    CY[i] = acc;
}
__global__ void __launch_bounds__(256) k_conv_ln(const float* CY, const float* ln_g, const float* ln_b, act_t* CZ, int nrows) {
    const long i = GID; if (i >= (long)nrows * 256) return;
    const int r = (int)(i / 256), ch = (int)(i % 256);
    const float* p = CY + (size_t)r * 256;
    float mu = 0.f; for (int k = 0; k < 256; ++k) mu += p[k]; mu *= (1.0f / 256);
    float var = 0.f; for (int k = 0; k < 256; ++k) { const float d = p[k] - mu; var += d * d; } var *= (1.0f / 256);
    const float y = (p[ch] - mu) * rsqrtf(var + EPS) * ln_g[ch] + ln_b[ch];
    stA(CZ + i, siluf_(y));
}
__global__ void __launch_bounds__(256) k_gla_gates(const act_t* P, const float* w_f, const float* b_f, const float* w_b, const float* b_b, float* LAF, float* LAB) {
    const long i = GID; if (i >= (long)M * 256) return;
    const int r = (int)(i / 256), dir = (int)((i / 128) & 1), hd = (int)(i % 128);
    const float* w = dir ? w_b : w_f; const float* b = dir ? b_b : b_f;
    float pre = b[hd];
    for (int j = 0; j < 16; ++j) pre += ldA(P + (size_t)r * PIN + OFF_Z + j) * w[j * 128 + hd];
    const float ls = fminf(pre, 0.f) - log1pf(expf(-fabsf(pre)));
    (dir ? LAB : LAF)[(size_t)r * 128 + hd] = ls * (1.0f / 16.0f);
}
__global__ void __launch_bounds__(256) k_att_prep(const act_t* P, const float* qg, const float* kg, act_t* QA, act_t* KA) {
    const long i = GID; if (i >= (long)M * 6) return;
    const int r = (int)(i / 6), slot = (int)(i % 6);
    const act_t* src = P + (size_t)r * PIN + (slot < 4 ? OFF_AQ + slot * 64 : OFF_AK + (slot - 4) * 64);
    const float* g = slot < 4 ? qg : kg;
    act_t* dst = slot < 4 ? QA + (size_t)r * 256 + slot * 64 : KA + (size_t)r * 128 + (slot - 4) * 64;
    float ss = 0.f; for (int d = 0; d < 64; ++d) { const float v = ldA(src + d); ss += v * v; }
    const float rs = rsqrtf(ss * (1.0f / 64) + EPS);
    const bool lat = r < ML; const int t = lat ? r % SEQ : 0;
    const float rid = (float)(t / GRIDW), cid = (float)(t % GRIDW);
    for (int k = 0; k < 32; ++k) {
        const float x1 = ldA(src + k) * rs * g[k], x2 = ldA(src + k + 32) * rs * g[k + 32];
        float c = 1.f, s = 0.f;
        if (lat) { const float inv = powf(10000.0f, -(float)(k & 15) / 16.0f); const float ang = (k < 16 ? rid : cid) * inv; c = cosf(ang); s = sinf(ang); }
        stA(dst + k, x1 * c - x2 * s); stA(dst + k + 32, x2 * c + x1 * s);
    }
}
__global__ void __launch_bounds__(256) k_ret_prep(const act_t* P, act_t* RQ, act_t* RK) {
    const long i = GID; if (i >= (long)M * 8) return;
    const int r = (int)(i / 8), h = (int)((i / 2) % 4), which = (int)(i & 1);
    const act_t* src = P + (size_t)r * PIN + (which ? OFF_RK : OFF_RQ) + h * 32;
    act_t* dst = (which ? RK : RQ) + (size_t)r * 128 + h * 32;
    const float sc = which ? 0.17677669529663687f : 1.0f;
    const bool lat = r < ML; const int t = lat ? r % SEQ : 0;
    const float rid = (float)(t / GRIDW), cid = (float)(t % GRIDW);
    for (int k = 0; k < 16; ++k) {
        const float x1 = ldA(src + k) * sc, x2 = ldA(src + k + 16) * sc;
        float c = 1.f, s = 0.f;
        if (lat) { const float inv = powf(10000.0f, -(float)(k & 7) / 8.0f); const float ang = (k < 8 ? rid : cid) * inv; c = cosf(ang); s = sinf(ang); }
        stA(dst + k, x1 * c - x2 * s); stA(dst + k + 16, x2 * c + x1 * s);
    }
}
__global__ void __launch_bounds__(256) k_att(const act_t* QA, const act_t* KA, const act_t* P, act_t* Y, int nrows) {
    const long i = GID; if (i >= (long)nrows * 16) return;
    const int r = (int)(i / 16), h = (int)((i / 4) % 4), dc = (int)(i % 4), kvh = h / 2;
    float q[64];
#pragma unroll
    for (int d = 0; d < 64; ++d) q[d] = ldA(QA + (size_t)r * 256 + h * 64 + d);
    float o[16];
#pragma unroll
    for (int e = 0; e < 16; ++e) o[e] = 0.f;
    float mx = -1e30f, l = 0.f;
    const bool lat = r < ML; const int b = lat ? r / SEQ : (r - ML) / CTX;
    const int nkeys = lat ? CTX + SEQ : CTX;
    for (int s = 0; s < nkeys; ++s) {
        const int kr = s < CTX ? ML + b * CTX + s : b * SEQ + (s - CTX);
        const act_t* kp = KA + (size_t)kr * 128 + kvh * 64;
        float sc = 0.f;
#pragma unroll
        for (int d = 0; d < 64; ++d) sc += q[d] * ldA(kp + d);
        sc *= 0.125f;
        const float mn = fmaxf(mx, sc), f = expf(mx - mn), p = expf(sc - mn);
        l = l * f + p; mx = mn;
        const act_t* vp = P + (size_t)kr * PIN + OFF_AV + kvh * 64 + dc * 16;
#pragma unroll
        for (int e = 0; e < 16; ++e) o[e] = o[e] * f + p * ldA(vp + e);
    }
    const float il = 1.0f / l;
#pragma unroll
    for (int e = 0; e < 16; ++e) stA(Y + (size_t)r * D + 512 + h * 64 + dc * 16 + e, o[e] * il);
}
__global__ void __launch_bounds__(256) k_scan(const act_t* P, const float* LAF, const float* LAB, const act_t* RQ, const act_t* RK, float* OG, float* OR, int dir) {
    const long i = GID; if (i >= (long)2 * NB * 4 * 64) return;
    const int e = (int)(i % 64), h = (int)((i / 64) % 4), b = (int)((i / 256) % NB), mixer = (int)(i / (256 * NB));
    float S[32];
#pragma unroll
    for (int d = 0; d < 32; ++d) S[d] = 0.f;
    const float gamma = 1.0f - exp2f(-5.0f - (float)h);
    float* O = mixer ? OR : OG;
    const float* LA = dir ? LAB : LAF;
    for (int step = 0; step < CTX + SEQ; ++step) {
        int r;
        if (step < CTX) r = ML + b * CTX + (dir ? CTX - 1 - step : step);
        else { const int t = step - CTX; r = b * SEQ + (dir ? SEQ - 1 - t : t); }
        const act_t* pr = P + (size_t)r * PIN;
        const float v = ldA(pr + (mixer ? OFF_RV : OFF_GV) + h * 64 + e);
        float o = 0.f;
#pragma unroll
        for (int d = 0; d < 32; ++d) {
            float q, k, a;
            if (mixer == 0) { q = ldA(pr + OFF_GQ + h * 32 + d) * 0.17677669529663687f; k = ldA(pr + OFF_GK + h * 32 + d); a = expf(LA[(size_t)r * 128 + h * 32 + d]); }
            else { q = ldA(RQ + (size_t)r * 128 + h * 32 + d); k = ldA(RK + (size_t)r * 128 + h * 32 + d); a = gamma; }
            S[d] = a * S[d] + k * v;
            o += q * S[d];
        }
        float* op = O + (size_t)r * 256 + h * 64 + e;
        if (dir) *op += o; else *op = o;
    }
}
__global__ void __launch_bounds__(256) k_scan_out(const float* OG, const float* OR, const act_t* P, const float* gn_gla, const float* gn_ret, act_t* Y, int nrows) {
    const long i = GID; if (i >= (long)nrows * 8) return;
    const int r = (int)(i / 8), h = (int)((i / 2) % 4), mixer = (int)(i & 1);
    const float* o = (mixer ? OR : OG) + (size_t)r * 256 + h * 64;
    const float* g = (mixer ? gn_ret : gn_gla) + h * 64;
    const act_t* gate = P + (size_t)r * PIN + (mixer ? OFF_RG : OFF_GR) + h * 64;
    float ss = 0.f; for (int e = 0; e < 64; ++e) ss += o[e] * o[e];
    const float rs = rsqrtf(ss * (1.0f / 64) + EPS);
    act_t* y = Y + (size_t)r * D + (mixer ? 768 : 256) + h * 64;
    for (int e = 0; e < 64; ++e) stA(y + e, o[e] * rs * g[e] * siluf_(ldA(gate + e)));
}

struct WsMap { size_t MOD, SS, XC, XN, Y, Pm, CY, CZ, QA, KA, LAF, LAB, RQ, RK, OR, H, END; };
static WsMap make_ws() {
    WsMap w; size_t o = 0; auto carve = [&](size_t bytes) { size_t r = o; o += (bytes + 255) & ~(size_t)255; return r; };
    w.MOD = carve((size_t)DEPTH * NS * NMOD * 4); w.SS = carve((size_t)M * 4); w.XC = carve((size_t)MC * D * 4);
    w.XN = carve((size_t)M * D * sizeof(act_t)); w.Y = carve((size_t)M * D * sizeof(act_t));
    const size_t baseC = o;
    w.Pm = carve((size_t)M * PIN * sizeof(act_t)); w.CY = carve((size_t)M * 256 * 4); w.CZ = carve((size_t)M * 256 * sizeof(act_t));
    w.QA = carve((size_t)M * 256 * sizeof(act_t)); w.KA = carve((size_t)M * 128 * sizeof(act_t));
    w.LAF = carve((size_t)M * 128 * 4); w.LAB = carve((size_t)M * 128 * 4); w.RQ = carve((size_t)M * 128 * sizeof(act_t)); w.RK = carve((size_t)M * 128 * sizeof(act_t));
    w.OR = carve((size_t)M * 256 * 4);
    const size_t endMix = o; o = baseC; w.H = carve((size_t)M * DFF * sizeof(act_t));
    w.END = o > endMix ? o : endMix; return w;
}

extern "C" void kernel_launch(void* const* d_in, const int* in_sizes, int n_in, void* d_out, int out_size, void* d_ws, size_t ws_size, hipStream_t stream) {
    static const WsMap w = make_ws();
    if (ws_size < w.END) { fprintf(stderr, "kernel_launch: workspace too small: need %zu have %zu\n", w.END, ws_size); return; }
    const float* x = (const float*)d_in[0]; const float* c = (const float*)d_in[1]; const float* ctx = (const float*)d_in[2]; const float* c_ctx = (const float*)d_in[3];
    const float* w_mod = (const float*)d_in[4]; const float* b_mod = (const float*)d_in[5]; const float* norm1_g = (const float*)d_in[6]; const float* norm2_g = (const float*)d_in[7];
    const float* w_in = (const float*)d_in[8]; const float* conv_w_dw = (const float*)d_in[9]; const float* conv_b_dw = (const float*)d_in[10]; const float* conv_ln_g = (const float*)d_in[11];
    const float* conv_ln_b = (const float*)d_in[12]; const float* conv_w_pw = (const float*)d_in[13]; const float* conv_b_pw = (const float*)d_in[14];
    const float* gla_w_a_f = (const float*)d_in[15]; const float* gla_b_a_f = (const float*)d_in[16]; const float* gla_w_a_b = (const float*)d_in[17]; const float* gla_b_a_b = (const float*)d_in[18];
    const float* gla_norm_g = (const float*)d_in[19]; const float* att_q_norm_g = (const float*)d_in[20]; const float* att_k_norm_g = (const float*)d_in[21]; const float* ret_norm_g = (const float*)d_in[22];
    const float* w_out = (const float*)d_in[23]; const float* w_up = (const float*)d_in[24]; const float* w_down = (const float*)d_in[25]; const float* final_norm_g = (const float*)d_in[26];
    char* ws = (char*)d_ws; float* out = (float*)d_out;
    float* MOD = (float*)(ws + w.MOD); float* SS = (float*)(ws + w.SS); float* XC = (float*)(ws + w.XC);
    act_t* XN = (act_t*)(ws + w.XN); act_t* Y = (act_t*)(ws + w.Y); act_t* P = (act_t*)(ws + w.Pm); float* CY = (float*)(ws + w.CY); act_t* CZ = (act_t*)(ws + w.CZ);
    act_t* QA = (act_t*)(ws + w.QA); act_t* KA = (act_t*)(ws + w.KA); float* LAF = (float*)(ws + w.LAF); float* LAB = (float*)(ws + w.LAB);
    act_t* RQ = (act_t*)(ws + w.RQ); act_t* RK = (act_t*)(ws + w.RK); float* OG = CY; float* OR = (float*)(ws + w.OR); act_t* H = (act_t*)(ws + w.H);

    LAUNCH(k_mod, (long)DEPTH * NS * NMOD, c, c_ctx, w_mod, b_mod, MOD);
    for (int l = 0; l < DEPTH; ++l) {
        const bool need_ctx = l < DEPTH - 1;
        const int nro = need_ctx ? M : ML;
        const float* xl = l == 0 ? x : out; const float* xc = l == 0 ? ctx : XC;
        const float* mod = MOD + (size_t)l * NS * NMOD;
        LAUNCH(k_rowss, M, xl, xc, SS, M);
        LAUNCH(k_normmod, (long)M * D, xl, xc, SS, norm1_g + l * D, mod, 0, 1, XN, M);
        { GemmArgs a{}; a.A = XN; a.lda = D; a.W = w_in + (size_t)l * D * PIN; a.ldw = PIN; a.K = D; a.N = PIN; a.nrows = M; a.C = P; a.ldc = PIN; a.bias = nullptr;
          LAUNCH(k_gemm<0>, (long)(M / 8) * PIN, a); }
        LAUNCH(k_conv_dw, (long)nro * 256, P, conv_w_dw + l * 31 * 256, conv_b_dw + l * 256, CY, nro);
        LAUNCH(k_conv_ln, (long)nro * 256, CY, conv_ln_g + l * 256, conv_ln_b + l * 256, CZ, nro);
        { GemmArgs a{}; a.A = CZ; a.lda = 256; a.W = conv_w_pw + (size_t)l * 256 * 256; a.ldw = 256; a.K = 256; a.N = 256; a.nrows = nro; a.C = Y; a.ldc = D; a.bias = conv_b_pw + l * 256;
          LAUNCH(k_gemm<0>, (long)(nro / 8) * 256, a); }
        LAUNCH(k_gla_gates, (long)M * 256, P, gla_w_a_f + l * 16 * 128, gla_b_a_f + l * 128, gla_w_a_b + l * 16 * 128, gla_b_a_b + l * 128, LAF, LAB);
        LAUNCH(k_att_prep, (long)M * 6, P, att_q_norm_g + l * 64, att_k_norm_g + l * 64, QA, KA);
        LAUNCH(k_ret_prep, (long)M * 8, P, RQ, RK);
        LAUNCH(k_att, (long)nro * 16, QA, KA, P, Y, nro);
        LAUNCH(k_scan, (long)2 * NB * 4 * 64, P, LAF, LAB, RQ, RK, OG, OR, 0);
        LAUNCH(k_scan, (long)2 * NB * 4 * 64, P, LAF, LAB, RQ, RK, OG, OR, 1);
        LAUNCH(k_scan_out, (long)nro * 8, OG, OR, P, gla_norm_g + l * 256, ret_norm_g + l * 256, Y, nro);
        { GemmArgs a{}; a.A = Y; a.lda = D; a.W = w_out + (size_t)l * D * D; a.ldw = D; a.K = D; a.N = D; a.nrows = nro;
          a.xin_l = xl; a.xin_c = xc; a.xout_l = out; a.xout_c = XC; a.gate = mod + 2 * D;
          LAUNCH(k_gemm<2>, (long)(nro / 8) * D, a); }
        LAUNCH(k_rowss, nro, out, XC, SS, nro);
        LAUNCH(k_normmod, (long)nro * D, out, XC, SS, norm2_g + l * D, mod, 3, 4, XN, nro);
        { GemmArgs a{}; a.A = XN; a.lda = D; a.W = w_up + (size_t)l * D * DFF; a.ldw = DFF; a.K = D; a.N = DFF; a.nrows = nro; a.C = H; a.ldc = DFF;
          LAUNCH(k_gemm<1>, (long)(nro / 8) * DFF, a); }
        { GemmArgs a{}; a.A = H; a.lda = DFF; a.W = w_down + (size_t)l * DFF * D; a.ldw = D; a.K = DFF; a.N = D; a.nrows = nro;
          a.xin_l = out; a.xin_c = XC; a.xout_l = out; a.xout_c = XC; a.gate = mod + 5 * D;
          LAUNCH(k_gemm<2>, (long)(nro / 8) * D, a); }
    }
    LAUNCH(k_rowss, ML, out, XC, SS, ML);
    LAUNCH(k_final, (long)ML * D, out, SS, final_norm_g);
}
```

```cpp
#include <hip/hip_runtime.h>
#include <hip/hip_cooperative_groups.h>
#include <cstdio>
#include <cstdint>
namespace cg = cooperative_groups;

constexpr int D = 1024, NB = 4, SEQ = 4096, CTX = 256, DFF = 4096, DEPTH = 2, GRIDW = 64;
constexpr int ML = NB * SEQ, MC = NB * CTX, M = ML + MC, NS = NB + 1, NMOD = 6 * D;
constexpr int PIN = 2576;
constexpr int PP = 2816;
constexpr int OFF_CA = 0, OFF_CG = 256, OFF_GQ = 512, OFF_GK = 640, OFF_GV = 768, OFF_GR = 1024, OFF_AQ = 1280, OFF_AK = 1536, OFF_AV = 1664,
              OFF_RQ = 1792, OFF_RK = 1920, OFF_RV = 2048, OFF_RG = 2304, OFF_Z = 2560;
constexpr float EPS = 1e-6f;
constexpr int KEYS = CTX + SEQ;
namespace pg8 {
#define PG8_LAS __attribute__((address_space(3)))
typedef unsigned short bf16_t;
typedef short bf16x8 __attribute__((ext_vector_type(8)));
typedef float f32x4 __attribute__((ext_vector_type(4)));
typedef unsigned u32x4 __attribute__((ext_vector_type(4)));
constexpr int BM = 256, BK = 64, HALF = 128, HTB = HALF * BK * 2  , STAGE_BYTES = 8 * HTB, NXCD = 8, WGM = 8;

__host__ __device__ __forceinline__ int lds_byte(int r, int c) { const int st = (r >> 4) * 2 + (c >> 5), rr = r & 15, cc = c & 31, ob = rr * 64 + cc * 2; return st * 1024 + (ob ^ (((ob >> 9) & 1) << 5)); }
__host__ __device__ __forceinline__ void stage_rc(int b, int& R, int& C) { const int st = b / 1024, sb = b % 1024, swz = sb ^ (((sb >> 9) & 1) << 5); R = (st >> 1) * 16 + swz / 64; C = (st & 1) * 32 + (swz % 64) / 2; }
__host__ __device__ __forceinline__ int perm32(int rho) { const int n = rho >> 4, i = rho & 15; return 8 * (i >> 2) + 4 * n + (i & 3); }

struct Unit { int pm, pn; };
struct Gemm { const bf16_t* A; const bf16_t* Bt; int M, N, K; };

struct StaticOrder {
    int nM, nN, nwg, G, c;
    __host__ __device__ void init(int M, int N, int G_, int c_) { nM = M / BM; nN = N / BM; nwg = nM * nN; G = G_; c = c_; }
    __host__ __device__ bool next(int i, Unit& u) const {
        const long L = (long)i * G + c; if (L >= nwg) return false;
        int wgid = (int)L; { const int q = nwg / NXCD, r = nwg % NXCD, xcd = wgid % NXCD, off = wgid / NXCD; wgid = (xcd < r ? xcd * (q + 1) : r * (q + 1) + (xcd - r) * q) + off; }
        const int nig = WGM * nN, gid = wgid / nig, fm = gid * WGM, gsz = (nM - fm) < WGM ? (nM - fm) : WGM;
        u.pm = fm + ((wgid % nig) % gsz); u.pn = (wgid % nig) / gsz; return true;
    }
    __device__ __forceinline__ void a_ready(const Unit&) const {}
    __device__ __forceinline__ void done(const Unit&) const {}
};

__device__ __forceinline__ unsigned cvt_pk_bf16(float lo, float hi) { unsigned r; asm volatile("v_cvt_pk_bf16_f32 %0, %1, %2" : "=v"(r) : "v"(lo), "v"(hi)); return r; }
typedef float f32x2 __attribute__((ext_vector_type(2)));
__device__ __forceinline__ f32x2 gelu_pk(f32x2 v) {
    const f32x2 av = __builtin_elementwise_abs(v), d = av * 0.2316418882f + 1.0f;
    f32x2 t; t.x = __builtin_amdgcn_rcpf(d.x); t.y = __builtin_amdgcn_rcpf(d.y);
    f32x2 q = t * 0.5307027145f + (-0.7265760135f); q = q * t + 0.7107068705f; q = q * t + (-0.142248368f); q = q * t + 0.127414796f; q = q * t;
    const f32x2 s = (v * v) * (-0.72134752044f);
    f32x2 e; e.x = __builtin_amdgcn_exp2f(s.x); e.y = __builtin_amdgcn_exp2f(s.y);
    const f32x2 m = v * (q * e), r = v - m;
    f32x2 o; o.x = v.x < 0.f ? m.x : r.x; o.y = v.y < 0.f ? m.y : r.y; return o;
}

template <int ACT  > struct EpiBf16 {
    static constexpr bool PERM = true, AFTER_DRAIN = false; static_assert(ACT == 0 || ACT == 1, "EpiBf16: ACT is 0 (none) or 1 (gelu_pk)");
    bf16_t* O; int ldc; const float* bias; int split_cols; size_t split_stride; float scale0;
    __device__ __forceinline__ void operator()(const f32x4 (&acc)[2][2][4][2], const Unit& u, int wr, int wc, int fr, int fq) const {
        const int row0 = u.pm * BM + wr * 64 + fr; int colt = u.pn * BM; bf16_t* base = O;
        float sc = 1.f; if (split_cols) { const int t = colt / split_cols; base += (size_t)t * split_stride; colt -= t * split_cols; if (t == 0) sc = scale0; }
        const int col0 = colt + wc * 32 + 8 * fq, bcol0 = u.pn * BM + wc * 32 + 8 * fq;
        f32x4 bv[2][2];
#pragma unroll
        for (int bj = 0; bj < 2; ++bj)
#pragma unroll
            for (int n = 0; n < 2; ++n) bv[bj][n] = bias ? *(const f32x4*)(bias + bcol0 + bj * HALF + 4 * n) : (f32x4){0.f, 0.f, 0.f, 0.f};
#pragma unroll
        for (int ai = 0; ai < 2; ++ai)
#pragma unroll
            for (int m = 0; m < 4; ++m) { bf16_t* rowp = base + (size_t)(row0 + ai * HALF + m * 16) * ldc + col0;
#pragma unroll
                for (int bj = 0; bj < 2; ++bj) { f32x4 v0 = acc[ai][bj][m][0] + bv[bj][0], v1 = acc[ai][bj][m][1] + bv[bj][1];
                    if (ACT == 1) { f32x2 a = gelu_pk((f32x2){v0[0], v0[1]}), b = gelu_pk((f32x2){v0[2], v0[3]}), c = gelu_pk((f32x2){v1[0], v1[1]}), d = gelu_pk((f32x2){v1[2], v1[3]});
                        v0 = (f32x4){a.x, a.y, b.x, b.y}; v1 = (f32x4){c.x, c.y, d.x, d.y}; }
                    v0 = v0 * sc; v1 = v1 * sc; u32x4 w; w.x = cvt_pk_bf16(v0[0], v0[1]); w.y = cvt_pk_bf16(v0[2], v0[3]); w.z = cvt_pk_bf16(v1[0], v1[1]); w.w = cvt_pk_bf16(v1[2], v1[3]);
                    *(u32x4*)(rowp + bj * HALF) = w; } }
    }
};

template <int ACT> struct EpiStore {
    static constexpr bool PERM = true, AFTER_DRAIN = false;
    bf16_t* O; int ldc;
    __device__ __forceinline__ void operator()(const f32x4 (&acc)[2][2][4][2], const Unit& u, int wr, int wc, int fr, int fq) const {
        const int row0 = u.pm * BM + wr * 64 + fr, col0 = u.pn * BM + wc * 32 + 8 * fq;
#pragma unroll
        for (int ai = 0; ai < 2; ++ai)
#pragma unroll
            for (int m = 0; m < 4; ++m) { bf16_t* rowp = O + (size_t)(row0 + ai * HALF + m * 16) * ldc + col0;
#pragma unroll
                for (int bj = 0; bj < 2; ++bj) { f32x4 v0 = acc[ai][bj][m][0], v1 = acc[ai][bj][m][1];
                    if (ACT == 2) {
#pragma unroll
                        for (int e = 0; e < 4; ++e) { const float a = v0[e] > 0.f ? v0[e] : 0.f, b = v1[e] > 0.f ? v1[e] : 0.f; v0[e] = a * a; v1[e] = b * b; } }
                    u32x4 w; w.x = cvt_pk_bf16(v0[0], v0[1]); w.y = cvt_pk_bf16(v0[2], v0[3]); w.z = cvt_pk_bf16(v1[0], v1[1]); w.w = cvt_pk_bf16(v1[2], v1[3]);
                    *(u32x4*)(rowp + bj * HALF) = w; } }
    }
};
struct EpiResid {
    static constexpr bool PERM = false, AFTER_DRAIN = false;
    const float* xin_l; const float* xin_c; float* xout_l; float* xout_c; const float* gate;
    __device__ __forceinline__ void operator()(const f32x4 (&acc)[2][2][4][2], const Unit& u, int wr, int wc, int fr, int fq) const {
        const int r0 = u.pm * BM; const bool lat = r0 < ML; const int slot = lat ? r0 / SEQ : NB;
        const float* xin = lat ? xin_l + (size_t)r0 * D : xin_c + (size_t)(r0 - ML) * D;
        float* xout = lat ? xout_l + (size_t)r0 * D : xout_c + (size_t)(r0 - ML) * D;
        const int col0 = wc * 32 + 4 * fq;
        const float* gp = gate + (size_t)slot * NMOD + u.pn * BM;
        xin += u.pn * BM; xout += u.pn * BM;
#pragma unroll
        for (int ai = 0; ai < 2; ++ai)
#pragma unroll
            for (int m = 0; m < 4; ++m) { const int off = (ai * HALF + wr * 64 + m * 16 + fr) * D + col0;
#pragma unroll
                for (int bj = 0; bj < 2; ++bj)
#pragma unroll
                    for (int n = 0; n < 2; ++n) { const f32x4 xi = *(const f32x4*)(xin + off + bj * HALF + n * 16); const f32x4 gv = *(const f32x4*)(gp + col0 + bj * HALF + n * 16);
                        *(f32x4*)(xout + off + bj * HALF + n * 16) = xi + gv * acc[ai][bj][m][n]; }
                asm volatile("" ::: "memory"); }
    }
};

template <class Epi, class Sched, bool ALIGN_EPI = false, bool SP2 = false>
__device__ __forceinline__ void gemm_phase(PG8_LAS unsigned char* lds, const Gemm g, const Sched& S, const Epi& E) {
    const int tid = threadIdx.x, wid = __builtin_amdgcn_readfirstlane(tid >> 6), lane = tid & 63, wr = wid >> 2, wc = wid & 3, fr = lane & 15, fq = lane >> 4;
    const int K = g.K, nt = K / BK;
    unsigned voffA[2], voffB[2];
#pragma unroll
    for (int i = 0; i < 2; ++i) { int R, C; stage_rc(tid * 16 + i * 8192, R, C); const int Rb = Epi::PERM ? ((R & ~31) + perm32(R & 31)) : R;
        voffA[i] = (unsigned)(R * K + C) * 2u; voffB[i] = (unsigned)(Rb * K + C) * 2u; }
    const size_t kstep = (size_t)(BK * 2);
    const size_t hstep = (size_t)HALF * K * 2;
    const size_t tstep = 2 * hstep;
    const unsigned ldsw = (unsigned)wid * 1024u;
    const int aoff = lds_byte(wr * 64 + fr, fq * 8), boff = lds_byte(wc * 32 + fr, fq * 8);
#define PG8_SA(b, h) (((b) * 2 + (h)) * HTB)
#define PG8_SB(b, h) ((4 + (b) * 2 + (h)) * HTB)
#define PG8_STAGE(bufoff, gbase, voff) do { _Pragma("unroll") for (int _i = 0; _i < 2; ++_i) \
        __builtin_amdgcn_global_load_lds((const unsigned*)((const char*)(gbase) + (voff)[_i]), (PG8_LAS unsigned*)(lds + (bufoff) + ldsw + _i * 8192), 16, 0, 0); } while (0)
#define PG8_LDA(dst, b, h) do { _Pragma("unroll") for (int m = 0; m < 4; ++m) _Pragma("unroll") for (int k = 0; k < 2; ++k) dst[m][k] = *(const PG8_LAS bf16x8*)(lds + PG8_SA(b, h) + aoff + m * 2048 + k * 1024); } while (0)
#define PG8_LDB(dst, b, h) do { _Pragma("unroll") for (int n = 0; n < 2; ++n) _Pragma("unroll") for (int k = 0; k < 2; ++k) dst[n][k] = *(const PG8_LAS bf16x8*)(lds + PG8_SB(b, h) + boff + n * 2048 + k * 1024); } while (0)
#define PG8_MMA(ai, bj, At, Bt) do { __builtin_amdgcn_s_setprio(1); _Pragma("unroll") for (int m = 0; m < 4; ++m) _Pragma("unroll") for (int n = 0; n < 2; ++n) _Pragma("unroll") for (int k = 0; k < 2; ++k) \
        acc[ai][bj][m][n] = __builtin_amdgcn_mfma_f32_16x16x32_bf16(Bt[n][k], At[m][k], acc[ai][bj][m][n], 0, 0, 0); __builtin_amdgcn_s_setprio(0); } while (0)
#define PG8_WAIT_V(n) asm volatile("s_waitcnt vmcnt(" #n ")" ::: "memory")
#define PG8_WAIT_L(n) asm volatile("s_waitcnt lgkmcnt(" #n ")" ::: "memory")
#define PG8_BAR __builtin_amdgcn_s_barrier()
#define PG8_SCHED __builtin_amdgcn_sched_barrier(0)
    Unit cur, nxt; int ui = 0;
    if (!S.next(0, cur)) return;
    f32x4 acc[2][2][4][2];
#pragma unroll
    for (int a = 0; a < 2; ++a)
#pragma unroll
        for (int b = 0; b < 2; ++b)
#pragma unroll
            for (int m = 0; m < 4; ++m)
#pragma unroll
                for (int n = 0; n < 2; ++n) acc[a][b][m][n] = (f32x4){0.f, 0.f, 0.f, 0.f};
    bf16x8 At[4][2], B0[2][2], B1[2][2];
    const char* cA = (const char*)g.A + (size_t)cur.pm * tstep; const char* cB = (const char*)g.Bt + (size_t)cur.pn * tstep;
    S.a_ready(cur);
    if constexpr (SP2) {
        PG8_STAGE(PG8_SB(0, 0), cB, voffB); PG8_STAGE(PG8_SB(0, 1), cB + hstep, voffB); PG8_STAGE(PG8_SA(0, 0), cA, voffA); PG8_STAGE(PG8_SA(0, 1), cA + hstep, voffA);
        if (wr == 1) PG8_BAR;
        PG8_WAIT_V(2); PG8_BAR;
        PG8_STAGE(PG8_SB(1, 0), cB + kstep, voffB); PG8_STAGE(PG8_SA(1, 0), cA + kstep, voffA); PG8_STAGE(PG8_SB(1, 1), cB + hstep + kstep, voffB);
        PG8_WAIT_V(6); PG8_BAR;
    } else {
        PG8_STAGE(PG8_SB(0, 0), cB, voffB); PG8_STAGE(PG8_SA(0, 0), cA, voffA); PG8_STAGE(PG8_SB(0, 1), cB + hstep, voffB); PG8_STAGE(PG8_SA(0, 1), cA + hstep, voffA);
        if (wr == 1) PG8_BAR;
        PG8_WAIT_V(4); PG8_BAR;
        PG8_STAGE(PG8_SB(1, 0), cB + kstep, voffB); PG8_STAGE(PG8_SA(1, 0), cA + kstep, voffA); PG8_STAGE(PG8_SB(1, 1), cB + hstep + kstep, voffB);
        PG8_WAIT_V(6); PG8_BAR;
    }
    for (;;) {
        const bool has_next = S.next(ui + 1, nxt);
        const char* nA = has_next ? (const char*)g.A + (size_t)nxt.pm * tstep : cA; const char* nB = has_next ? (const char*)g.Bt + (size_t)nxt.pn * tstep : cB;
        for (int t = 0; t < nt; t += 2) {
            const bool last = (t == nt - 2);
            const char* a1 = cA + (size_t)(t + 1) * kstep;
            const char* a2 = last ? nA : cA + (size_t)(t + 2) * kstep; const char* b2 = last ? nB : cB + (size_t)(t + 2) * kstep;
            const char* a3 = a2 + kstep; const char* b3 = b2 + kstep;
            if (last && has_next) S.a_ready(nxt);
            if constexpr (SP2) {
            PG8_LDB(B0, 0, 0); PG8_LDB(B1, 0, 1); PG8_SCHED; PG8_LDA(At, 0, 0); PG8_STAGE(PG8_SA(1, 1), a1 + hstep, voffA);
            PG8_WAIT_V(8); PG8_WAIT_L(0); PG8_BAR; PG8_MMA(0, 0, At, B0); PG8_MMA(0, 1, At, B1); PG8_BAR; PG8_SCHED;
            PG8_LDA(At, 0, 1); PG8_STAGE(PG8_SB(0, 0), b2, voffB); PG8_STAGE(PG8_SB(0, 1), b2 + hstep, voffB); PG8_STAGE(PG8_SA(0, 0), a2, voffA);
            PG8_WAIT_V(8); PG8_WAIT_L(0); PG8_BAR; PG8_MMA(1, 0, At, B0); PG8_MMA(1, 1, At, B1); PG8_BAR; PG8_SCHED;
            PG8_LDB(B0, 1, 0); PG8_LDB(B1, 1, 1); PG8_SCHED; PG8_LDA(At, 1, 0); PG8_STAGE(PG8_SA(0, 1), a2 + hstep, voffA);
            PG8_WAIT_V(8); PG8_WAIT_L(0); PG8_BAR; PG8_MMA(0, 0, At, B0); PG8_MMA(0, 1, At, B1); PG8_BAR; PG8_SCHED;
            PG8_LDA(At, 1, 1); PG8_STAGE(PG8_SB(1, 0), b3, voffB); PG8_STAGE(PG8_SB(1, 1), b3 + hstep, voffB); PG8_STAGE(PG8_SA(1, 0), a3, voffA);
            PG8_WAIT_V(8); PG8_WAIT_L(0); PG8_BAR; PG8_MMA(1, 0, At, B0); PG8_MMA(1, 1, At, B1); PG8_BAR; PG8_SCHED;
            } else {
            PG8_LDB(B0, 0, 0); PG8_SCHED; PG8_LDA(At, 0, 0); PG8_STAGE(PG8_SA(1, 1), a1 + hstep, voffA);
            PG8_WAIT_L(8); PG8_BAR; PG8_WAIT_L(0); PG8_MMA(0, 0, At, B0); PG8_BAR; PG8_SCHED;
            PG8_LDB(B1, 0, 1); PG8_STAGE(PG8_SB(0, 0), b2, voffB);
            PG8_BAR; PG8_WAIT_L(0); PG8_MMA(0, 1, At, B1); PG8_BAR;
            PG8_LDA(At, 0, 1); PG8_STAGE(PG8_SA(0, 0), a2, voffA);
            PG8_BAR; PG8_WAIT_L(0); PG8_MMA(1, 0, At, B0); PG8_BAR; PG8_SCHED;
            PG8_STAGE(PG8_SB(0, 1), b2 + hstep, voffB);
            PG8_WAIT_V(6); PG8_BAR; PG8_MMA(1, 1, At, B1); PG8_BAR;
            PG8_LDB(B0, 1, 0); PG8_SCHED; PG8_LDA(At, 1, 0); PG8_STAGE(PG8_SA(0, 1), a2 + hstep, voffA);
            PG8_WAIT_L(8); PG8_BAR; PG8_WAIT_L(0); PG8_MMA(0, 0, At, B0); PG8_BAR; PG8_SCHED;
            PG8_LDB(B1, 1, 1); PG8_STAGE(PG8_SB(1, 0), b3, voffB);
            PG8_BAR; PG8_WAIT_L(0); PG8_MMA(0, 1, At, B1); PG8_BAR;
            PG8_LDA(At, 1, 1); PG8_STAGE(PG8_SA(1, 0), a3, voffA);
            PG8_BAR; PG8_WAIT_L(0); PG8_MMA(1, 0, At, B0); PG8_BAR; PG8_SCHED;
            PG8_STAGE(PG8_SB(1, 1), b3 + hstep, voffB);
            PG8_WAIT_V(6); PG8_BAR; PG8_MMA(1, 1, At, B1); PG8_BAR;
            }
        }
        if constexpr (ALIGN_EPI) { if (wr == 0) PG8_BAR; }
        if constexpr (!Epi::AFTER_DRAIN) { E(acc, cur, wr, wc, fr, fq); S.done(cur); }
        if (!has_next) break;
#pragma unroll
        for (int a = 0; a < 2; ++a)
#pragma unroll
            for (int b = 0; b < 2; ++b)
#pragma unroll
                for (int m = 0; m < 4; ++m)
#pragma unroll
                    for (int n = 0; n < 2; ++n) acc[a][b][m][n] = (f32x4){0.f, 0.f, 0.f, 0.f};
        cur = nxt; cA = nA; cB = nB; ++ui;
        if constexpr (ALIGN_EPI) { if (wr == 1) PG8_BAR; }
    }
    PG8_WAIT_V(0);
    if constexpr (!ALIGN_EPI) { if (wr == 0) PG8_BAR; }
    PG8_BAR;
    if constexpr (Epi::AFTER_DRAIN) { E.fused(acc, cur, wr, wc, fr, fq, lds, wid, lane); S.done(cur); }
#undef PG8_SA
#undef PG8_SB
#undef PG8_STAGE
#undef PG8_LDA
#undef PG8_LDB
#undef PG8_MMA
#undef PG8_WAIT_V
#undef PG8_WAIT_L
#undef PG8_BAR
#undef PG8_SCHED
}
}
#define GAS __attribute__((address_space(1)))
#define LAS __attribute__((address_space(3)))
typedef unsigned short bf16;
typedef unsigned v4u __attribute__((ext_vector_type(4)));
typedef unsigned v2u __attribute__((ext_vector_type(2)));
typedef float f32x4 __attribute__((ext_vector_type(4)));
typedef short bf16x8 __attribute__((ext_vector_type(8)));
constexpr int NWAVES = 8, NTHREADS = 512;
constexpr int RING_BYTES = 131072, LDS_BYTES = 147456;
#define LDS_WAIT() asm volatile("s_waitcnt lgkmcnt(0)" ::: "memory")
#define VM_WAIT() asm volatile("s_waitcnt vmcnt(0)" ::: "memory")
__device__ __forceinline__ unsigned f2bf(float f) { unsigned u = __builtin_bit_cast(unsigned, f); return (u + 0x7fffu + ((u >> 16) & 1u)) >> 16; }
__device__ __forceinline__ unsigned pk2(float lo, float hi) { return f2bf(lo) | (f2bf(hi) << 16); }
__device__ __forceinline__ float bf2f(unsigned short b) { return __builtin_bit_cast(float, ((unsigned)b) << 16); }
__device__ __forceinline__ float sigmoidf_(float x) { return 1.0f / (1.0f + __expf(-x)); }
__device__ __forceinline__ float siluf_(float x) { return x * sigmoidf_(x); }
__device__ __forceinline__ float wave_sum(float v) {
#pragma unroll
    for (int o = 1; o < 64; o <<= 1) v += __shfl_xor(v, o);
    return v;
}

constexpr size_t MiB = 1u << 20;
constexpr size_t WS_CTL = 0, WS_MOD = 1 * MiB;
constexpr size_t WS_WIN = 2 * MiB, WIN_BYTES = (size_t)PP * D * 2;
constexpr size_t WS_WOUT = WS_WIN + 2 * WIN_BYTES, WOUT_BYTES = (size_t)D * D * 2;
constexpr size_t WS_WUP = WS_WOUT + 2 * WOUT_BYTES, WUP_BYTES = (size_t)DFF * D * 2;
constexpr size_t WS_WDN = WS_WUP + 2 * WUP_BYTES, WDN_BYTES = (size_t)D * DFF * 2;
constexpr size_t WS_WPW = WS_WDN + 2 * WDN_BYTES, WPW_BYTES = (size_t)256 * 256 * 2;
static_assert(WS_WPW + 2 * WPW_BYTES <= 50 * MiB, "weights");
constexpr size_t WS_XC = 50 * MiB;
constexpr size_t WS_ACT = 54 * MiB;
constexpr size_t WS_P = 88 * MiB;
constexpr size_t WS_H = 88 * MiB;
constexpr size_t WS_QA = 182 * MiB;
constexpr size_t WS_KA = 191 * MiB, WS_VA = 196 * MiB;
constexpr size_t WS_KV = 201 * MiB;
constexpr size_t WS_DEC = 235 * MiB;
constexpr size_t WS_END = 256 * MiB;
static_assert(WS_P + (size_t)M * PP * 2 <= WS_QA && WS_H + (size_t)M * DFF * 2 <= WS_END && WS_ACT + (size_t)M * D * 2 <= WS_P, "ws map");

struct Args { const float* in[27]; float* out; unsigned char* ws; int ph_lo, ph_hi, layer, pad; };

template <class Map> __device__ __forceinline__ void transpose_item(const float* W, int K, int N, bf16* WT, LAS float* scr, int kb, int nb, int lane, Map srcc) {
    const int k0 = 64 * kb, n0 = 32 * nb; const int sc = srcc(n0 + (lane & 31));
#pragma unroll 8
    for (int i = 0; i < 32; ++i) { const int kk = 2 * i + (lane >> 5); scr[kk * 33 + (lane & 31)] = sc >= 0 ? W[(size_t)(k0 + kk) * N + sc] : 0.f; }
    LDS_WAIT(); asm volatile("" ::: "memory");
    const int c = lane & 7;
#pragma unroll
    for (int j = 0; j < 4; ++j) { const int n = (lane >> 3) + 8 * j; const LAS float* s = scr + (8 * c) * 33 + n;
        v4u o; o.x = pk2(s[0 * 33], s[1 * 33]); o.y = pk2(s[2 * 33], s[3 * 33]); o.z = pk2(s[4 * 33], s[5 * 33]); o.w = pk2(s[6 * 33], s[7 * 33]);
        *(GAS v4u*)(WT + (size_t)(n0 + n) * K + k0 + 8 * c) = o; }
    LDS_WAIT(); asm volatile("" ::: "memory");
}
struct MapId { __device__ __forceinline__ int operator()(int n) const { return n; } };
struct MapWin { __device__ __forceinline__ int operator()(int n) const { return n < 1280 ? n : (n < 2560 ? n + 16 : (n < 2576 ? n - 1280 : -1)); } };

__device__ __forceinline__ void ph_prologue(const Args& a, LAS unsigned char* lds, int tid, int lane, int wave, int bid, int G) {
    unsigned char* ws = a.ws;
    LAS float* scr = (LAS float*)(lds + wave * 16384);
    const int gw = bid * NWAVES + wave, NGW = G * NWAVES;
    constexpr int I_IN = (D / 64) * (PP / 32), I_OUT = (D / 64) * (D / 32), I_UP = (D / 64) * (DFF / 32), I_DN = (DFF / 64) * (D / 32), I_PW = (256 / 64) * (256 / 32);
    constexpr int I_L = I_IN + I_OUT + I_UP + I_DN + I_PW;
    for (int it = gw; it < DEPTH * I_L; it += NGW) {
        const int l = it / I_L; int r = it % I_L;
        if (r < I_IN) { transpose_item(a.in[8] + (size_t)l * D * PIN, D, PIN, (bf16*)(ws + WS_WIN + l * WIN_BYTES), scr, r / (PP / 32), r % (PP / 32), lane, MapWin()); continue; } r -= I_IN;
        if (r < I_OUT) { transpose_item(a.in[23] + (size_t)l * D * D, D, D, (bf16*)(ws + WS_WOUT + l * WOUT_BYTES), scr, r / (D / 32), r % (D / 32), lane, MapId()); continue; } r -= I_OUT;
        if (r < I_UP) { transpose_item(a.in[24] + (size_t)l * D * DFF, D, DFF, (bf16*)(ws + WS_WUP + l * WUP_BYTES), scr, r / (DFF / 32), r % (DFF / 32), lane, MapId()); continue; } r -= I_UP;
        if (r < I_DN) { transpose_item(a.in[25] + (size_t)l * DFF * D, DFF, D, (bf16*)(ws + WS_WDN + l * WDN_BYTES), scr, r / (D / 32), r % (D / 32), lane, MapId()); continue; } r -= I_DN;
        transpose_item(a.in[13] + (size_t)l * 256 * 256, 256, 256, (bf16*)(ws + WS_WPW + l * WPW_BYTES), scr, r / 8, r % 8, lane, MapId());
    }
    __syncthreads();
    LAS float* sil = (LAS float*)lds;
    LAS float* part = (LAS float*)(lds + NS * D * 4);
    float* MOD = (float*)(ws + WS_MOD);
    const float* c = a.in[1]; const float* cc = a.in[3]; const float* w_mod = a.in[4]; const float* b_mod = a.in[5];
    bool staged = false;
    for (int task = bid; task < DEPTH * (NMOD / 64); task += G) {
        if (!staged) { for (int i = tid; i < NS * D; i += NTHREADS) { const int s = i / D, k = i % D; const float v = s < NB ? c[s * D + k] : cc[k]; sil[i] = siluf_(v); } staged = true; __syncthreads(); }
        const int l = task / (NMOD / 64), c0 = (task % (NMOD / 64)) * 64;
        float acc[NS];
#pragma unroll
        for (int s = 0; s < NS; ++s) acc[s] = 0.f;
        const float* wp = w_mod + (size_t)l * D * NMOD + (size_t)(wave * 128) * NMOD + c0 + lane;
#pragma unroll 4
        for (int k = 0; k < 128; ++k) { const float wv = wp[(size_t)k * NMOD];
#pragma unroll
            for (int s = 0; s < NS; ++s) acc[s] += sil[s * D + wave * 128 + k] * wv; }
#pragma unroll
        for (int s = 0; s < NS; ++s) part[(wave * NS + s) * 64 + lane] = acc[s];
        __syncthreads();
        if (tid < NS * 64) { const int s = tid / 64, ln = tid % 64; float v = 0.f;
#pragma unroll
            for (int w = 0; w < 8; ++w) v += part[(w * NS + s) * 64 + ln];
            MOD[((size_t)l * NS + s) * NMOD + c0 + ln] = v + b_mod[(size_t)l * NMOD + c0 + ln]; }
        __syncthreads();
    }
}
__device__ __forceinline__ void ph_normmod(const float* xl, const float* xc, const float* g, const float* mod, int i_shift, int i_scale, bf16* XN, int nrows, int lane, int gw, int NGW) {
    for (int r = gw; r < nrows; r += NGW) {
        const float* xr = r < ML ? xl + (size_t)r * D : xc + (size_t)(r - ML) * D;
        const float* m = mod + (size_t)(r < ML ? r / SEQ : NB) * NMOD;
        f32x4 v[4]; float s = 0.f;
#pragma unroll
        for (int j = 0; j < 4; ++j) { v[j] = *(const f32x4*)(xr + 4 * lane + 256 * j); s += (v[j].x * v[j].x + v[j].y * v[j].y) + (v[j].z * v[j].z + v[j].w * v[j].w); }
        const float rs = 1.0f / sqrtf(wave_sum(s) * (1.0f / D) + EPS);
#pragma unroll
        for (int j = 0; j < 4; ++j) { const int c0 = 4 * lane + 256 * j;
            const f32x4 gg = *(const f32x4*)(g + c0), sc = *(const f32x4*)(m + i_scale * D + c0), sh = *(const f32x4*)(m + i_shift * D + c0);
            const f32x4 o = v[j] * rs * gg * (sc + 1.0f) + sh;
            v2u w; w.x = pk2(o.x, o.y); w.y = pk2(o.z, o.w); *(v2u*)(XN + (size_t)r * D + c0) = w; }
    }
}
__device__ __forceinline__ void ph_final(float* x, const float* g, int lane, int gw, int NGW) {
    for (int r = gw; r < ML; r += NGW) {
        float* xr = x + (size_t)r * D;
        f32x4 v[4]; float s = 0.f;
#pragma unroll
        for (int j = 0; j < 4; ++j) { v[j] = *(const f32x4*)(xr + 4 * lane + 256 * j); s += (v[j].x * v[j].x + v[j].y * v[j].y) + (v[j].z * v[j].z + v[j].w * v[j].w); }
        const float rs = 1.0f / sqrtf(wave_sum(s) * (1.0f / D) + EPS);
#pragma unroll
        for (int j = 0; j < 4; ++j) { const int c0 = 4 * lane + 256 * j; *(f32x4*)(xr + c0) = v[j] * rs * *(const f32x4*)(g + c0); }
    }
}
typedef unsigned short act_t;
__device__ __forceinline__ float ldA(const act_t* p) { return __uint_as_float(((unsigned)*p) << 16); }
__device__ __forceinline__ void stA(act_t* p, float v) { *p = (act_t)f2bf(v); }
#define LAUNCH(k, n, ...) do { const long n_ = (long)(n); const int nb_ = (int)((n_ + 255) / 256); hipLaunchKernelGGL(k, dim3(nb_), dim3(256), 0, stream, __VA_ARGS__); } while (0)
#define GID ((long)blockIdx.x * blockDim.x + threadIdx.x)

__device__ __forceinline__ int row_slot(int r) { return r < ML ? r / SEQ : NB; }

struct GemmArgs {
    const act_t* A; int lda; const float* W; int ldw; int K; int N; int nrows;
    act_t* C; int ldc; const float* bias;
    const float* xin_l; const float* xin_c; float* xout_l; float* xout_c; const float* gate;
};
template <int MODE> __global__ void __launch_bounds__(256) k_gemm(GemmArgs a) {
    const long i = GID; const long total = (long)(a.nrows / 8) * a.N; if (i >= total) return;
    const int rg = (int)(i / a.N), n = (int)(i % a.N), r0 = rg * 8;
    float acc[8];
#pragma unroll
    for (int j = 0; j < 8; ++j) acc[j] = 0.f;
    const act_t* Ap = a.A + (size_t)r0 * a.lda;
    const float* Wp = a.W + n;
    for (int k = 0; k < a.K; ++k) {
        const float w = Wp[(size_t)k * a.ldw];
#pragma unroll
        for (int j = 0; j < 8; ++j) acc[j] += ldA(Ap + (size_t)j * a.lda + k) * w;
    }
#pragma unroll
    for (int j = 0; j < 8; ++j) {
        const int r = r0 + j;
        if (MODE == 0) stA(a.C + (size_t)r * a.ldc + n, acc[j] + (a.bias ? a.bias[n] : 0.f));
        else if (MODE == 1) { const float v = acc[j] > 0.f ? acc[j] : 0.f; stA(a.C + (size_t)r * a.ldc + n, v * v); }
        else {
            const float gte = a.gate[(size_t)row_slot(r) * NMOD + n];
            if (r < ML) a.xout_l[(size_t)r * D + n] = a.xin_l[(size_t)r * D + n] + gte * acc[j];
            else a.xout_c[(size_t)(r - ML) * D + n] = a.xin_c[(size_t)(r - ML) * D + n] + gte * acc[j];
        }
    }
}
__global__ void __launch_bounds__(256) k_conv_dw(const act_t* P, const float* w_dw  , const float* b_dw, float* CY, int nrows) {
    const long i = GID; if (i >= (long)nrows * 256) return;
    const int r = (int)(i / 256), ch = (int)(i % 256);
    int base, t, T;
    if (r < ML) { base = (r / SEQ) * SEQ; t = r % SEQ; T = SEQ; } else { const int rc = r - ML; base = ML + (rc / CTX) * CTX; t = rc % CTX; T = CTX; }
    float acc = b_dw[ch];
    for (int j = 0; j < 31; ++j) {
        const int tt = t - 15 + j;
        if (tt >= 0 && tt < T) {
            const act_t* p = P + (size_t)(base + tt) * PP;
            acc += ldA(p + OFF_CA + ch) * sigmoidf_(ldA(p + OFF_CG + ch)) * w_dw[j * 256 + ch];
        }
    }
    CY[i] = acc;
}
__global__ void __launch_bounds__(256) k_conv_ln(const float* CY, const float* ln_g, const float* ln_b, act_t* CZ, int nrows) {
    const long i = GID; if (i >= (long)nrows * 256) return;
    const int r = (int)(i / 256), ch = (int)(i % 256);
    const float* p = CY + (size_t)r * 256;
    float mu = 0.f; for (int k = 0; k < 256; ++k) mu += p[k]; mu *= (1.0f / 256);
    float var = 0.f; for (int k = 0; k < 256; ++k) { const float d = p[k] - mu; var += d * d; } var *= (1.0f / 256);
    const float y = (p[ch] - mu) * rsqrtf(var + EPS) * ln_g[ch] + ln_b[ch];
    stA(CZ + i, siluf_(y));
}
__global__ void __launch_bounds__(256) k_gla_gates(const act_t* P, const float* w_f, const float* b_f, const float* w_b, const float* b_b, float* LAF, float* LAB) {
    const long i = GID; if (i >= (long)M * 256) return;
    const int r = (int)(i / 256), dir = (int)((i / 128) & 1), hd = (int)(i % 128);
    const float* w = dir ? w_b : w_f; const float* b = dir ? b_b : b_f;
    float pre = b[hd];
    for (int j = 0; j < 16; ++j) pre += ldA(P + (size_t)r * PP + OFF_Z + j) * w[j * 128 + hd];
    const float ls = fminf(pre, 0.f) - log1pf(expf(-fabsf(pre)));
    (dir ? LAB : LAF)[(size_t)r * 128 + hd] = ls * (1.0f / 16.0f);
}
__global__ void __launch_bounds__(256) k_att_prep(const act_t* P, const float* qg, const float* kg, act_t* QA, act_t* KA) {
    const long i = GID; if (i >= (long)M * 6) return;
    const int r = (int)(i / 6), slot = (int)(i % 6);
    const act_t* src = P + (size_t)r * PP + (slot < 4 ? OFF_AQ + slot * 64 : OFF_AK + (slot - 4) * 64);
    const float* g = slot < 4 ? qg : kg;
    act_t* dst = slot < 4 ? QA + (size_t)r * 256 + slot * 64 : KA + (size_t)r * 128 + (slot - 4) * 64;
    float ss = 0.f; for (int d = 0; d < 64; ++d) { const float v = ldA(src + d); ss += v * v; }
    const float rs = rsqrtf(ss * (1.0f / 64) + EPS);
    const bool lat = r < ML; const int t = lat ? r % SEQ : 0;
    const float rid = (float)(t / GRIDW), cid = (float)(t % GRIDW);
    for (int k = 0; k < 32; ++k) {
        const float x1 = ldA(src + k) * rs * g[k], x2 = ldA(src + k + 32) * rs * g[k + 32];
        float c = 1.f, s = 0.f;
        if (lat) { const float inv = powf(10000.0f, -(float)(k & 15) / 16.0f); const float ang = (k < 16 ? rid : cid) * inv; c = cosf(ang); s = sinf(ang); }
        stA(dst + k, x1 * c - x2 * s); stA(dst + k + 32, x2 * c + x1 * s);
    }
}
__global__ void __launch_bounds__(256) k_ret_prep(const act_t* P, act_t* RQ, act_t* RK) {
    const long i = GID; if (i >= (long)M * 8) return;
    const int r = (int)(i / 8), h = (int)((i / 2) % 4), which = (int)(i & 1);
    const act_t* src = P + (size_t)r * PP + (which ? OFF_RK : OFF_RQ) + h * 32;
    act_t* dst = (which ? RK : RQ) + (size_t)r * 128 + h * 32;
    const float sc = which ? 0.17677669529663687f : 1.0f;
    const bool lat = r < ML; const int t = lat ? r % SEQ : 0;
    const float rid = (float)(t / GRIDW), cid = (float)(t % GRIDW);
    for (int k = 0; k < 16; ++k) {
        const float x1 = ldA(src + k) * sc, x2 = ldA(src + k + 16) * sc;
        float c = 1.f, s = 0.f;
        if (lat) { const float inv = powf(10000.0f, -(float)(k & 7) / 8.0f); const float ang = (k < 8 ? rid : cid) * inv; c = cosf(ang); s = sinf(ang); }
        stA(dst + k, x1 * c - x2 * s); stA(dst + k + 16, x2 * c + x1 * s);
    }
}
__global__ void __launch_bounds__(256) k_att(const act_t* QA, const act_t* KA, const act_t* P, act_t* Y, int nrows) {
    const long i = GID; if (i >= (long)nrows * 16) return;
    const int r = (int)(i / 16), h = (int)((i / 4) % 4), dc = (int)(i % 4), kvh = h / 2;
    float q[64];
#pragma unroll
    for (int d = 0; d < 64; ++d) q[d] = ldA(QA + (size_t)r * 256 + h * 64 + d);
    float o[16];
#pragma unroll
    for (int e = 0; e < 16; ++e) o[e] = 0.f;
    float mx = -1e30f, l = 0.f;
    const bool lat = r < ML; const int b = lat ? r / SEQ : (r - ML) / CTX;
    const int nkeys = lat ? CTX + SEQ : CTX;
    for (int s = 0; s < nkeys; ++s) {
        const int kr = s < CTX ? ML + b * CTX + s : b * SEQ + (s - CTX);
        const act_t* kp = KA + (size_t)kr * 128 + kvh * 64;
        float sc = 0.f;
#pragma unroll
        for (int d = 0; d < 64; ++d) sc += q[d] * ldA(kp + d);
        sc *= 0.125f;
        const float mn = fmaxf(mx, sc), f = expf(mx - mn), p = expf(sc - mn);
        l = l * f + p; mx = mn;
        const act_t* vp = P + (size_t)kr * PP + OFF_AV + kvh * 64 + dc * 16;
#pragma unroll
        for (int e = 0; e < 16; ++e) o[e] = o[e] * f + p * ldA(vp + e);
    }
    const float il = 1.0f / l;
#pragma unroll
    for (int e = 0; e < 16; ++e) stA(Y + (size_t)r * D + 512 + h * 64 + dc * 16 + e, o[e] * il);
}
__global__ void __launch_bounds__(256) k_scan(const act_t* P, const float* LAF, const float* LAB, const act_t* RQ, const act_t* RK, float* OG, float* OR, int dir) {
    const long i = GID; if (i >= (long)2 * NB * 4 * 64) return;
    const int e = (int)(i % 64), h = (int)((i / 64) % 4), b = (int)((i / 256) % NB), mixer = (int)(i / (256 * NB));
    float S[32];
#pragma unroll
    for (int d = 0; d < 32; ++d) S[d] = 0.f;
    const float gamma = 1.0f - exp2f(-5.0f - (float)h);
    float* O = mixer ? OR : OG;
    const float* LA = dir ? LAB : LAF;
    for (int step = 0; step < CTX + SEQ; ++step) {
        int r;
        if (step < CTX) r = ML + b * CTX + (dir ? CTX - 1 - step : step);
        else { const int t = step - CTX; r = b * SEQ + (dir ? SEQ - 1 - t : t); }
        const act_t* pr = P + (size_t)r * PP;
        const float v = ldA(pr + (mixer ? OFF_RV : OFF_GV) + h * 64 + e);
        float o = 0.f;
#pragma unroll
        for (int d = 0; d < 32; ++d) {
            float q, k, a;
            if (mixer == 0) { q = ldA(pr + OFF_GQ + h * 32 + d) * 0.17677669529663687f; k = ldA(pr + OFF_GK + h * 32 + d); a = expf(LA[(size_t)r * 128 + h * 32 + d]); }
            else { q = ldA(RQ + (size_t)r * 128 + h * 32 + d); k = ldA(RK + (size_t)r * 128 + h * 32 + d); a = gamma; }
            S[d] = a * S[d] + k * v;
            o += q * S[d];
        }
        float* op = O + (size_t)r * 256 + h * 64 + e;
        if (dir) *op += o; else *op = o;
    }
}
__global__ void __launch_bounds__(256) k_scan_out(const float* OG, const float* OR, const act_t* P, const float* gn_gla, const float* gn_ret, act_t* Y, int nrows) {
    const long i = GID; if (i >= (long)nrows * 8) return;
    const int r = (int)(i / 8), h = (int)((i / 2) % 4), mixer = (int)(i & 1);
    const float* o = (mixer ? OR : OG) + (size_t)r * 256 + h * 64;
    const float* g = (mixer ? gn_ret : gn_gla) + h * 64;
    const act_t* gate = P + (size_t)r * PP + (mixer ? OFF_RG : OFF_GR) + h * 64;
    float ss = 0.f; for (int e = 0; e < 64; ++e) ss += o[e] * o[e];
    const float rs = rsqrtf(ss * (1.0f / 64) + EPS);
    act_t* y = Y + (size_t)r * D + (mixer ? 768 : 256) + h * 64;
    for (int e = 0; e < 64; ++e) stA(y + e, o[e] * rs * g[e] * siluf_(ldA(gate + e)));
}

enum { PH_PROLOG = 0, PH_NORM1, PH_INPROJ, PH_WOUT, PH_NORM2, PH_UP, PH_DOWN, PH_FINAL };
__global__ void __launch_bounds__(NTHREADS, 2) mk(Args a) {
    extern __shared__ __attribute__((aligned(16))) unsigned char lds_raw[];
    LAS unsigned char* lds = (LAS unsigned char*)lds_raw;
    const int tid = threadIdx.x, lane = tid & 63, wave = __builtin_amdgcn_readfirstlane(tid >> 6);
    const int bid = blockIdx.x, G = gridDim.x, gw = bid * NWAVES + wave, NGW = G * NWAVES;
    unsigned char* ws = a.ws;
    const int l = a.layer; const bool need_ctx = l < DEPTH - 1; const int nro = need_ctx ? M : ML;
    const float* mod = (const float*)(ws + WS_MOD) + (size_t)l * NS * NMOD;
    const float* xl = l == 0 ? a.in[0] : a.out; const float* xc = l == 0 ? a.in[2] : (const float*)(ws + WS_XC);
    float* XC = (float*)(ws + WS_XC);
    bf16* ACT = (bf16*)(ws + WS_ACT); bf16* P = (bf16*)(ws + WS_P); bf16* H = (bf16*)(ws + WS_H);
    const int lo = a.ph_lo, hi = a.ph_hi;
#define IN(k) (lo <= (k) && (k) < hi)
    if (IN(PH_PROLOG)) { ph_prologue(a, lds, tid, lane, wave, bid, G); }
    if (IN(PH_NORM1)) { ph_normmod(xl, xc, a.in[6] + l * D, mod, 0, 1, ACT, M, lane, gw, NGW); }
    if (IN(PH_INPROJ)) { { pg8::Gemm g{ACT, (const bf16*)(ws + WS_WIN + l * WIN_BYTES), M, PP, D}; pg8::StaticOrder S; S.init(M, PP, G, bid);
            pg8::EpiStore<0> E{P, PP}; pg8::gemm_phase<pg8::EpiStore<0>, pg8::StaticOrder, true, true>(lds, g, S, E); } }
    if (IN(PH_WOUT)) { { pg8::Gemm g{ACT, (const bf16*)(ws + WS_WOUT + l * WOUT_BYTES), nro, D, D}; pg8::StaticOrder S; S.init(nro, D, G, bid);
            pg8::EpiResid E{xl, xc, a.out, XC, mod + 2 * D}; pg8::gemm_phase<pg8::EpiResid, pg8::StaticOrder, true, true>(lds, g, S, E); } }
    if (IN(PH_NORM2)) { ph_normmod(a.out, XC, a.in[7] + l * D, mod, 3, 4, ACT, nro, lane, gw, NGW); }
    if (IN(PH_UP)) { { pg8::Gemm g{ACT, (const bf16*)(ws + WS_WUP + l * WUP_BYTES), nro, DFF, D}; pg8::StaticOrder S; S.init(nro, DFF, G, bid);
            pg8::EpiStore<2> E{H, DFF}; pg8::gemm_phase<pg8::EpiStore<2>, pg8::StaticOrder, true, true>(lds, g, S, E); } }
    if (IN(PH_DOWN)) { { pg8::Gemm g{H, (const bf16*)(ws + WS_WDN + l * WDN_BYTES), nro, D, DFF}; pg8::StaticOrder S; S.init(nro, D, G, bid);
            pg8::EpiResid E{a.out, XC, a.out, XC, mod + 5 * D}; pg8::gemm_phase<pg8::EpiResid, pg8::StaticOrder, true, true>(lds, g, S, E); } }
    if (IN(PH_FINAL)) { ph_final(a.out, a.in[26], lane, gw, NGW); }
#undef IN
}
extern "C" void kernel_launch(void* const* d_in, const int* in_sizes, int n_in, void* d_out, int out_size, void* d_ws, size_t ws_size, hipStream_t stream) {
    static int grid = 0;
    if (grid == 0) {
        if (n_in != 27 || in_sizes[0] != ML * D || out_size != ML * D || ws_size < WS_END) { fprintf(stderr, "kernel_launch: unexpected shapes / workspace (n_in %d, ws %zu)\n", n_in, ws_size); grid = -1; return; }
        int dev = 0, cus = 0;
        if (hipGetDevice(&dev) != hipSuccess || hipDeviceGetAttribute(&cus, hipDeviceAttributeMultiprocessorCount, dev) != hipSuccess) { grid = -1; return; }
        if (hipFuncSetAttribute((const void*)mk, hipFuncAttributeMaxDynamicSharedMemorySize, LDS_BYTES) != hipSuccess) { fprintf(stderr, "kernel_launch: hipFuncSetAttribute failed\n"); grid = -1; return; }
        grid = cus;
    }
    if (grid < 0) return;
    Args a{};
    for (int i = 0; i < 27; ++i) a.in[i] = (const float*)d_in[i];
    a.out = (float*)d_out; a.ws = (unsigned char*)d_ws;
    auto run = [&](int ph, int l) { a.ph_lo = ph; a.ph_hi = ph + 1; a.layer = l; hipLaunchKernelGGL(mk, dim3(grid), dim3(NTHREADS), LDS_BYTES, stream, a); };
    char* ws = (char*)d_ws;
    const size_t NVB = 182 * MiB;
    act_t* Y = (act_t*)(ws + WS_ACT); act_t* P = (act_t*)(ws + WS_P);
    float* CY = (float*)(ws + NVB); act_t* CZ = (act_t*)(ws + NVB + 17 * MiB); act_t* QA = (act_t*)(ws + NVB + 26 * MiB); act_t* KA = (act_t*)(ws + NVB + 35 * MiB);
    float* LAF = (float*)(ws + NVB + 40 * MiB); float* LAB = (float*)(ws + NVB + 49 * MiB); act_t* RQ = (act_t*)(ws + NVB + 58 * MiB); act_t* RK = (act_t*)(ws + NVB + 63 * MiB);
    float* OG = CY; float* OR = (float*)(ws + NVB + 17 * MiB);
    const float* conv_w_dw = (const float*)d_in[9]; const float* conv_b_dw = (const float*)d_in[10]; const float* conv_ln_g = (const float*)d_in[11];
    const float* conv_ln_b = (const float*)d_in[12]; const float* conv_w_pw = (const float*)d_in[13]; const float* conv_b_pw = (const float*)d_in[14];
    const float* gla_w_a_f = (const float*)d_in[15]; const float* gla_b_a_f = (const float*)d_in[16]; const float* gla_w_a_b = (const float*)d_in[17]; const float* gla_b_a_b = (const float*)d_in[18];
    const float* gla_norm_g = (const float*)d_in[19]; const float* att_q_norm_g = (const float*)d_in[20]; const float* att_k_norm_g = (const float*)d_in[21]; const float* ret_norm_g = (const float*)d_in[22];
    run(PH_PROLOG, 0);
    for (int l = 0; l < DEPTH; ++l) {
        const bool need_ctx = l < DEPTH - 1; const int nro = need_ctx ? M : ML;
        run(PH_NORM1, l);
        run(PH_INPROJ, l);
        LAUNCH(k_conv_dw, (long)nro * 256, P, conv_w_dw + l * 31 * 256, conv_b_dw + l * 256, CY, nro);
        LAUNCH(k_conv_ln, (long)nro * 256, CY, conv_ln_g + l * 256, conv_ln_b + l * 256, CZ, nro);
        { GemmArgs g{}; g.A = CZ; g.lda = 256; g.W = conv_w_pw + (size_t)l * 256 * 256; g.ldw = 256; g.K = 256; g.N = 256; g.nrows = nro; g.C = Y; g.ldc = D; g.bias = conv_b_pw + l * 256;
          LAUNCH(k_gemm<0>, (long)(nro / 8) * 256, g); }
        LAUNCH(k_gla_gates, (long)M * 256, P, gla_w_a_f + l * 16 * 128, gla_b_a_f + l * 128, gla_w_a_b + l * 16 * 128, gla_b_a_b + l * 128, LAF, LAB);
        LAUNCH(k_att_prep, (long)M * 6, P, att_q_norm_g + l * 64, att_k_norm_g + l * 64, QA, KA);
        LAUNCH(k_ret_prep, (long)M * 8, P, RQ, RK);
        LAUNCH(k_att, (long)nro * 16, QA, KA, P, Y, nro);
        LAUNCH(k_scan, (long)2 * NB * 4 * 64, P, LAF, LAB, RQ, RK, OG, OR, 0);
        LAUNCH(k_scan, (long)2 * NB * 4 * 64, P, LAF, LAB, RQ, RK, OG, OR, 1);
        LAUNCH(k_scan_out, (long)nro * 8, OG, OR, P, gla_norm_g + l * 256, ret_norm_g + l * 256, Y, nro);
        run(PH_WOUT, l); run(PH_NORM2, l); run(PH_UP, l); run(PH_DOWN, l);
    }
    run(PH_FINAL, 0);
}
```

```cpp
#include <hip/hip_runtime.h>
#include <hip/hip_cooperative_groups.h>
#include <cstdio>
#include <cstdint>
namespace cg = cooperative_groups;

constexpr int D = 1024, NB = 4, SEQ = 4096, CTX = 256, DFF = 4096, DEPTH = 2, GRIDW = 64;
constexpr int ML = NB * SEQ, MC = NB * CTX, M = ML + MC, NS = NB + 1, NMOD = 6 * D;
constexpr int PIN = 2576;
constexpr int PP = 2816;
constexpr int OFF_CA = 0, OFF_CG = 256, OFF_GQ = 512, OFF_GK = 640, OFF_GV = 768, OFF_GR = 1024, OFF_AQ = 1280, OFF_AK = 1536, OFF_AV = 1664,
              OFF_RQ = 1792, OFF_RK = 1920, OFF_RV = 2048, OFF_RG = 2304, OFF_Z = 2560;
constexpr float EPS = 1e-6f;
constexpr int KEYS = CTX + SEQ;
namespace pg8 {
#define PG8_LAS __attribute__((address_space(3)))
typedef unsigned short bf16_t;
typedef short bf16x8 __attribute__((ext_vector_type(8)));
typedef float f32x4 __attribute__((ext_vector_type(4)));
typedef unsigned u32x4 __attribute__((ext_vector_type(4)));
constexpr int BM = 256, BK = 64, HALF = 128, HTB = HALF * BK * 2  , STAGE_BYTES = 8 * HTB, NXCD = 8, WGM = 8;

__host__ __device__ __forceinline__ int lds_byte(int r, int c) { const int st = (r >> 4) * 2 + (c >> 5), rr = r & 15, cc = c & 31, ob = rr * 64 + cc * 2; return st * 1024 + (ob ^ (((ob >> 9) & 1) << 5)); }
__host__ __device__ __forceinline__ void stage_rc(int b, int& R, int& C) { const int st = b / 1024, sb = b % 1024, swz = sb ^ (((sb >> 9) & 1) << 5); R = (st >> 1) * 16 + swz / 64; C = (st & 1) * 32 + (swz % 64) / 2; }
__host__ __device__ __forceinline__ int perm32(int rho) { const int n = rho >> 4, i = rho & 15; return 8 * (i >> 2) + 4 * n + (i & 3); }

struct Unit { int pm, pn; };
struct Gemm { const bf16_t* A; const bf16_t* Bt; int M, N, K; };

struct StaticOrder {
    int nM, nN, nwg, G, c;
    __host__ __device__ void init(int M, int N, int G_, int c_) { nM = M / BM; nN = N / BM; nwg = nM * nN; G = G_; c = c_; }
    __host__ __device__ bool next(int i, Unit& u) const {
        const long L = (long)i * G + c; if (L >= nwg) return false;
        int wgid = (int)L; { const int q = nwg / NXCD, r = nwg % NXCD, xcd = wgid % NXCD, off = wgid / NXCD; wgid = (xcd < r ? xcd * (q + 1) : r * (q + 1) + (xcd - r) * q) + off; }
        const int nig = WGM * nN, gid = wgid / nig, fm = gid * WGM, gsz = (nM - fm) < WGM ? (nM - fm) : WGM;
        u.pm = fm + ((wgid % nig) % gsz); u.pn = (wgid % nig) / gsz; return true;
    }
    __device__ __forceinline__ void a_ready(const Unit&) const {}
    __device__ __forceinline__ void done(const Unit&) const {}
};

__device__ __forceinline__ unsigned cvt_pk_bf16(float lo, float hi) { unsigned r; asm volatile("v_cvt_pk_bf16_f32 %0, %1, %2" : "=v"(r) : "v"(lo), "v"(hi)); return r; }
typedef float f32x2 __attribute__((ext_vector_type(2)));
__device__ __forceinline__ f32x2 gelu_pk(f32x2 v) {
    const f32x2 av = __builtin_elementwise_abs(v), d = av * 0.2316418882f + 1.0f;
    f32x2 t; t.x = __builtin_amdgcn_rcpf(d.x); t.y = __builtin_amdgcn_rcpf(d.y);
    f32x2 q = t * 0.5307027145f + (-0.7265760135f); q = q * t + 0.7107068705f; q = q * t + (-0.142248368f); q = q * t + 0.127414796f; q = q * t;
    const f32x2 s = (v * v) * (-0.72134752044f);
    f32x2 e; e.x = __builtin_amdgcn_exp2f(s.x); e.y = __builtin_amdgcn_exp2f(s.y);
    const f32x2 m = v * (q * e), r = v - m;
    f32x2 o; o.x = v.x < 0.f ? m.x : r.x; o.y = v.y < 0.f ? m.y : r.y; return o;
}

template <int ACT  > struct EpiBf16 {
    static constexpr bool PERM = true, AFTER_DRAIN = false; static_assert(ACT == 0 || ACT == 1, "EpiBf16: ACT is 0 (none) or 1 (gelu_pk)");
    bf16_t* O; int ldc; const float* bias; int split_cols; size_t split_stride; float scale0;
    __device__ __forceinline__ void operator()(const f32x4 (&acc)[2][2][4][2], const Unit& u, int wr, int wc, int fr, int fq) const {
        const int row0 = u.pm * BM + wr * 64 + fr; int colt = u.pn * BM; bf16_t* base = O;
        float sc = 1.f; if (split_cols) { const int t = colt / split_cols; base += (size_t)t * split_stride; colt -= t * split_cols; if (t == 0) sc = scale0; }
        const int col0 = colt + wc * 32 + 8 * fq, bcol0 = u.pn * BM + wc * 32 + 8 * fq;
        f32x4 bv[2][2];
#pragma unroll
        for (int bj = 0; bj < 2; ++bj)
#pragma unroll
            for (int n = 0; n < 2; ++n) bv[bj][n] = bias ? *(const f32x4*)(bias + bcol0 + bj * HALF + 4 * n) : (f32x4){0.f, 0.f, 0.f, 0.f};
#pragma unroll
        for (int ai = 0; ai < 2; ++ai)
#pragma unroll
            for (int m = 0; m < 4; ++m) { bf16_t* rowp = base + (size_t)(row0 + ai * HALF + m * 16) * ldc + col0;
#pragma unroll
                for (int bj = 0; bj < 2; ++bj) { f32x4 v0 = acc[ai][bj][m][0] + bv[bj][0], v1 = acc[ai][bj][m][1] + bv[bj][1];
                    if (ACT == 1) { f32x2 a = gelu_pk((f32x2){v0[0], v0[1]}), b = gelu_pk((f32x2){v0[2], v0[3]}), c = gelu_pk((f32x2){v1[0], v1[1]}), d = gelu_pk((f32x2){v1[2], v1[3]});
                        v0 = (f32x4){a.x, a.y, b.x, b.y}; v1 = (f32x4){c.x, c.y, d.x, d.y}; }
                    v0 = v0 * sc; v1 = v1 * sc; u32x4 w; w.x = cvt_pk_bf16(v0[0], v0[1]); w.y = cvt_pk_bf16(v0[2], v0[3]); w.z = cvt_pk_bf16(v1[0], v1[1]); w.w = cvt_pk_bf16(v1[2], v1[3]);
                    *(u32x4*)(rowp + bj * HALF) = w; } }
    }
};

template <int ACT> struct EpiStore {
    static constexpr bool PERM = true, AFTER_DRAIN = false;
    bf16_t* O; int ldc;
    __device__ __forceinline__ void operator()(const f32x4 (&acc)[2][2][4][2], const Unit& u, int wr, int wc, int fr, int fq) const {
        const int row0 = u.pm * BM + wr * 64 + fr, col0 = u.pn * BM + wc * 32 + 8 * fq;
#pragma unroll
        for (int ai = 0; ai < 2; ++ai)
#pragma unroll
            for (int m = 0; m < 4; ++m) { bf16_t* rowp = O + (size_t)(row0 + ai * HALF + m * 16) * ldc + col0;
#pragma unroll
                for (int bj = 0; bj < 2; ++bj) { f32x4 v0 = acc[ai][bj][m][0], v1 = acc[ai][bj][m][1];
                    if (ACT == 2) {
#pragma unroll
                        for (int e = 0; e < 4; ++e) { const float a = v0[e] > 0.f ? v0[e] : 0.f, b = v1[e] > 0.f ? v1[e] : 0.f; v0[e] = a * a; v1[e] = b * b; } }
                    u32x4 w; w.x = cvt_pk_bf16(v0[0], v0[1]); w.y = cvt_pk_bf16(v0[2], v0[3]); w.z = cvt_pk_bf16(v1[0], v1[1]); w.w = cvt_pk_bf16(v1[2], v1[3]);
                    *(u32x4*)(rowp + bj * HALF) = w; } }
    }
};
struct EpiResid {
    static constexpr bool PERM = false, AFTER_DRAIN = false;
    const float* xin_l; const float* xin_c; float* xout_l; float* xout_c; const float* gate;
    __device__ __forceinline__ void operator()(const f32x4 (&acc)[2][2][4][2], const Unit& u, int wr, int wc, int fr, int fq) const {
        const int r0 = u.pm * BM; const bool lat = r0 < ML; const int slot = lat ? r0 / SEQ : NB;
        const float* xin = lat ? xin_l + (size_t)r0 * D : xin_c + (size_t)(r0 - ML) * D;
        float* xout = lat ? xout_l + (size_t)r0 * D : xout_c + (size_t)(r0 - ML) * D;
        const int col0 = wc * 32 + 4 * fq;
        const float* gp = gate + (size_t)slot * NMOD + u.pn * BM;
        xin += u.pn * BM; xout += u.pn * BM;
#pragma unroll
        for (int ai = 0; ai < 2; ++ai)
#pragma unroll
            for (int m = 0; m < 4; ++m) { const int off = (ai * HALF + wr * 64 + m * 16 + fr) * D + col0;
#pragma unroll
                for (int bj = 0; bj < 2; ++bj)
#pragma unroll
                    for (int n = 0; n < 2; ++n) { const f32x4 xi = *(const f32x4*)(xin + off + bj * HALF + n * 16); const f32x4 gv = *(const f32x4*)(gp + col0 + bj * HALF + n * 16);
                        *(f32x4*)(xout + off + bj * HALF + n * 16) = xi + gv * acc[ai][bj][m][n]; }
                asm volatile("" ::: "memory"); }
    }
};

template <class Epi, class Sched, bool ALIGN_EPI = false, bool SP2 = false>
__device__ __forceinline__ void gemm_phase(PG8_LAS unsigned char* lds, const Gemm g, const Sched& S, const Epi& E) {
    const int tid = threadIdx.x, wid = __builtin_amdgcn_readfirstlane(tid >> 6), lane = tid & 63, wr = wid >> 2, wc = wid & 3, fr = lane & 15, fq = lane >> 4;
    const int K = g.K, nt = K / BK;
    unsigned voffA[2], voffB[2];
#pragma unroll
    for (int i = 0; i < 2; ++i) { int R, C; stage_rc(tid * 16 + i * 8192, R, C); const int Rb = Epi::PERM ? ((R & ~31) + perm32(R & 31)) : R;
        voffA[i] = (unsigned)(R * K + C) * 2u; voffB[i] = (unsigned)(Rb * K + C) * 2u; }
    const size_t kstep = (size_t)(BK * 2);
    const size_t hstep = (size_t)HALF * K * 2;
    const size_t tstep = 2 * hstep;
    const unsigned ldsw = (unsigned)wid * 1024u;
    const int aoff = lds_byte(wr * 64 + fr, fq * 8), boff = lds_byte(wc * 32 + fr, fq * 8);
#define PG8_SA(b, h) (((b) * 2 + (h)) * HTB)
#define PG8_SB(b, h) ((4 + (b) * 2 + (h)) * HTB)
#define PG8_STAGE(bufoff, gbase, voff) do { _Pragma("unroll") for (int _i = 0; _i < 2; ++_i) \
        __builtin_amdgcn_global_load_lds((const unsigned*)((const char*)(gbase) + (voff)[_i]), (PG8_LAS unsigned*)(lds + (bufoff) + ldsw + _i * 8192), 16, 0, 0); } while (0)
#define PG8_LDA(dst, b, h) do { _Pragma("unroll") for (int m = 0; m < 4; ++m) _Pragma("unroll") for (int k = 0; k < 2; ++k) dst[m][k] = *(const PG8_LAS bf16x8*)(lds + PG8_SA(b, h) + aoff + m * 2048 + k * 1024); } while (0)
#define PG8_LDB(dst, b, h) do { _Pragma("unroll") for (int n = 0; n < 2; ++n) _Pragma("unroll") for (int k = 0; k < 2; ++k) dst[n][k] = *(const PG8_LAS bf16x8*)(lds + PG8_SB(b, h) + boff + n * 2048 + k * 1024); } while (0)
#define PG8_MMA(ai, bj, At, Bt) do { __builtin_amdgcn_s_setprio(1); _Pragma("unroll") for (int m = 0; m < 4; ++m) _Pragma("unroll") for (int n = 0; n < 2; ++n) _Pragma("unroll") for (int k = 0; k < 2; ++k) \
        acc[ai][bj][m][n] = __builtin_amdgcn_mfma_f32_16x16x32_bf16(Bt[n][k], At[m][k], acc[ai][bj][m][n], 0, 0, 0); __builtin_amdgcn_s_setprio(0); } while (0)
#define PG8_WAIT_V(n) asm volatile("s_waitcnt vmcnt(" #n ")" ::: "memory")
#define PG8_WAIT_L(n) asm volatile("s_waitcnt lgkmcnt(" #n ")" ::: "memory")
#define PG8_BAR __builtin_amdgcn_s_barrier()
#define PG8_SCHED __builtin_amdgcn_sched_barrier(0)
    Unit cur, nxt; int ui = 0;
    if (!S.next(0, cur)) return;
    f32x4 acc[2][2][4][2];
#pragma unroll
    for (int a = 0; a < 2; ++a)
#pragma unroll
        for (int b = 0; b < 2; ++b)
#pragma unroll
            for (int m = 0; m < 4; ++m)
#pragma unroll
                for (int n = 0; n < 2; ++n) acc[a][b][m][n] = (f32x4){0.f, 0.f, 0.f, 0.f};
    bf16x8 At[4][2], B0[2][2], B1[2][2];
    const char* cA = (const char*)g.A + (size_t)cur.pm * tstep; const char* cB = (const char*)g.Bt + (size_t)cur.pn * tstep;
    S.a_ready(cur);
    if constexpr (SP2) {
        PG8_STAGE(PG8_SB(0, 0), cB, voffB); PG8_STAGE(PG8_SB(0, 1), cB + hstep, voffB); PG8_STAGE(PG8_SA(0, 0), cA, voffA); PG8_STAGE(PG8_SA(0, 1), cA + hstep, voffA);
        if (wr == 1) PG8_BAR;
        PG8_WAIT_V(2); PG8_BAR;
        PG8_STAGE(PG8_SB(1, 0), cB + kstep, voffB); PG8_STAGE(PG8_SA(1, 0), cA + kstep, voffA); PG8_STAGE(PG8_SB(1, 1), cB + hstep + kstep, voffB);
        PG8_WAIT_V(6); PG8_BAR;
    } else {
        PG8_STAGE(PG8_SB(0, 0), cB, voffB); PG8_STAGE(PG8_SA(0, 0), cA, voffA); PG8_STAGE(PG8_SB(0, 1), cB + hstep, voffB); PG8_STAGE(PG8_SA(0, 1), cA + hstep, voffA);
        if (wr == 1) PG8_BAR;
        PG8_WAIT_V(4); PG8_BAR;
        PG8_STAGE(PG8_SB(1, 0), cB + kstep, voffB); PG8_STAGE(PG8_SA(1, 0), cA + kstep, voffA); PG8_STAGE(PG8_SB(1, 1), cB + hstep + kstep, voffB);
        PG8_WAIT_V(6); PG8_BAR;
    }
    for (;;) {
        const bool has_next = S.next(ui + 1, nxt);
        const char* nA = has_next ? (const char*)g.A + (size_t)nxt.pm * tstep : cA; const char* nB = has_next ? (const char*)g.Bt + (size_t)nxt.pn * tstep : cB;
        for (int t = 0; t < nt; t += 2) {
            const bool last = (t == nt - 2);
            const char* a1 = cA + (size_t)(t + 1) * kstep;
            const char* a2 = last ? nA : cA + (size_t)(t + 2) * kstep; const char* b2 = last ? nB : cB + (size_t)(t + 2) * kstep;
            const char* a3 = a2 + kstep; const char* b3 = b2 + kstep;
            if (last && has_next) S.a_ready(nxt);
            if constexpr (SP2) {
            PG8_LDB(B0, 0, 0); PG8_LDB(B1, 0, 1); PG8_SCHED; PG8_LDA(At, 0, 0); PG8_STAGE(PG8_SA(1, 1), a1 + hstep, voffA);
            PG8_WAIT_V(8); PG8_WAIT_L(0); PG8_BAR; PG8_MMA(0, 0, At, B0); PG8_MMA(0, 1, At, B1); PG8_BAR; PG8_SCHED;
            PG8_LDA(At, 0, 1); PG8_STAGE(PG8_SB(0, 0), b2, voffB); PG8_STAGE(PG8_SB(0, 1), b2 + hstep, voffB); PG8_STAGE(PG8_SA(0, 0), a2, voffA);
            PG8_WAIT_V(8); PG8_WAIT_L(0); PG8_BAR; PG8_MMA(1, 0, At, B0); PG8_MMA(1, 1, At, B1); PG8_BAR; PG8_SCHED;
            PG8_LDB(B0, 1, 0); PG8_LDB(B1, 1, 1); PG8_SCHED; PG8_LDA(At, 1, 0); PG8_STAGE(PG8_SA(0, 1), a2 + hstep, voffA);
            PG8_WAIT_V(8); PG8_WAIT_L(0); PG8_BAR; PG8_MMA(0, 0, At, B0); PG8_MMA(0, 1, At, B1); PG8_BAR; PG8_SCHED;
            PG8_LDA(At, 1, 1); PG8_STAGE(PG8_SB(1, 0), b3, voffB); PG8_STAGE(PG8_SB(1, 1), b3 + hstep, voffB); PG8_STAGE(PG8_SA(1, 0), a3, voffA);
            PG8_WAIT_V(8); PG8_WAIT_L(0); PG8_BAR; PG8_MMA(1, 0, At, B0); PG8_MMA(1, 1, At, B1); PG8_BAR; PG8_SCHED;
            } else {
            PG8_LDB(B0, 0, 0); PG8_SCHED; PG8_LDA(At, 0, 0); PG8_STAGE(PG8_SA(1, 1), a1 + hstep, voffA);
            PG8_WAIT_L(8); PG8_BAR; PG8_WAIT_L(0); PG8_MMA(0, 0, At, B0); PG8_BAR; PG8_SCHED;
            PG8_LDB(B1, 0, 1); PG8_STAGE(PG8_SB(0, 0), b2, voffB);
            PG8_BAR; PG8_WAIT_L(0); PG8_MMA(0, 1, At, B1); PG8_BAR;
            PG8_LDA(At, 0, 1); PG8_STAGE(PG8_SA(0, 0), a2, voffA);
            PG8_BAR; PG8_WAIT_L(0); PG8_MMA(1, 0, At, B0); PG8_BAR; PG8_SCHED;
            PG8_STAGE(PG8_SB(0, 1), b2 + hstep, voffB);
            PG8_WAIT_V(6); PG8_BAR; PG8_MMA(1, 1, At, B1); PG8_BAR;
            PG8_LDB(B0, 1, 0); PG8_SCHED; PG8_LDA(At, 1, 0); PG8_STAGE(PG8_SA(0, 1), a2 + hstep, voffA);
            PG8_WAIT_L(8); PG8_BAR; PG8_WAIT_L(0); PG8_MMA(0, 0, At, B0); PG8_BAR; PG8_SCHED;
            PG8_LDB(B1, 1, 1); PG8_STAGE(PG8_SB(1, 0), b3, voffB);
            PG8_BAR; PG8_WAIT_L(0); PG8_MMA(0, 1, At, B1); PG8_BAR;
            PG8_LDA(At, 1, 1); PG8_STAGE(PG8_SA(1, 0), a3, voffA);
            PG8_BAR; PG8_WAIT_L(0); PG8_MMA(1, 0, At, B0); PG8_BAR; PG8_SCHED;
            PG8_STAGE(PG8_SB(1, 1), b3 + hstep, voffB);
            PG8_WAIT_V(6); PG8_BAR; PG8_MMA(1, 1, At, B1); PG8_BAR;
            }
        }
        if constexpr (ALIGN_EPI) { if (wr == 0) PG8_BAR; }
        if constexpr (!Epi::AFTER_DRAIN) { E(acc, cur, wr, wc, fr, fq); S.done(cur); }
        if (!has_next) break;
#pragma unroll
        for (int a = 0; a < 2; ++a)
#pragma unroll
            for (int b = 0; b < 2; ++b)
#pragma unroll
                for (int m = 0; m < 4; ++m)
#pragma unroll
                    for (int n = 0; n < 2; ++n) acc[a][b][m][n] = (f32x4){0.f, 0.f, 0.f, 0.f};
        cur = nxt; cA = nA; cB = nB; ++ui;
        if constexpr (ALIGN_EPI) { if (wr == 1) PG8_BAR; }
    }
    PG8_WAIT_V(0);
    if constexpr (!ALIGN_EPI) { if (wr == 0) PG8_BAR; }
    PG8_BAR;
    if constexpr (Epi::AFTER_DRAIN) { E.fused(acc, cur, wr, wc, fr, fq, lds, wid, lane); S.done(cur); }
#undef PG8_SA
#undef PG8_SB
#undef PG8_STAGE
#undef PG8_LDA
#undef PG8_LDB
#undef PG8_MMA
#undef PG8_WAIT_V
#undef PG8_WAIT_L
#undef PG8_BAR
#undef PG8_SCHED
}
}
#include <hip/hip_bf16.h>
#include <cmath>
namespace attn_body {
using bf16=__hip_bfloat16;
using bf16x8=__attribute__((ext_vector_type(8)))short;
using s16x4=__attribute__((ext_vector_type(4)))short;
using f32x16=__attribute__((ext_vector_type(16)))float;
using u32x4=__attribute__((ext_vector_type(4)))unsigned;
constexpr int D=64;
constexpr int QP=256,KP=128,OP=1024;
constexpr int NW=8,QBLK=32,QB=QBLK*NW,KVBLK=64;
constexpr int ATTN_UNIT_ROWS=QB;
__device__ __forceinline__ int crow(int r,int hi){return (r&3)+8*(r>>2)+4*hi;}
#define SBAR() __builtin_amdgcn_sched_barrier(0)
__device__ __forceinline__ void cmask(f32x16&p0,f32x16&p1,int jb,int qrel,int hi){
  const float NEG=-INFINITY; int kb=64*jb+4*hi;
  #pragma unroll
  for(int r=0;r<16;++r){int kv=kb+(r&3)+8*(r>>2); if(kv>qrel)p0[r]=NEG; if(kv+32>qrel)p1[r]=NEG;}
}

constexpr int NSLOT=3, SLOTB=8192;
constexpr int LDS_K=0, LDS_V=NSLOT*SLOTB, LDS_WS=2*NSLOT*SLOTB, LDS_OST=LDS_WS+NW*64*4, LDS_BYTES=LDS_OST+NW*4096;
constexpr float C2=0.125f*1.4426950408889634f;
__device__ __forceinline__ void glds16(const void*gsrc,unsigned lds_dst){unsigned keep;
  asm volatile("s_mov_b32 %0, m0\n\ts_mov_b32 m0, %2\n\ts_nop 0\n\tglobal_load_lds_dwordx4 %1, off\n\ts_mov_b32 m0, %0":"=&s"(keep):"v"(gsrc),"s"(lds_dst):"memory");}
__device__ __forceinline__ float max3f(float a,float b,float c){float r;asm("v_max3_f32 %0, %1, %2, %3":"=v"(r):"v"(a),"v"(b),"v"(c));return r;}
__device__ __forceinline__ float max2f(float a,float b){float r;asm("v_max_f32_e32 %0, %1, %2":"=v"(r):"v"(a),"v"(b));return r;}
__device__ __forceinline__ float fadd_s(float a,float b){float r;asm("v_add_f32_e32 %0, %1, %2":"=v"(r):"v"(a),"v"(b));return r;}
__device__ __forceinline__ float fsub_s(float a,float b){float r;asm("v_sub_f32_e32 %0, %1, %2":"=v"(r):"v"(a),"v"(b));return r;}
typedef float f32x2_t __attribute__((ext_vector_type(2))); typedef __bf16 bf16x2_t __attribute__((ext_vector_type(2)));
__device__ __forceinline__ unsigned cvtpk_s(float lo,float hi){f32x2_t v={lo,hi};bf16x2_t b=__builtin_convertvector(v,bf16x2_t);return __builtin_bit_cast(unsigned,b);}
#define WAIT_BAR(N) asm volatile("s_waitcnt vmcnt(" #N ") lgkmcnt(0)\n\ts_barrier":::"memory")

__device__ __forceinline__ void qkt(f32x16&p0,f32x16&p1,const char*Kslot,const bf16x8*qr,const f32x16&negm,int r32,int hi){
  const char*kb=Kslot+hi*1024+r32*16;
  #pragma unroll
  for(int d0=0;d0<4;++d0){
    const bf16x8 b0=*reinterpret_cast<const bf16x8*>(kb+d0*2048);
    const bf16x8 b1=*reinterpret_cast<const bf16x8*>(kb+d0*2048+512);
    if(d0==0){p0=__builtin_amdgcn_mfma_f32_32x32x16_bf16(b0,qr[0],negm,0,0,0);p1=__builtin_amdgcn_mfma_f32_32x32x16_bf16(b1,qr[0],negm,0,0,0);}
    else{p0=__builtin_amdgcn_mfma_f32_32x32x16_bf16(b0,qr[d0],p0,0,0,0);p1=__builtin_amdgcn_mfma_f32_32x32x16_bf16(b1,qr[d0],p1,0,0,0);}}
}
typedef __attribute__((address_space(3))) const char* lds_cptr;
typedef short v4i16_t __attribute__((ext_vector_type(4)));
__device__ __forceinline__ void kload8(bf16x8*kf,lds_cptr kp){
  kf[0]=*(const __attribute__((address_space(3))) bf16x8*)(kp);      kf[1]=*(const __attribute__((address_space(3))) bf16x8*)(kp+512);
  kf[2]=*(const __attribute__((address_space(3))) bf16x8*)(kp+2048); kf[3]=*(const __attribute__((address_space(3))) bf16x8*)(kp+2560);
  kf[4]=*(const __attribute__((address_space(3))) bf16x8*)(kp+4096); kf[5]=*(const __attribute__((address_space(3))) bf16x8*)(kp+4608);
  kf[6]=*(const __attribute__((address_space(3))) bf16x8*)(kp+6144); kf[7]=*(const __attribute__((address_space(3))) bf16x8*)(kp+6656);
}
__device__ __forceinline__ void kload2(bf16x8*kf,lds_cptr kp,int j){ kf[2*j]=*(const __attribute__((address_space(3))) bf16x8*)(kp+j*2048); kf[2*j+1]=*(const __attribute__((address_space(3))) bf16x8*)(kp+j*2048+512); }
__device__ __forceinline__ s16x4 vtr(lds_cptr p){ return __builtin_bit_cast(s16x4,__builtin_amdgcn_ds_read_tr16_b64_v4i16((__attribute__((address_space(3))) v4i16_t*)p)); }
__device__ __forceinline__ float rowmax(const f32x16&p0,const f32x16&p1){
  float a=max3f(p0[0],p0[1],p1[0]),b=max3f(p0[2],p0[3],p1[1]);a=max3f(a,p1[2],p1[3]);
  #pragma unroll
  for(int r=4;r<16;r+=4){a=max3f(a,p0[r],p0[r+1]);b=max3f(b,p0[r+2],p0[r+3]);a=max3f(a,p1[r],p1[r+1]);b=max3f(b,p1[r+2],p1[r+3]);}
  const float m=max2f(a,b);
  auto rr=__builtin_amdgcn_permlane32_swap(__float_as_uint(m),__float_as_uint(m),false,false);
  return max2f(__uint_as_float(rr[0]),__uint_as_float(rr[1]));
}
__device__ __forceinline__ void pv(f32x16*o,int vb,bf16x8 pa0,bf16x8 pa1,bf16x8 pa2,bf16x8 pa3){
  #pragma unroll
  for(int d0=0;d0<2;++d0){s16x4 lo[4],hi[4];
    #pragma unroll
    for(int ks=0;ks<4;++ks){
      asm volatile("ds_read_b64_tr_b16 %0,%1 offset:%c2":"=&v"(lo[ks]):"v"(vb),"i"(d0*4096+ks*1024):"memory");
      asm volatile("ds_read_b64_tr_b16 %0,%1 offset:%c2":"=&v"(hi[ks]):"v"(vb),"i"(d0*4096+ks*1024+512):"memory");}
    asm volatile("s_waitcnt lgkmcnt(0)":::"memory");SBAR();
    #define PK(k) (bf16x8){lo[k][0],lo[k][1],lo[k][2],lo[k][3],hi[k][0],hi[k][1],hi[k][2],hi[k][3]}
    o[d0]=__builtin_amdgcn_mfma_f32_32x32x16_bf16(pa0,PK(0),o[d0],0,0,0);
    o[d0]=__builtin_amdgcn_mfma_f32_32x32x16_bf16(pa1,PK(1),o[d0],0,0,0);
    o[d0]=__builtin_amdgcn_mfma_f32_32x32x16_bf16(pa2,PK(2),o[d0],0,0,0);
    o[d0]=__builtin_amdgcn_mfma_f32_32x32x16_bf16(pa3,PK(3),o[d0],0,0,0);
    #undef PK
  }
}

#ifndef ATTN_STORE16
#define ATTN_STORE16(p,v) (*(u32x4*)(p)=(v))
#endif
template<int THRL> __device__ __forceinline__ void attn_unit(const bf16*Qu,const bf16*__restrict__ Kh,const bf16*__restrict__ Vh,bf16*Ou,const int NT,char*shm){
  const int tid=threadIdx.x,lane=tid&63,r32=lane&31,hi=lane>>5; const int wid=__builtin_amdgcn_readfirstlane(tid>>6);
  const bf16*Qw=Qu+(long)(wid*QBLK)*QP;
  const unsigned lds0=(unsigned)(uintptr_t)shm;
  float*wsf=(float*)(shm+LDS_WS)+wid*64;
  const bf16*ksrc=Kh+(long)lane*KP+wid*8;
  const bf16*vsrc=Vh+(long)(16*(wid&3)+(lane>>2))*KP+(wid>>2)*32+(lane&3)*8;
  const unsigned kdst=lds0+LDS_K+wid*1024, vdst=lds0+LDS_V+wid*1024;
  #define DMA_K(t,slot) glds16(ksrc+(long)(t)*KVBLK*KP,(unsigned)__builtin_amdgcn_readfirstlane(kdst+(slot)))
  #define DMA_V(t,slot) glds16(vsrc+(long)(t)*KVBLK*KP,(unsigned)__builtin_amdgcn_readfirstlane(vdst+(slot)))
  const int vb0=(int)(lds0+LDS_V)+((lane>>4)&1)*32+(lane&3)*8+(4*hi+((lane&15)>>2))*64;
  const char*Kbase=shm+LDS_K; bf16x8 kf[8];
  const lds_cptr shm3=(lds_cptr)shm; const lds_cptr kp0=shm3+LDS_K+hi*1024+r32*16; const lds_cptr vp0=shm3+LDS_V+((lane>>4)&1)*32+(lane&3)*8+(4*hi+((lane&15)>>2))*64;
  DMA_K(0,0);DMA_V(0,0);DMA_K(1,SLOTB);
  bf16x8 qr[4];
  #pragma unroll
  for(int d0=0;d0<4;++d0)qr[d0]=*reinterpret_cast<const bf16x8*>(&Qw[(long)r32*QP+d0*16+hi*8]);
  float mhat=0.f,l_reg=0.f;f32x16 o[2];o[0]=f32x16{};o[1]=f32x16{};f32x16 negm=f32x16{};asm volatile("":"+v"(negm));
  #define CMASK(P0,P1,t) do{}while(0)
  bool resc=false;
  #define START(P0,P1) do{ const float rm=rowmax(P0,P1); resc=false; \
    { const float dl=rm; mhat=fadd_s(mhat,dl); \
      _Pragma("unroll") for(int r=0;r<16;++r){P0[r]=fsub_s(P0[r],dl);P1[r]=fsub_s(P1[r],dl);} \
      _Pragma("unroll") for(int r=0;r<16;++r)negm[r]=-mhat; asm volatile("":"+v"(negm)); } \
    _Pragma("unroll") for(int r=0;r<16;++r)P0[r]=__builtin_amdgcn_exp2f(P0[r]); }while(0)
  #define RESC() do{ if(resc){ asm volatile("s_waitcnt lgkmcnt(0)":::"memory"); \
      _Pragma("unroll") for(int d_=0;d_<2;++d_) _Pragma("unroll") for(int r=0;r<16;++r)o[d_][r]*=wsf[crow(r,hi)]; } }while(0)
  f32x16 pA0,pA1,pB0,pB1;
  int sl_prev=0,sl_cur=0,sl_next=SLOTB;
  #define ROT() do{sl_prev=sl_cur;sl_cur=sl_next;sl_next=(sl_next==(NSLOT-1)*SLOTB)?0:sl_next+SLOTB;}while(0)
  DMA_K(2,2*SLOTB);
  WAIT_BAR(3);
  qkt(pA0,pA1,Kbase,qr,negm,r32,hi);asm volatile("s_nop 15\n\ts_nop 7":"+v"(pA0),"+v"(pA1));CMASK(pA0,pA1,0);
  START(pA0,pA1);
  _Pragma("unroll") for(int r=0;r<16;++r)pA1[r]=__builtin_amdgcn_exp2f(pA1[r]);
  WAIT_BAR(0);
  DMA_K(3,0);DMA_V(1,SLOTB);
  ROT();
  kload8(kf,kp0+sl_cur);
  WAIT_BAR(2);
  s16x4 vlo[8],vhi[8]; u32x4 pw0,pw1,pw2,pw3;
  #define PKW(P,B) cvtpk_s(P[B],P[B+1])
  #define PAF(k) __builtin_bit_cast(bf16x8,pw##k)
  #define VFR(i) (bf16x8){vlo[i][0],vlo[i][1],vlo[i][2],vlo[i][3],vhi[i][0],vhi[i][1],vhi[i][2],vhi[i][3]}
  #define PIN(x) asm volatile("":"+v"(x))
  #define MX3(a,b,c) __builtin_fmaxf(__builtin_fmaxf((a),(b)),(c))
  #define GAPA(MF,A0,A1,A2,A3,W0,W1,PW) do{ MF; sacc+=A0; sacc+=A1; sacc+=A2; sacc+=A3; PIN(sacc); W0; W1; PIN(PW); SBAR(); }while(0)
  #define EX(v) __builtin_amdgcn_exp2f(v)
  #define GAPB(MF,X,B) do{ MF; X[B]=EX(X[B]); X[B+1]=EX(X[B+1]); X[B+2]=EX(X[B+2]); X[B+3]=EX(X[B+3]); PIN(X); SBAR(); }while(0)
  #define VRD(i) do{ vlo[i]=vtr(vp_+(((i)>>2)*4096+((i)&3)*1024)); vhi[i]=vtr(vp_+(((i)>>2)*4096+((i)&3)*1024+512)); }while(0)
  #define KRD(G,j) do{ if(G){ kload2(kf,kp0+sl_next,j); SBAR(); } }while(0)
  #define STEP(C0,C1,P0,P1,t,GK,GV,GL) do{ SBAR(); \
    const lds_cptr vp_=vp0+sl_prev; \
    VRD(0); SBAR(); float sacc=(P0[0]+P0[1]); \
    GAPA(C0=__builtin_amdgcn_mfma_f32_32x32x16_bf16(kf[0],qr[0],negm,0,0,0), P0[2],P0[3],P0[4],P0[5],     pw0[0]=PKW(P0,0), pw0[1]=PKW(P0,2), pw0); \
    VRD(4); SBAR(); GAPA(C1=__builtin_amdgcn_mfma_f32_32x32x16_bf16(kf[1],qr[0],negm,0,0,0), P0[6],P0[7],P0[8],P0[9],     pw0[2]=PKW(P0,4), pw0[3]=PKW(P0,6), pw0); \
    VRD(1); SBAR(); GAPA(C0=__builtin_amdgcn_mfma_f32_32x32x16_bf16(kf[2],qr[1],C0,0,0,0),   P0[10],P0[11],P0[12],P0[13], pw1[0]=PKW(P0,8), pw1[1]=PKW(P0,10), pw1); \
    VRD(5); SBAR(); GAPA(C1=__builtin_amdgcn_mfma_f32_32x32x16_bf16(kf[3],qr[1],C1,0,0,0),   P0[14],P0[15],P1[0],P1[1],   pw1[2]=PKW(P0,12),pw1[3]=PKW(P0,14), pw1); \
    VRD(2); SBAR(); GAPA(C0=__builtin_amdgcn_mfma_f32_32x32x16_bf16(kf[4],qr[2],C0,0,0,0),   P1[2],P1[3],P1[4],P1[5],     pw2[0]=PKW(P1,0), pw2[1]=PKW(P1,2), pw2); \
    VRD(6); SBAR(); GAPA(C1=__builtin_amdgcn_mfma_f32_32x32x16_bf16(kf[5],qr[2],C1,0,0,0),   P1[6],P1[7],P1[8],P1[9],     pw2[2]=PKW(P1,4), pw2[3]=PKW(P1,6), pw2); \
    VRD(3); SBAR(); GAPA(C0=__builtin_amdgcn_mfma_f32_32x32x16_bf16(kf[6],qr[3],C0,0,0,0),   P1[10],P1[11],P1[12],P1[13], pw3[0]=PKW(P1,8), pw3[1]=PKW(P1,10), pw3); \
    VRD(7); SBAR(); GAPA(C1=__builtin_amdgcn_mfma_f32_32x32x16_bf16(kf[7],qr[3],C1,0,0,0),   P1[14],P1[15],0.f,0.f,       pw3[2]=PKW(P1,12),pw3[3]=PKW(P1,14), pw3); \
    l_reg+=sacc; \
    if(GK){DMA_K((t)+3,sl_cur);} if(GV){DMA_V((t)+1,sl_next);} \
    CMASK(C0,C1,t); \
    { float a=MX3(C0[0],C0[1],C1[0]),b=MX3(C0[2],C0[3],C1[1]); a=MX3(a,C1[2],C1[3]); \
      _Pragma("unroll") for(int r=4;r<16;r+=4){a=MX3(a,C0[r],C0[r+1]);b=MX3(b,C0[r+2],C0[r+3]);a=MX3(a,C1[r],C1[r+1]);b=MX3(b,C1[r+2],C1[r+3]);} \
      float rm=__builtin_fmaxf(a,b); { auto rr=__builtin_amdgcn_permlane32_swap(__float_as_uint(rm),__float_as_uint(rm),false,false); rm=__builtin_fmaxf(__uint_as_float(rr[0]),__uint_as_float(rr[1])); } \
      resc=false; \
      if(__builtin_expect(__any(rm>(float)THRL),0)){ const float dl=__builtin_fmaxf(rm,0.f); mhat+=dl; \
        _Pragma("unroll") for(int r=0;r<16;++r){C0[r]-=dl;C1[r]-=dl;} \
        _Pragma("unroll") for(int r=0;r<16;++r)negm[r]=-mhat; asm volatile("":"+v"(negm)); \
        const float f=__builtin_amdgcn_exp2f(-dl); l_reg*=f; if(hi==0)wsf[r32]=f; resc=true; } } \
    SBAR(); \
    GAPB(o[0]=__builtin_amdgcn_mfma_f32_32x32x16_bf16(PAF(0),VFR(0),o[0],0,0,0), C0,0); \
    GAPB(o[1]=__builtin_amdgcn_mfma_f32_32x32x16_bf16(PAF(0),VFR(4),o[1],0,0,0), C0,4); \
    KRD(GL,0); GAPB(o[0]=__builtin_amdgcn_mfma_f32_32x32x16_bf16(PAF(1),VFR(1),o[0],0,0,0), C0,8); \
    KRD(GL,1); GAPB(o[1]=__builtin_amdgcn_mfma_f32_32x32x16_bf16(PAF(1),VFR(5),o[1],0,0,0), C0,12); \
    KRD(GL,2); GAPB(o[0]=__builtin_amdgcn_mfma_f32_32x32x16_bf16(PAF(2),VFR(2),o[0],0,0,0), C1,0); \
    KRD(GL,3); GAPB(o[1]=__builtin_amdgcn_mfma_f32_32x32x16_bf16(PAF(2),VFR(6),o[1],0,0,0), C1,4); \
    GAPB(o[0]=__builtin_amdgcn_mfma_f32_32x32x16_bf16(PAF(3),VFR(3),o[0],0,0,0), C1,8); \
    GAPB(o[1]=__builtin_amdgcn_mfma_f32_32x32x16_bf16(PAF(3),VFR(7),o[1],0,0,0), C1,12); \
    }while(0)
  int t=1;
  for(;t+5<NT;t+=2){
    STEP(pB0,pB1,pA0,pA1,t,true,true,true);     WAIT_BAR(2); RESC(); ROT();
    STEP(pA0,pA1,pB0,pB1,t+1,true,true,true);   WAIT_BAR(2); RESC(); ROT();
  }
  #define ENDW(tt) do{ if((tt)+3<NT){WAIT_BAR(2);} else if((tt)+2<NT){WAIT_BAR(1);} else {WAIT_BAR(0);} }while(0)
  for(;t+1<NT;t+=2){
    STEP(pB0,pB1,pA0,pA1,t,(t+3<NT),(t+1<NT),(t+1<NT));       ENDW(t);   RESC(); ROT();
    STEP(pA0,pA1,pB0,pB1,t+1,(t+4<NT),(t+2<NT),(t+2<NT));     ENDW(t+1); RESC(); ROT();
  }
  STEP(pB0,pB1,pA0,pA1,NT-1,false,false,false); RESC();
  { float sacc=pB0[0]+pB0[1]; _Pragma("unroll") for(int r=2;r<16;++r)sacc+=pB0[r]; _Pragma("unroll") for(int r=0;r<16;++r)sacc+=pB1[r]; l_reg+=sacc;
    pw0=(u32x4){PKW(pB0,0),PKW(pB0,2),PKW(pB0,4),PKW(pB0,6)};pw1=(u32x4){PKW(pB0,8),PKW(pB0,10),PKW(pB0,12),PKW(pB0,14)};pw2=(u32x4){PKW(pB1,0),PKW(pB1,2),PKW(pB1,4),PKW(pB1,6)};pw3=(u32x4){PKW(pB1,8),PKW(pB1,10),PKW(pB1,12),PKW(pB1,14)};
    SBAR(); pv(o,vb0+sl_cur,PAF(0),PAF(1),PAF(2),PAF(3)); }
  #undef PKW
  #undef PAF
  #undef VFR
  #undef PIN
  #undef MX3
  #undef GAPA
  #undef GAPB
  #undef EX
  #undef VRD
  #undef KRD
  #undef STEP
  #undef ENDW
  {auto rr=__builtin_amdgcn_permlane32_swap(__float_as_uint(l_reg),__float_as_uint(l_reg),false,false);l_reg=__uint_as_float(rr[0])+__uint_as_float(rr[1]);}
  if(hi==0)wsf[32+r32]=l_reg;asm volatile("s_waitcnt lgkmcnt(0)":::"memory");
  float rli[16];
  #pragma unroll
  for(int r=0;r<16;++r)rli[r]=__builtin_amdgcn_rcpf(wsf[32+crow(r,hi)]);
  bf16*Ow=Ou+(long)(wid*QBLK)*OP;
  { bf16*stg=(bf16*)(shm+LDS_OST)+wid*2048;
    #pragma unroll
    for(int r=0;r<16;++r){const int orow=crow(r,hi);
      #pragma unroll
      for(int d0=0;d0<2;++d0)stg[orow*64+d0*32+r32]=__float2bfloat16(o[d0][r]*rli[r]);}
    asm volatile("s_waitcnt lgkmcnt(0)":::"memory");
    #pragma unroll
    for(int i=0;i<4;++i){const int row=i*8+(lane>>3),ch=lane&7; const u32x4 v=*(const u32x4*)(stg+row*64+ch*8); ATTN_STORE16(Ow+(long)row*OP+ch*8,v);} }
  asm volatile("s_waitcnt lgkmcnt(0)\n\ts_barrier":::"memory");
  #undef DMA_K
  #undef DMA_V
  #undef CMASK
  #undef START
  #undef RESC
  #undef ROT
}
constexpr int ATTN_LDS_BYTES=LDS_BYTES;
#undef SBAR
#undef WAIT_BAR
}
#define GAS __attribute__((address_space(1)))
#define LAS __attribute__((address_space(3)))
typedef unsigned short bf16;
typedef unsigned v4u __attribute__((ext_vector_type(4)));
typedef unsigned v2u __attribute__((ext_vector_type(2)));
typedef float f32x4 __attribute__((ext_vector_type(4)));
typedef short bf16x8 __attribute__((ext_vector_type(8)));
constexpr int NWAVES = 8, NTHREADS = 512;
constexpr int RING_BYTES = 131072, LDS_BYTES = 147456;
#define LDS_WAIT() asm volatile("s_waitcnt lgkmcnt(0)" ::: "memory")
#define VM_WAIT() asm volatile("s_waitcnt vmcnt(0)" ::: "memory")
__device__ __forceinline__ unsigned f2bf(float f) { unsigned u = __builtin_bit_cast(unsigned, f); return (u + 0x7fffu + ((u >> 16) & 1u)) >> 16; }
__device__ __forceinline__ unsigned pk2(float lo, float hi) { return f2bf(lo) | (f2bf(hi) << 16); }
__device__ __forceinline__ float bf2f(unsigned short b) { return __builtin_bit_cast(float, ((unsigned)b) << 16); }
__device__ __forceinline__ float sigmoidf_(float x) { return 1.0f / (1.0f + __expf(-x)); }
__device__ __forceinline__ float siluf_(float x) { return x * sigmoidf_(x); }
__device__ __forceinline__ float wave_sum(float v) {
#pragma unroll
    for (int o = 1; o < 64; o <<= 1) v += __shfl_xor(v, o);
    return v;
}

constexpr size_t MiB = 1u << 20;
constexpr size_t WS_CTL = 0, WS_MOD = 1 * MiB;
constexpr size_t WS_WIN = 2 * MiB, WIN_BYTES = (size_t)PP * D * 2;
constexpr size_t WS_WOUT = WS_WIN + 2 * WIN_BYTES, WOUT_BYTES = (size_t)D * D * 2;
constexpr size_t WS_WUP = WS_WOUT + 2 * WOUT_BYTES, WUP_BYTES = (size_t)DFF * D * 2;
constexpr size_t WS_WDN = WS_WUP + 2 * WUP_BYTES, WDN_BYTES = (size_t)D * DFF * 2;
constexpr size_t WS_WPW = WS_WDN + 2 * WDN_BYTES, WPW_BYTES = (size_t)256 * 256 * 2;
static_assert(WS_WPW + 2 * WPW_BYTES <= 50 * MiB, "weights");
constexpr size_t WS_XC = 50 * MiB;
constexpr size_t WS_ACT = 54 * MiB;
constexpr size_t WS_P = 88 * MiB;
constexpr size_t WS_H = 88 * MiB;
constexpr size_t WS_QA = 182 * MiB;
constexpr size_t WS_KA = 191 * MiB, WS_VA = 196 * MiB;
constexpr size_t WS_KV = 201 * MiB;
constexpr size_t WS_DEC = 235 * MiB;
constexpr size_t WS_END = 256 * MiB;
static_assert(WS_P + (size_t)M * PP * 2 <= WS_QA && WS_H + (size_t)M * DFF * 2 <= WS_END && WS_ACT + (size_t)M * D * 2 <= WS_P, "ws map");

struct Args { const float* in[27]; float* out; unsigned char* ws; int ph_lo, ph_hi, layer, pad; };

template <class Map> __device__ __forceinline__ void transpose_item(const float* W, int K, int N, bf16* WT, LAS float* scr, int kb, int nb, int lane, Map srcc) {
    const int k0 = 64 * kb, n0 = 32 * nb; const int sc = srcc(n0 + (lane & 31));
#pragma unroll 8
    for (int i = 0; i < 32; ++i) { const int kk = 2 * i + (lane >> 5); scr[kk * 33 + (lane & 31)] = sc >= 0 ? W[(size_t)(k0 + kk) * N + sc] : 0.f; }
    LDS_WAIT(); asm volatile("" ::: "memory");
    const int c = lane & 7;
#pragma unroll
    for (int j = 0; j < 4; ++j) { const int n = (lane >> 3) + 8 * j; const LAS float* s = scr + (8 * c) * 33 + n;
        v4u o; o.x = pk2(s[0 * 33], s[1 * 33]); o.y = pk2(s[2 * 33], s[3 * 33]); o.z = pk2(s[4 * 33], s[5 * 33]); o.w = pk2(s[6 * 33], s[7 * 33]);
        *(GAS v4u*)(WT + (size_t)(n0 + n) * K + k0 + 8 * c) = o; }
    LDS_WAIT(); asm volatile("" ::: "memory");
}
struct MapId { __device__ __forceinline__ int operator()(int n) const { return n; } };
struct MapWin { __device__ __forceinline__ int operator()(int n) const { return n < 1280 ? n : (n < 2560 ? n + 16 : (n < 2576 ? n - 1280 : -1)); } };

__device__ __forceinline__ void ph_prologue(const Args& a, LAS unsigned char* lds, int tid, int lane, int wave, int bid, int G) {
    unsigned char* ws = a.ws;
    LAS float* scr = (LAS float*)(lds + wave * 16384);
    const int gw = bid * NWAVES + wave, NGW = G * NWAVES;
    constexpr int I_IN = (D / 64) * (PP / 32), I_OUT = (D / 64) * (D / 32), I_UP = (D / 64) * (DFF / 32), I_DN = (DFF / 64) * (D / 32), I_PW = (256 / 64) * (256 / 32);
    constexpr int I_L = I_IN + I_OUT + I_UP + I_DN + I_PW;
    for (int it = gw; it < DEPTH * I_L; it += NGW) {
        const int l = it / I_L; int r = it % I_L;
        if (r < I_IN) { transpose_item(a.in[8] + (size_t)l * D * PIN, D, PIN, (bf16*)(ws + WS_WIN + l * WIN_BYTES), scr, r / (PP / 32), r % (PP / 32), lane, MapWin()); continue; } r -= I_IN;
        if (r < I_OUT) { transpose_item(a.in[23] + (size_t)l * D * D, D, D, (bf16*)(ws + WS_WOUT + l * WOUT_BYTES), scr, r / (D / 32), r % (D / 32), lane, MapId()); continue; } r -= I_OUT;
        if (r < I_UP) { transpose_item(a.in[24] + (size_t)l * D * DFF, D, DFF, (bf16*)(ws + WS_WUP + l * WUP_BYTES), scr, r / (DFF / 32), r % (DFF / 32), lane, MapId()); continue; } r -= I_UP;
        if (r < I_DN) { transpose_item(a.in[25] + (size_t)l * DFF * D, DFF, D, (bf16*)(ws + WS_WDN + l * WDN_BYTES), scr, r / (D / 32), r % (D / 32), lane, MapId()); continue; } r -= I_DN;
        transpose_item(a.in[13] + (size_t)l * 256 * 256, 256, 256, (bf16*)(ws + WS_WPW + l * WPW_BYTES), scr, r / 8, r % 8, lane, MapId());
    }
    __syncthreads();
    LAS float* sil = (LAS float*)lds;
    LAS float* part = (LAS float*)(lds + NS * D * 4);
    float* MOD = (float*)(ws + WS_MOD);
    const float* c = a.in[1]; const float* cc = a.in[3]; const float* w_mod = a.in[4]; const float* b_mod = a.in[5];
    bool staged = false;
    for (int task = bid; task < DEPTH * (NMOD / 64); task += G) {
        if (!staged) { for (int i = tid; i < NS * D; i += NTHREADS) { const int s = i / D, k = i % D; const float v = s < NB ? c[s * D + k] : cc[k]; sil[i] = siluf_(v); } staged = true; __syncthreads(); }
        const int l = task / (NMOD / 64), c0 = (task % (NMOD / 64)) * 64;
        float acc[NS];
#pragma unroll
        for (int s = 0; s < NS; ++s) acc[s] = 0.f;
        const float* wp = w_mod + (size_t)l * D * NMOD + (size_t)(wave * 128) * NMOD + c0 + lane;
#pragma unroll 4
        for (int k = 0; k < 128; ++k) { const float wv = wp[(size_t)k * NMOD];
#pragma unroll
            for (int s = 0; s < NS; ++s) acc[s] += sil[s * D + wave * 128 + k] * wv; }
#pragma unroll
        for (int s = 0; s < NS; ++s) part[(wave * NS + s) * 64 + lane] = acc[s];
        __syncthreads();
        if (tid < NS * 64) { const int s = tid / 64, ln = tid % 64; float v = 0.f;
#pragma unroll
            for (int w = 0; w < 8; ++w) v += part[(w * NS + s) * 64 + ln];
            MOD[((size_t)l * NS + s) * NMOD + c0 + ln] = v + b_mod[(size_t)l * NMOD + c0 + ln]; }
        __syncthreads();
    }
}
__device__ __forceinline__ void ph_normmod(const float* xl, const float* xc, const float* g, const float* mod, int i_shift, int i_scale, bf16* XN, int nrows, int lane, int gw, int NGW) {
    for (int r = gw; r < nrows; r += NGW) {
        const float* xr = r < ML ? xl + (size_t)r * D : xc + (size_t)(r - ML) * D;
        const float* m = mod + (size_t)(r < ML ? r / SEQ : NB) * NMOD;
        f32x4 v[4]; float s = 0.f;
#pragma unroll
        for (int j = 0; j < 4; ++j) { v[j] = *(const f32x4*)(xr + 4 * lane + 256 * j); s += (v[j].x * v[j].x + v[j].y * v[j].y) + (v[j].z * v[j].z + v[j].w * v[j].w); }
        const float rs = 1.0f / sqrtf(wave_sum(s) * (1.0f / D) + EPS);
#pragma unroll
        for (int j = 0; j < 4; ++j) { const int c0 = 4 * lane + 256 * j;
            const f32x4 gg = *(const f32x4*)(g + c0), sc = *(const f32x4*)(m + i_scale * D + c0), sh = *(const f32x4*)(m + i_shift * D + c0);
            const f32x4 o = v[j] * rs * gg * (sc + 1.0f) + sh;
            v2u w; w.x = pk2(o.x, o.y); w.y = pk2(o.z, o.w); *(v2u*)(XN + (size_t)r * D + c0) = w; }
    }
}
__device__ __forceinline__ void ph_final(float* x, const float* g, int lane, int gw, int NGW) {
    for (int r = gw; r < ML; r += NGW) {
        float* xr = x + (size_t)r * D;
        f32x4 v[4]; float s = 0.f;
#pragma unroll
        for (int j = 0; j < 4; ++j) { v[j] = *(const f32x4*)(xr + 4 * lane + 256 * j); s += (v[j].x * v[j].x + v[j].y * v[j].y) + (v[j].z * v[j].z + v[j].w * v[j].w); }
        const float rs = 1.0f / sqrtf(wave_sum(s) * (1.0f / D) + EPS);
#pragma unroll
        for (int j = 0; j < 4; ++j) { const int c0 = 4 * lane + 256 * j; *(f32x4*)(xr + c0) = v[j] * rs * *(const f32x4*)(g + c0); }
    }
}
__device__ __forceinline__ void ph_attprep(const bf16* P, const float* qg, const float* kg, bf16* QA, bf16* KA, bf16* VA, int lane, int gw, int NGW) {
    const float gq = qg[lane], gk = kg[lane];
    const int kk = lane & 31; const float inv = exp2f(-(float)(kk & 15) * (13.287712379549449f / 16.0f));
    for (int r = gw; r < M; r += NGW) {
        const bool lat = r < ML; const int b = lat ? r / SEQ : (r - ML) / CTX, t = lat ? r % SEQ : (r - ML) % CTX;
        const bf16* pr = P + (size_t)r * PP;
        float cs = 1.f, sn = 0.f;
        if (lat) { const float ang = (float)(kk < 16 ? t / GRIDW : t % GRIDW) * inv; sincosf(ang, &sn, &cs); }
        const float sgn = lane < 32 ? -1.f : 1.f;
        const size_t krow = (size_t)b * KEYS + (lat ? CTX + t : t);
#pragma unroll
        for (int h = 0; h < 6; ++h) {
            const float x = bf2f(pr[(h < 4 ? OFF_AQ + h * 64 : OFF_AK + (h - 4) * 64) + lane]);
            const float rs = 1.0f / sqrtf(wave_sum(x * x) * (1.0f / 64) + EPS);
            const float v = x * rs * (h < 4 ? gq : gk);
            const float o = v * cs + sgn * __shfl_xor(v, 32) * sn;
            if (h < 4) QA[(size_t)r * 256 + h * 64 + lane] = (bf16)f2bf(o * (0.125f * 1.4426950408889634f));
            else KA[krow * 128 + (h - 4) * 64 + lane] = (bf16)f2bf(o);
        }
        VA[krow * 128 + lane] = pr[OFF_AV + lane]; VA[krow * 128 + 64 + lane] = pr[OFF_AV + 64 + lane];
    }
}
__device__ __forceinline__ void ph_attention(const bf16* QA, const bf16* KA, const bf16* VA, bf16* Y, bool need_ctx, char* lds, int bid, int G) {
    const int vcu = (G % 8 == 0) ? (bid % 8) * (G / 8) + bid / 8 : bid;
    const int NU = 256 + (need_ctx ? 16 : 0);
    for (int u = vcu; u < NU; u += G) {
        if (u < 256) { const int b = u >> 6, h = (u >> 4) & 3, qb = u & 15; const size_t row = (size_t)b * SEQ + qb * 256;
            attn_body::attn_unit<8>((const attn_body::bf16*)(QA + row * 256 + h * 64), (const attn_body::bf16*)(KA + (size_t)b * KEYS * 128 + (h >> 1) * 64), (const attn_body::bf16*)(VA + (size_t)b * KEYS * 128 + (h >> 1) * 64),
                                    (attn_body::bf16*)(Y + row * D + 512 + h * 64), KEYS / 64, lds); }
        else { const int b = (u - 256) >> 2, h = (u - 256) & 3; const size_t row = (size_t)ML + b * CTX;
            attn_body::attn_unit<8>((const attn_body::bf16*)(QA + row * 256 + h * 64), (const attn_body::bf16*)(KA + (size_t)b * KEYS * 128 + (h >> 1) * 64), (const attn_body::bf16*)(VA + (size_t)b * KEYS * 128 + (h >> 1) * 64),
                                    (attn_body::bf16*)(Y + row * D + 512 + h * 64), CTX / 64, lds); }
    }
}
typedef unsigned short act_t;
__device__ __forceinline__ float ldA(const act_t* p) { return __uint_as_float(((unsigned)*p) << 16); }
__device__ __forceinline__ void stA(act_t* p, float v) { *p = (act_t)f2bf(v); }
#define LAUNCH(k, n, ...) do { const long n_ = (long)(n); const int nb_ = (int)((n_ + 255) / 256); hipLaunchKernelGGL(k, dim3(nb_), dim3(256), 0, stream, __VA_ARGS__); } while (0)
#define GID ((long)blockIdx.x * blockDim.x + threadIdx.x)

__device__ __forceinline__ int row_slot(int r) { return r < ML ? r / SEQ : NB; }

struct GemmArgs {
    const act_t* A; int lda; const float* W; int ldw; int K; int N; int nrows;
    act_t* C; int ldc; const float* bias;
    const float* xin_l; const float* xin_c; float* xout_l; float* xout_c; const float* gate;
};
template <int MODE> __global__ void __launch_bounds__(256) k_gemm(GemmArgs a) {
    const long i = GID; const long total = (long)(a.nrows / 8) * a.N; if (i >= total) return;
    const int rg = (int)(i / a.N), n = (int)(i % a.N), r0 = rg * 8;
    float acc[8];
#pragma unroll
    for (int j = 0; j < 8; ++j) acc[j] = 0.f;
    const act_t* Ap = a.A + (size_t)r0 * a.lda;
    const float* Wp = a.W + n;
    for (int k = 0; k < a.K; ++k) {
        const float w = Wp[(size_t)k * a.ldw];
#pragma unroll
        for (int j = 0; j < 8; ++j) acc[j] += ldA(Ap + (size_t)j * a.lda + k) * w;
    }
#pragma unroll
    for (int j = 0; j < 8; ++j) {
        const int r = r0 + j;
        if (MODE == 0) stA(a.C + (size_t)r * a.ldc + n, acc[j] + (a.bias ? a.bias[n] : 0.f));
        else if (MODE == 1) { const float v = acc[j] > 0.f ? acc[j] : 0.f; stA(a.C + (size_t)r * a.ldc + n, v * v); }
        else {
            const float gte = a.gate[(size_t)row_slot(r) * NMOD + n];
            if (r < ML) a.xout_l[(size_t)r * D + n] = a.xin_l[(size_t)r * D + n] + gte * acc[j];
            else a.xout_c[(size_t)(r - ML) * D + n] = a.xin_c[(size_t)(r - ML) * D + n] + gte * acc[j];
        }
    }
}
__global__ void __launch_bounds__(256) k_conv_dw(const act_t* P, const float* w_dw  , const float* b_dw, float* CY, int nrows) {
    const long i = GID; if (i >= (long)nrows * 256) return;
    const int r = (int)(i / 256), ch = (int)(i % 256);
    int base, t, T;
    if (r < ML) { base = (r / SEQ) * SEQ; t = r % SEQ; T = SEQ; } else { const int rc = r - ML; base = ML + (rc / CTX) * CTX; t = rc % CTX; T = CTX; }
    float acc = b_dw[ch];
    for (int j = 0; j < 31; ++j) {
        const int tt = t - 15 + j;
        if (tt >= 0 && tt < T) {
            const act_t* p = P + (size_t)(base + tt) * PP;
            acc += ldA(p + OFF_CA + ch) * sigmoidf_(ldA(p + OFF_CG + ch)) * w_dw[j * 256 + ch];
        }
    }
    CY[i] = acc;
}
__global__ void __launch_bounds__(256) k_conv_ln(const float* CY, const float* ln_g, const float* ln_b, act_t* CZ, int nrows) {
    const long i = GID; if (i >= (long)nrows * 256) return;
    const int r = (int)(i / 256), ch = (int)(i % 256);
    const float* p = CY + (size_t)r * 256;
    float mu = 0.f; for (int k = 0; k < 256; ++k) mu += p[k]; mu *= (1.0f / 256);
    float var = 0.f; for (int k = 0; k < 256; ++k) { const float d = p[k] - mu; var += d * d; } var *= (1.0f / 256);
    const float y = (p[ch] - mu) * rsqrtf(var + EPS) * ln_g[ch] + ln_b[ch];
    stA(CZ + i, siluf_(y));
}
__global__ void __launch_bounds__(256) k_gla_gates(const act_t* P, const float* w_f, const float* b_f, const float* w_b, const float* b_b, act_t* LAF, act_t* LAB) {
    const long i = GID; if (i >= (long)M * 256) return;
    const int r = (int)(i / 256), dir = (int)((i / 128) & 1), hd = (int)(i % 128);
    const float* w = dir ? w_b : w_f; const float* b = dir ? b_b : b_f;
    float pre = b[hd];
    for (int j = 0; j < 16; ++j) pre += ldA(P + (size_t)r * PP + OFF_Z + j) * w[j * 128 + hd];
    const float ls = fminf(pre, 0.f) - log1pf(expf(-fabsf(pre)));
    stA((dir ? LAB : LAF) + (size_t)r * 128 + hd, ls * (1.0f / 16.0f));
}
__global__ void __launch_bounds__(256) k_ret_prep(const act_t* P, act_t* RQ, act_t* RK) {
    const long i = GID; if (i >= (long)M * 8) return;
    const int r = (int)(i / 8), h = (int)((i / 2) % 4), which = (int)(i & 1);
    const act_t* src = P + (size_t)r * PP + (which ? OFF_RK : OFF_RQ) + h * 32;
    act_t* dst = (which ? RK : RQ) + (size_t)r * 128 + h * 32;
    const float sc = which ? 0.17677669529663687f : 1.0f;
    const bool lat = r < ML; const int t = lat ? r % SEQ : 0;
    const float rid = (float)(t / GRIDW), cid = (float)(t % GRIDW);
    for (int k = 0; k < 16; ++k) {
        const float x1 = ldA(src + k) * sc, x2 = ldA(src + k + 16) * sc;
        float c = 1.f, s = 0.f;
        if (lat) { const float inv = powf(10000.0f, -(float)(k & 7) / 8.0f); const float ang = (k < 8 ? rid : cid) * inv; c = cosf(ang); s = sinf(ang); }
        stA(dst + k, x1 * c - x2 * s); stA(dst + k + 16, x2 * c + x1 * s);
    }
}
__global__ void __launch_bounds__(256) k_scan(const act_t* P, const act_t* LAF, const act_t* LAB, const act_t* RQ, const act_t* RK, float* OG, float* OR, int dir) {
    const long i = GID; if (i >= (long)2 * NB * 4 * 64) return;
    const int e = (int)(i % 64), h = (int)((i / 64) % 4), b = (int)((i / 256) % NB), mixer = (int)(i / (256 * NB));
    float S[32];
#pragma unroll
    for (int d = 0; d < 32; ++d) S[d] = 0.f;
    const float gamma = 1.0f - exp2f(-5.0f - (float)h);
    float* O = mixer ? OR : OG;
    const act_t* LA = dir ? LAB : LAF;
    for (int step = 0; step < CTX + SEQ; ++step) {
        int r;
        if (step < CTX) r = ML + b * CTX + (dir ? CTX - 1 - step : step);
        else { const int t = step - CTX; r = b * SEQ + (dir ? SEQ - 1 - t : t); }
        const act_t* pr = P + (size_t)r * PP;
        const float v = ldA(pr + (mixer ? OFF_RV : OFF_GV) + h * 64 + e);
        float o = 0.f;
#pragma unroll
        for (int d = 0; d < 32; ++d) {
            float q, k, a;
            if (mixer == 0) { q = ldA(pr + OFF_GQ + h * 32 + d) * 0.17677669529663687f; k = ldA(pr + OFF_GK + h * 32 + d); a = expf(ldA(LA + (size_t)r * 128 + h * 32 + d)); }
            else { q = ldA(RQ + (size_t)r * 128 + h * 32 + d); k = ldA(RK + (size_t)r * 128 + h * 32 + d); a = gamma; }
            S[d] = a * S[d] + k * v;
            o += q * S[d];
        }
        float* op = O + (size_t)r * 256 + h * 64 + e;
        if (dir) *op += o; else *op = o;
    }
}
__global__ void __launch_bounds__(256) k_scan_out(const float* OG, const float* OR, const act_t* P, const float* gn_gla, const float* gn_ret, act_t* Y, int nrows) {
    const long i = GID; if (i >= (long)nrows * 8) return;
    const int r = (int)(i / 8), h = (int)((i / 2) % 4), mixer = (int)(i & 1);
    const float* o = (mixer ? OR : OG) + (size_t)r * 256 + h * 64;
    const float* g = (mixer ? gn_ret : gn_gla) + h * 64;
    const act_t* gate = P + (size_t)r * PP + (mixer ? OFF_RG : OFF_GR) + h * 64;
    float ss = 0.f; for (int e = 0; e < 64; ++e) ss += o[e] * o[e];
    const float rs = rsqrtf(ss * (1.0f / 64) + EPS);
    act_t* y = Y + (size_t)r * D + (mixer ? 768 : 256) + h * 64;
    for (int e = 0; e < 64; ++e) stA(y + e, o[e] * rs * g[e] * siluf_(ldA(gate + e)));
}

enum { PH_PROLOG = 0, PH_NORM1, PH_INPROJ, PH_ATTPREP, PH_ATT, PH_WOUT, PH_NORM2, PH_UP, PH_DOWN, PH_FINAL };
__global__ void __launch_bounds__(NTHREADS, 2) mk(Args a) {
    extern __shared__ __attribute__((aligned(16))) unsigned char lds_raw[];
    LAS unsigned char* lds = (LAS unsigned char*)lds_raw;
    const int tid = threadIdx.x, lane = tid & 63, wave = __builtin_amdgcn_readfirstlane(tid >> 6);
    const int bid = blockIdx.x, G = gridDim.x, gw = bid * NWAVES + wave, NGW = G * NWAVES;
    unsigned char* ws = a.ws;
    const int l = a.layer; const bool need_ctx = l < DEPTH - 1; const int nro = need_ctx ? M : ML;
    const float* mod = (const float*)(ws + WS_MOD) + (size_t)l * NS * NMOD;
    const float* xl = l == 0 ? a.in[0] : a.out; const float* xc = l == 0 ? a.in[2] : (const float*)(ws + WS_XC);
    float* XC = (float*)(ws + WS_XC);
    bf16* ACT = (bf16*)(ws + WS_ACT); bf16* P = (bf16*)(ws + WS_P); bf16* H = (bf16*)(ws + WS_H);
    const int lo = a.ph_lo, hi = a.ph_hi;
#define IN(k) (lo <= (k) && (k) < hi)
    if (IN(PH_PROLOG)) { ph_prologue(a, lds, tid, lane, wave, bid, G); }
    if (IN(PH_NORM1)) { ph_normmod(xl, xc, a.in[6] + l * D, mod, 0, 1, ACT, M, lane, gw, NGW); }
    if (IN(PH_INPROJ)) { { pg8::Gemm g{ACT, (const bf16*)(ws + WS_WIN + l * WIN_BYTES), M, PP, D}; pg8::StaticOrder S; S.init(M, PP, G, bid);
            pg8::EpiStore<0> E{P, PP}; pg8::gemm_phase<pg8::EpiStore<0>, pg8::StaticOrder, true, true>(lds, g, S, E); } }
    if (IN(PH_ATTPREP)) { ph_attprep(P, a.in[20] + l * 64, a.in[21] + l * 64, (bf16*)(ws + WS_QA), (bf16*)(ws + WS_KA), (bf16*)(ws + WS_VA), lane, gw, NGW); }
    if (IN(PH_ATT)) { ph_attention((const bf16*)(ws + WS_QA), (const bf16*)(ws + WS_KA), (const bf16*)(ws + WS_VA), ACT, need_ctx, (char*)lds_raw, bid, G); }
    if (IN(PH_WOUT)) { { pg8::Gemm g{ACT, (const bf16*)(ws + WS_WOUT + l * WOUT_BYTES), nro, D, D}; pg8::StaticOrder S; S.init(nro, D, G, bid);
            pg8::EpiResid E{xl, xc, a.out, XC, mod + 2 * D}; pg8::gemm_phase<pg8::EpiResid, pg8::StaticOrder, true, true>(lds, g, S, E); } }
    if (IN(PH_NORM2)) { ph_normmod(a.out, XC, a.in[7] + l * D, mod, 3, 4, ACT, nro, lane, gw, NGW); }
    if (IN(PH_UP)) { { pg8::Gemm g{ACT, (const bf16*)(ws + WS_WUP + l * WUP_BYTES), nro, DFF, D}; pg8::StaticOrder S; S.init(nro, DFF, G, bid);
            pg8::EpiStore<2> E{H, DFF}; pg8::gemm_phase<pg8::EpiStore<2>, pg8::StaticOrder, true, true>(lds, g, S, E); } }
    if (IN(PH_DOWN)) { { pg8::Gemm g{H, (const bf16*)(ws + WS_WDN + l * WDN_BYTES), nro, D, DFF}; pg8::StaticOrder S; S.init(nro, D, G, bid);
            pg8::EpiResid E{a.out, XC, a.out, XC, mod + 5 * D}; pg8::gemm_phase<pg8::EpiResid, pg8::StaticOrder, true, true>(lds, g, S, E); } }
    if (IN(PH_FINAL)) { ph_final(a.out, a.in[26], lane, gw, NGW); }
#undef IN
}
extern "C" void kernel_launch(void* const* d_in, const int* in_sizes, int n_in, void* d_out, int out_size, void* d_ws, size_t ws_size, hipStream_t stream) {
    static int grid = 0;
    if (grid == 0) {
        if (n_in != 27 || in_sizes[0] != ML * D || out_size != ML * D || ws_size < WS_END) { fprintf(stderr, "kernel_launch: unexpected shapes / workspace (n_in %d, ws %zu)\n", n_in, ws_size); grid = -1; return; }
        int dev = 0, cus = 0;
        if (hipGetDevice(&dev) != hipSuccess || hipDeviceGetAttribute(&cus, hipDeviceAttributeMultiprocessorCount, dev) != hipSuccess) { grid = -1; return; }
        if (hipFuncSetAttribute((const void*)mk, hipFuncAttributeMaxDynamicSharedMemorySize, LDS_BYTES) != hipSuccess) { fprintf(stderr, "kernel_launch: hipFuncSetAttribute failed\n"); grid = -1; return; }
        grid = cus;
    }
    if (grid < 0) return;
    Args a{};
    for (int i = 0; i < 27; ++i) a.in[i] = (const float*)d_in[i];
    a.out = (float*)d_out; a.ws = (unsigned char*)d_ws;
    auto run = [&](int ph, int l) { a.ph_lo = ph; a.ph_hi = ph + 1; a.layer = l; hipLaunchKernelGGL(mk, dim3(grid), dim3(NTHREADS), LDS_BYTES, stream, a); };
    char* ws = (char*)d_ws;
    const size_t NVB = 201 * MiB;
    act_t* Y = (act_t*)(ws + WS_ACT); act_t* P = (act_t*)(ws + WS_P);
    float* CY = (float*)(ws + NVB); act_t* CZ = (act_t*)(ws + NVB + 17 * MiB);
    act_t* LAF = (act_t*)(ws + NVB + 34 * MiB); act_t* LAB = (act_t*)(ws + NVB + 39 * MiB); act_t* RQ = (act_t*)(ws + NVB + 44 * MiB); act_t* RK = (act_t*)(ws + NVB + 49 * MiB);
    float* OG = CY; float* OR = (float*)(ws + NVB + 17 * MiB);
    const float* conv_w_dw = (const float*)d_in[9]; const float* conv_b_dw = (const float*)d_in[10]; const float* conv_ln_g = (const float*)d_in[11];
    const float* conv_ln_b = (const float*)d_in[12]; const float* conv_w_pw = (const float*)d_in[13]; const float* conv_b_pw = (const float*)d_in[14];
    const float* gla_w_a_f = (const float*)d_in[15]; const float* gla_b_a_f = (const float*)d_in[16]; const float* gla_w_a_b = (const float*)d_in[17]; const float* gla_b_a_b = (const float*)d_in[18];
    const float* gla_norm_g = (const float*)d_in[19]; const float* att_q_norm_g = (const float*)d_in[20]; const float* att_k_norm_g = (const float*)d_in[21]; const float* ret_norm_g = (const float*)d_in[22];
    run(PH_PROLOG, 0);
    for (int l = 0; l < DEPTH; ++l) {
        const bool need_ctx = l < DEPTH - 1; const int nro = need_ctx ? M : ML;
        run(PH_NORM1, l);
        run(PH_INPROJ, l);
        LAUNCH(k_conv_dw, (long)nro * 256, P, conv_w_dw + l * 31 * 256, conv_b_dw + l * 256, CY, nro);
        LAUNCH(k_conv_ln, (long)nro * 256, CY, conv_ln_g + l * 256, conv_ln_b + l * 256, CZ, nro);
        { GemmArgs g{}; g.A = CZ; g.lda = 256; g.W = conv_w_pw + (size_t)l * 256 * 256; g.ldw = 256; g.K = 256; g.N = 256; g.nrows = nro; g.C = Y; g.ldc = D; g.bias = conv_b_pw + l * 256;
          LAUNCH(k_gemm<0>, (long)(nro / 8) * 256, g); }
        LAUNCH(k_gla_gates, (long)M * 256, P, gla_w_a_f + l * 16 * 128, gla_b_a_f + l * 128, gla_w_a_b + l * 16 * 128, gla_b_a_b + l * 128, LAF, LAB);
        run(PH_ATTPREP, l);
        LAUNCH(k_ret_prep, (long)M * 8, P, RQ, RK);
        run(PH_ATT, l);
        LAUNCH(k_scan, (long)2 * NB * 4 * 64, P, LAF, LAB, RQ, RK, OG, OR, 0);
        LAUNCH(k_scan, (long)2 * NB * 4 * 64, P, LAF, LAB, RQ, RK, OG, OR, 1);
        LAUNCH(k_scan_out, (long)nro * 8, OG, OR, P, gla_norm_g + l * 256, ret_norm_g + l * 256, Y, nro);
        run(PH_WOUT, l); run(PH_NORM2, l); run(PH_UP, l); run(PH_DOWN, l);
    }
    run(PH_FINAL, 0);
}
```

```cpp
#include <hip/hip_runtime.h>
#include <hip/hip_cooperative_groups.h>
#include <cstdio>
#include <cstdint>
namespace cg = cooperative_groups;

constexpr int D = 1024, NB = 4, SEQ = 4096, CTX = 256, DFF = 4096, DEPTH = 2, GRIDW = 64;
constexpr int ML = NB * SEQ, MC = NB * CTX, M = ML + MC, NS = NB + 1, NMOD = 6 * D;
constexpr int PIN = 2576;
constexpr int PP = 2816;
constexpr int OFF_CA = 0, OFF_CG = 256, OFF_GQ = 512, OFF_GK = 640, OFF_GV = 768, OFF_GR = 1024, OFF_AQ = 1280, OFF_AK = 1536, OFF_AV = 1664,
              OFF_RQ = 1792, OFF_RK = 1920, OFF_RV = 2048, OFF_RG = 2304, OFF_Z = 2560;
constexpr float EPS = 1e-6f;
constexpr int KEYS = CTX + SEQ;
namespace pg8 {
#define PG8_LAS __attribute__((address_space(3)))
typedef unsigned short bf16_t;
typedef short bf16x8 __attribute__((ext_vector_type(8)));
typedef float f32x4 __attribute__((ext_vector_type(4)));
typedef unsigned u32x4 __attribute__((ext_vector_type(4)));
constexpr int BM = 256, BK = 64, HALF = 128, HTB = HALF * BK * 2  , STAGE_BYTES = 8 * HTB, NXCD = 8, WGM = 8;

__host__ __device__ __forceinline__ int lds_byte(int r, int c) { const int st = (r >> 4) * 2 + (c >> 5), rr = r & 15, cc = c & 31, ob = rr * 64 + cc * 2; return st * 1024 + (ob ^ (((ob >> 9) & 1) << 5)); }
__host__ __device__ __forceinline__ void stage_rc(int b, int& R, int& C) { const int st = b / 1024, sb = b % 1024, swz = sb ^ (((sb >> 9) & 1) << 5); R = (st >> 1) * 16 + swz / 64; C = (st & 1) * 32 + (swz % 64) / 2; }
__host__ __device__ __forceinline__ int perm32(int rho) { const int n = rho >> 4, i = rho & 15; return 8 * (i >> 2) + 4 * n + (i & 3); }

struct Unit { int pm, pn; };
struct Gemm { const bf16_t* A; const bf16_t* Bt; int M, N, K; };

struct StaticOrder {
    int nM, nN, nwg, G, c;
    __host__ __device__ void init(int M, int N, int G_, int c_) { nM = M / BM; nN = N / BM; nwg = nM * nN; G = G_; c = c_; }
    __host__ __device__ bool next(int i, Unit& u) const {
        const long L = (long)i * G + c; if (L >= nwg) return false;
        int wgid = (int)L; { const int q = nwg / NXCD, r = nwg % NXCD, xcd = wgid % NXCD, off = wgid / NXCD; wgid = (xcd < r ? xcd * (q + 1) : r * (q + 1) + (xcd - r) * q) + off; }
        const int nig = WGM * nN, gid = wgid / nig, fm = gid * WGM, gsz = (nM - fm) < WGM ? (nM - fm) : WGM;
        u.pm = fm + ((wgid % nig) % gsz); u.pn = (wgid % nig) / gsz; return true;
    }
    __device__ __forceinline__ void a_ready(const Unit&) const {}
    __device__ __forceinline__ void done(const Unit&) const {}
};

__device__ __forceinline__ unsigned cvt_pk_bf16(float lo, float hi) { unsigned r; asm volatile("v_cvt_pk_bf16_f32 %0, %1, %2" : "=v"(r) : "v"(lo), "v"(hi)); return r; }
typedef float f32x2 __attribute__((ext_vector_type(2)));
__device__ __forceinline__ f32x2 gelu_pk(f32x2 v) {
    const f32x2 av = __builtin_elementwise_abs(v), d = av * 0.2316418882f + 1.0f;
    f32x2 t; t.x = __builtin_amdgcn_rcpf(d.x); t.y = __builtin_amdgcn_rcpf(d.y);
    f32x2 q = t * 0.5307027145f + (-0.7265760135f); q = q * t + 0.7107068705f; q = q * t + (-0.142248368f); q = q * t + 0.127414796f; q = q * t;
    const f32x2 s = (v * v) * (-0.72134752044f);
    f32x2 e; e.x = __builtin_amdgcn_exp2f(s.x); e.y = __builtin_amdgcn_exp2f(s.y);
    const f32x2 m = v * (q * e), r = v - m;
    f32x2 o; o.x = v.x < 0.f ? m.x : r.x; o.y = v.y < 0.f ? m.y : r.y; return o;
}

template <int ACT  > struct EpiBf16 {
    static constexpr bool PERM = true, AFTER_DRAIN = false; static_assert(ACT == 0 || ACT == 1, "EpiBf16: ACT is 0 (none) or 1 (gelu_pk)");
    bf16_t* O; int ldc; const float* bias; int split_cols; size_t split_stride; float scale0;
    __device__ __forceinline__ void operator()(const f32x4 (&acc)[2][2][4][2], const Unit& u, int wr, int wc, int fr, int fq) const {
        const int row0 = u.pm * BM + wr * 64 + fr; int colt = u.pn * BM; bf16_t* base = O;
        float sc = 1.f; if (split_cols) { const int t = colt / split_cols; base += (size_t)t * split_stride; colt -= t * split_cols; if (t == 0) sc = scale0; }
        const int col0 = colt + wc * 32 + 8 * fq, bcol0 = u.pn * BM + wc * 32 + 8 * fq;
        f32x4 bv[2][2];
#pragma unroll
        for (int bj = 0; bj < 2; ++bj)
#pragma unroll
            for (int n = 0; n < 2; ++n) bv[bj][n] = bias ? *(const f32x4*)(bias + bcol0 + bj * HALF + 4 * n) : (f32x4){0.f, 0.f, 0.f, 0.f};
#pragma unroll
        for (int ai = 0; ai < 2; ++ai)
#pragma unroll
            for (int m = 0; m < 4; ++m) { bf16_t* rowp = base + (size_t)(row0 + ai * HALF + m * 16) * ldc + col0;
#pragma unroll
                for (int bj = 0; bj < 2; ++bj) { f32x4 v0 = acc[ai][bj][m][0] + bv[bj][0], v1 = acc[ai][bj][m][1] + bv[bj][1];
                    if (ACT == 1) { f32x2 a = gelu_pk((f32x2){v0[0], v0[1]}), b = gelu_pk((f32x2){v0[2], v0[3]}), c = gelu_pk((f32x2){v1[0], v1[1]}), d = gelu_pk((f32x2){v1[2], v1[3]});
                        v0 = (f32x4){a.x, a.y, b.x, b.y}; v1 = (f32x4){c.x, c.y, d.x, d.y}; }
                    v0 = v0 * sc; v1 = v1 * sc; u32x4 w; w.x = cvt_pk_bf16(v0[0], v0[1]); w.y = cvt_pk_bf16(v0[2], v0[3]); w.z = cvt_pk_bf16(v1[0], v1[1]); w.w = cvt_pk_bf16(v1[2], v1[3]);
                    *(u32x4*)(rowp + bj * HALF) = w; } }
    }
};

template <int ACT> struct EpiStore {
    static constexpr bool PERM = true, AFTER_DRAIN = false;
    bf16_t* O; int ldc;
    __device__ __forceinline__ void operator()(const f32x4 (&acc)[2][2][4][2], const Unit& u, int wr, int wc, int fr, int fq) const {
        const int row0 = u.pm * BM + wr * 64 + fr, col0 = u.pn * BM + wc * 32 + 8 * fq;
#pragma unroll
        for (int ai = 0; ai < 2; ++ai)
#pragma unroll
            for (int m = 0; m < 4; ++m) { bf16_t* rowp = O + (size_t)(row0 + ai * HALF + m * 16) * ldc + col0;
#pragma unroll
                for (int bj = 0; bj < 2; ++bj) { f32x4 v0 = acc[ai][bj][m][0], v1 = acc[ai][bj][m][1];
                    if (ACT == 2) {
#pragma unroll
                        for (int e = 0; e < 4; ++e) { const float a = v0[e] > 0.f ? v0[e] : 0.f, b = v1[e] > 0.f ? v1[e] : 0.f; v0[e] = a * a; v1[e] = b * b; } }
                    u32x4 w; w.x = cvt_pk_bf16(v0[0], v0[1]); w.y = cvt_pk_bf16(v0[2], v0[3]); w.z = cvt_pk_bf16(v1[0], v1[1]); w.w = cvt_pk_bf16(v1[2], v1[3]);
                    *(u32x4*)(rowp + bj * HALF) = w; } }
    }
};
struct EpiResid {
    static constexpr bool PERM = false, AFTER_DRAIN = false;
    const float* xin_l; const float* xin_c; float* xout_l; float* xout_c; const float* gate;
    __device__ __forceinline__ void operator()(const f32x4 (&acc)[2][2][4][2], const Unit& u, int wr, int wc, int fr, int fq) const {
        const int r0 = u.pm * BM; const bool lat = r0 < ML; const int slot = lat ? r0 / SEQ : NB;
        const float* xin = lat ? xin_l + (size_t)r0 * D : xin_c + (size_t)(r0 - ML) * D;
        float* xout = lat ? xout_l + (size_t)r0 * D : xout_c + (size_t)(r0 - ML) * D;
        const int col0 = wc * 32 + 4 * fq;
        const float* gp = gate + (size_t)slot * NMOD + u.pn * BM;
        xin += u.pn * BM; xout += u.pn * BM;
#pragma unroll
        for (int ai = 0; ai < 2; ++ai)
#pragma unroll
            for (int m = 0; m < 4; ++m) { const int off = (ai * HALF + wr * 64 + m * 16 + fr) * D + col0;
#pragma unroll
                for (int bj = 0; bj < 2; ++bj)
#pragma unroll
                    for (int n = 0; n < 2; ++n) { const f32x4 xi = *(const f32x4*)(xin + off + bj * HALF + n * 16); const f32x4 gv = *(const f32x4*)(gp + col0 + bj * HALF + n * 16);
                        *(f32x4*)(xout + off + bj * HALF + n * 16) = xi + gv * acc[ai][bj][m][n]; }
                asm volatile("" ::: "memory"); }
    }
};

template <class Epi, class Sched, bool ALIGN_EPI = false, bool SP2 = false>
__device__ __forceinline__ void gemm_phase(PG8_LAS unsigned char* lds, const Gemm g, const Sched& S, const Epi& E) {
    const int tid = threadIdx.x, wid = __builtin_amdgcn_readfirstlane(tid >> 6), lane = tid & 63, wr = wid >> 2, wc = wid & 3, fr = lane & 15, fq = lane >> 4;
    const int K = g.K, nt = K / BK;
    unsigned voffA[2], voffB[2];
#pragma unroll
    for (int i = 0; i < 2; ++i) { int R, C; stage_rc(tid * 16 + i * 8192, R, C); const int Rb = Epi::PERM ? ((R & ~31) + perm32(R & 31)) : R;
        voffA[i] = (unsigned)(R * K + C) * 2u; voffB[i] = (unsigned)(Rb * K + C) * 2u; }
    const size_t kstep = (size_t)(BK * 2);
    const size_t hstep = (size_t)HALF * K * 2;
    const size_t tstep = 2 * hstep;
    const unsigned ldsw = (unsigned)wid * 1024u;
    const int aoff = lds_byte(wr * 64 + fr, fq * 8), boff = lds_byte(wc * 32 + fr, fq * 8);
#define PG8_SA(b, h) (((b) * 2 + (h)) * HTB)
#define PG8_SB(b, h) ((4 + (b) * 2 + (h)) * HTB)
#define PG8_STAGE(bufoff, gbase, voff) do { _Pragma("unroll") for (int _i = 0; _i < 2; ++_i) \
        __builtin_amdgcn_global_load_lds((const unsigned*)((const char*)(gbase) + (voff)[_i]), (PG8_LAS unsigned*)(lds + (bufoff) + ldsw + _i * 8192), 16, 0, 0); } while (0)
#define PG8_LDA(dst, b, h) do { _Pragma("unroll") for (int m = 0; m < 4; ++m) _Pragma("unroll") for (int k = 0; k < 2; ++k) dst[m][k] = *(const PG8_LAS bf16x8*)(lds + PG8_SA(b, h) + aoff + m * 2048 + k * 1024); } while (0)
#define PG8_LDB(dst, b, h) do { _Pragma("unroll") for (int n = 0; n < 2; ++n) _Pragma("unroll") for (int k = 0; k < 2; ++k) dst[n][k] = *(const PG8_LAS bf16x8*)(lds + PG8_SB(b, h) + boff + n * 2048 + k * 1024); } while (0)
#define PG8_MMA(ai, bj, At, Bt) do { __builtin_amdgcn_s_setprio(1); _Pragma("unroll") for (int m = 0; m < 4; ++m) _Pragma("unroll") for (int n = 0; n < 2; ++n) _Pragma("unroll") for (int k = 0; k < 2; ++k) \
        acc[ai][bj][m][n] = __builtin_amdgcn_mfma_f32_16x16x32_bf16(Bt[n][k], At[m][k], acc[ai][bj][m][n], 0, 0, 0); __builtin_amdgcn_s_setprio(0); } while (0)
#define PG8_WAIT_V(n) asm volatile("s_waitcnt vmcnt(" #n ")" ::: "memory")
#define PG8_WAIT_L(n) asm volatile("s_waitcnt lgkmcnt(" #n ")" ::: "memory")
#define PG8_BAR __builtin_amdgcn_s_barrier()
#define PG8_SCHED __builtin_amdgcn_sched_barrier(0)
    Unit cur, nxt; int ui = 0;
    if (!S.next(0, cur)) return;
    f32x4 acc[2][2][4][2];
#pragma unroll
    for (int a = 0; a < 2; ++a)
#pragma unroll
        for (int b = 0; b < 2; ++b)
#pragma unroll
            for (int m = 0; m < 4; ++m)
#pragma unroll
                for (int n = 0; n < 2; ++n) acc[a][b][m][n] = (f32x4){0.f, 0.f, 0.f, 0.f};
    bf16x8 At[4][2], B0[2][2], B1[2][2];
    const char* cA = (const char*)g.A + (size_t)cur.pm * tstep; const char* cB = (const char*)g.Bt + (size_t)cur.pn * tstep;
    S.a_ready(cur);
    if constexpr (SP2) {
        PG8_STAGE(PG8_SB(0, 0), cB, voffB); PG8_STAGE(PG8_SB(0, 1), cB + hstep, voffB); PG8_STAGE(PG8_SA(0, 0), cA, voffA); PG8_STAGE(PG8_SA(0, 1), cA + hstep, voffA);
        if (wr == 1) PG8_BAR;
        PG8_WAIT_V(2); PG8_BAR;
        PG8_STAGE(PG8_SB(1, 0), cB + kstep, voffB); PG8_STAGE(PG8_SA(1, 0), cA + kstep, voffA); PG8_STAGE(PG8_SB(1, 1), cB + hstep + kstep, voffB);
        PG8_WAIT_V(6); PG8_BAR;
    } else {
        PG8_STAGE(PG8_SB(0, 0), cB, voffB); PG8_STAGE(PG8_SA(0, 0), cA, voffA); PG8_STAGE(PG8_SB(0, 1), cB + hstep, voffB); PG8_STAGE(PG8_SA(0, 1), cA + hstep, voffA);
        if (wr == 1) PG8_BAR;
        PG8_WAIT_V(4); PG8_BAR;
        PG8_STAGE(PG8_SB(1, 0), cB + kstep, voffB); PG8_STAGE(PG8_SA(1, 0), cA + kstep, voffA); PG8_STAGE(PG8_SB(1, 1), cB + hstep + kstep, voffB);
        PG8_WAIT_V(6); PG8_BAR;
    }
    for (;;) {
        const bool has_next = S.next(ui + 1, nxt);
        const char* nA = has_next ? (const char*)g.A + (size_t)nxt.pm * tstep : cA; const char* nB = has_next ? (const char*)g.Bt + (size_t)nxt.pn * tstep : cB;
        for (int t = 0; t < nt; t += 2) {
            const bool last = (t == nt - 2);
            const char* a1 = cA + (size_t)(t + 1) * kstep;
            const char* a2 = last ? nA : cA + (size_t)(t + 2) * kstep; const char* b2 = last ? nB : cB + (size_t)(t + 2) * kstep;
            const char* a3 = a2 + kstep; const char* b3 = b2 + kstep;
            if (last && has_next) S.a_ready(nxt);
            if constexpr (SP2) {
            PG8_LDB(B0, 0, 0); PG8_LDB(B1, 0, 1); PG8_SCHED; PG8_LDA(At, 0, 0); PG8_STAGE(PG8_SA(1, 1), a1 + hstep, voffA);
            PG8_WAIT_V(8); PG8_WAIT_L(0); PG8_BAR; PG8_MMA(0, 0, At, B0); PG8_MMA(0, 1, At, B1); PG8_BAR; PG8_SCHED;
            PG8_LDA(At, 0, 1); PG8_STAGE(PG8_SB(0, 0), b2, voffB); PG8_STAGE(PG8_SB(0, 1), b2 + hstep, voffB); PG8_STAGE(PG8_SA(0, 0), a2, voffA);
            PG8_WAIT_V(8); PG8_WAIT_L(0); PG8_BAR; PG8_MMA(1, 0, At, B0); PG8_MMA(1, 1, At, B1); PG8_BAR; PG8_SCHED;
            PG8_LDB(B0, 1, 0); PG8_LDB(B1, 1, 1); PG8_SCHED; PG8_LDA(At, 1, 0); PG8_STAGE(PG8_SA(0, 1), a2 + hstep, voffA);
            PG8_WAIT_V(8); PG8_WAIT_L(0); PG8_BAR; PG8_MMA(0, 0, At, B0); PG8_MMA(0, 1, At, B1); PG8_BAR; PG8_SCHED;
            PG8_LDA(At, 1, 1); PG8_STAGE(PG8_SB(1, 0), b3, voffB); PG8_STAGE(PG8_SB(1, 1), b3 + hstep, voffB); PG8_STAGE(PG8_SA(1, 0), a3, voffA);
            PG8_WAIT_V(8); PG8_WAIT_L(0); PG8_BAR; PG8_MMA(1, 0, At, B0); PG8_MMA(1, 1, At, B1); PG8_BAR; PG8_SCHED;
            } else {
            PG8_LDB(B0, 0, 0); PG8_SCHED; PG8_LDA(At, 0, 0); PG8_STAGE(PG8_SA(1, 1), a1 + hstep, voffA);
            PG8_WAIT_L(8); PG8_BAR; PG8_WAIT_L(0); PG8_MMA(0, 0, At, B0); PG8_BAR; PG8_SCHED;
            PG8_LDB(B1, 0, 1); PG8_STAGE(PG8_SB(0, 0), b2, voffB);
            PG8_BAR; PG8_WAIT_L(0); PG8_MMA(0, 1, At, B1); PG8_BAR;
            PG8_LDA(At, 0, 1); PG8_STAGE(PG8_SA(0, 0), a2, voffA);
            PG8_BAR; PG8_WAIT_L(0); PG8_MMA(1, 0, At, B0); PG8_BAR; PG8_SCHED;
            PG8_STAGE(PG8_SB(0, 1), b2 + hstep, voffB);
            PG8_WAIT_V(6); PG8_BAR; PG8_MMA(1, 1, At, B1); PG8_BAR;
            PG8_LDB(B0, 1, 0); PG8_SCHED; PG8_LDA(At, 1, 0); PG8_STAGE(PG8_SA(0, 1), a2 + hstep, voffA);
            PG8_WAIT_L(8); PG8_BAR; PG8_WAIT_L(0); PG8_MMA(0, 0, At, B0); PG8_BAR; PG8_SCHED;
            PG8_LDB(B1, 1, 1); PG8_STAGE(PG8_SB(1, 0), b3, voffB);
            PG8_BAR; PG8_WAIT_L(0); PG8_MMA(0, 1, At, B1); PG8_BAR;
            PG8_LDA(At, 1, 1); PG8_STAGE(PG8_SA(1, 0), a3, voffA);
            PG8_BAR; PG8_WAIT_L(0); PG8_MMA(1, 0, At, B0); PG8_BAR; PG8_SCHED;
            PG8_STAGE(PG8_SB(1, 1), b3 + hstep, voffB);
            PG8_WAIT_V(6); PG8_BAR; PG8_MMA(1, 1, At, B1); PG8_BAR;
            }
        }
        if constexpr (ALIGN_EPI) { if (wr == 0) PG8_BAR; }
        if constexpr (!Epi::AFTER_DRAIN) { E(acc, cur, wr, wc, fr, fq); S.done(cur); }
        if (!has_next) break;
#pragma unroll
        for (int a = 0; a < 2; ++a)
#pragma unroll
            for (int b = 0; b < 2; ++b)
#pragma unroll
                for (int m = 0; m < 4; ++m)
#pragma unroll
                    for (int n = 0; n < 2; ++n) acc[a][b][m][n] = (f32x4){0.f, 0.f, 0.f, 0.f};
        cur = nxt; cA = nA; cB = nB; ++ui;
        if constexpr (ALIGN_EPI) { if (wr == 1) PG8_BAR; }
    }
    PG8_WAIT_V(0);
    if constexpr (!ALIGN_EPI) { if (wr == 0) PG8_BAR; }
    PG8_BAR;
    if constexpr (Epi::AFTER_DRAIN) { E.fused(acc, cur, wr, wc, fr, fq, lds, wid, lane); S.done(cur); }
#undef PG8_SA
#undef PG8_SB
#undef PG8_STAGE
#undef PG8_LDA
#undef PG8_LDB
#undef PG8_MMA
#undef PG8_WAIT_V
#undef PG8_WAIT_L
#undef PG8_BAR
#undef PG8_SCHED
}
}
#include <hip/hip_bf16.h>
#include <cmath>
namespace attn_body {
using bf16=__hip_bfloat16;
using bf16x8=__attribute__((ext_vector_type(8)))short;
using s16x4=__attribute__((ext_vector_type(4)))short;
using f32x16=__attribute__((ext_vector_type(16)))float;
using u32x4=__attribute__((ext_vector_type(4)))unsigned;
constexpr int D=64;
constexpr int QP=256,KP=128,OP=1024;
constexpr int NW=8,QBLK=32,QB=QBLK*NW,KVBLK=64;
constexpr int ATTN_UNIT_ROWS=QB;
__device__ __forceinline__ int crow(int r,int hi){return (r&3)+8*(r>>2)+4*hi;}
#define SBAR() __builtin_amdgcn_sched_barrier(0)
__device__ __forceinline__ void cmask(f32x16&p0,f32x16&p1,int jb,int qrel,int hi){
  const float NEG=-INFINITY; int kb=64*jb+4*hi;
  #pragma unroll
  for(int r=0;r<16;++r){int kv=kb+(r&3)+8*(r>>2); if(kv>qrel)p0[r]=NEG; if(kv+32>qrel)p1[r]=NEG;}
}

constexpr int NSLOT=3, SLOTB=8192;
constexpr int LDS_K=0, LDS_V=NSLOT*SLOTB, LDS_WS=2*NSLOT*SLOTB, LDS_OST=LDS_WS+NW*64*4, LDS_BYTES=LDS_OST+NW*4096;
constexpr float C2=0.125f*1.4426950408889634f;
__device__ __forceinline__ void glds16(const void*gsrc,unsigned lds_dst){unsigned keep;
  asm volatile("s_mov_b32 %0, m0\n\ts_mov_b32 m0, %2\n\ts_nop 0\n\tglobal_load_lds_dwordx4 %1, off\n\ts_mov_b32 m0, %0":"=&s"(keep):"v"(gsrc),"s"(lds_dst):"memory");}
__device__ __forceinline__ float max3f(float a,float b,float c){float r;asm("v_max3_f32 %0, %1, %2, %3":"=v"(r):"v"(a),"v"(b),"v"(c));return r;}
__device__ __forceinline__ float max2f(float a,float b){float r;asm("v_max_f32_e32 %0, %1, %2":"=v"(r):"v"(a),"v"(b));return r;}
__device__ __forceinline__ float fadd_s(float a,float b){float r;asm("v_add_f32_e32 %0, %1, %2":"=v"(r):"v"(a),"v"(b));return r;}
__device__ __forceinline__ float fsub_s(float a,float b){float r;asm("v_sub_f32_e32 %0, %1, %2":"=v"(r):"v"(a),"v"(b));return r;}
typedef float f32x2_t __attribute__((ext_vector_type(2))); typedef __bf16 bf16x2_t __attribute__((ext_vector_type(2)));
__device__ __forceinline__ unsigned cvtpk_s(float lo,float hi){f32x2_t v={lo,hi};bf16x2_t b=__builtin_convertvector(v,bf16x2_t);return __builtin_bit_cast(unsigned,b);}
#define WAIT_BAR(N) asm volatile("s_waitcnt vmcnt(" #N ") lgkmcnt(0)\n\ts_barrier":::"memory")

__device__ __forceinline__ void qkt(f32x16&p0,f32x16&p1,const char*Kslot,const bf16x8*qr,const f32x16&negm,int r32,int hi){
  const char*kb=Kslot+hi*1024+r32*16;
  #pragma unroll
  for(int d0=0;d0<4;++d0){
    const bf16x8 b0=*reinterpret_cast<const bf16x8*>(kb+d0*2048);
    const bf16x8 b1=*reinterpret_cast<const bf16x8*>(kb+d0*2048+512);
    if(d0==0){p0=__builtin_amdgcn_mfma_f32_32x32x16_bf16(b0,qr[0],negm,0,0,0);p1=__builtin_amdgcn_mfma_f32_32x32x16_bf16(b1,qr[0],negm,0,0,0);}
    else{p0=__builtin_amdgcn_mfma_f32_32x32x16_bf16(b0,qr[d0],p0,0,0,0);p1=__builtin_amdgcn_mfma_f32_32x32x16_bf16(b1,qr[d0],p1,0,0,0);}}
}
typedef __attribute__((address_space(3))) const char* lds_cptr;
typedef short v4i16_t __attribute__((ext_vector_type(4)));
__device__ __forceinline__ void kload8(bf16x8*kf,lds_cptr kp){
  kf[0]=*(const __attribute__((address_space(3))) bf16x8*)(kp);      kf[1]=*(const __attribute__((address_space(3))) bf16x8*)(kp+512);
  kf[2]=*(const __attribute__((address_space(3))) bf16x8*)(kp+2048); kf[3]=*(const __attribute__((address_space(3))) bf16x8*)(kp+2560);
  kf[4]=*(const __attribute__((address_space(3))) bf16x8*)(kp+4096); kf[5]=*(const __attribute__((address_space(3))) bf16x8*)(kp+4608);
  kf[6]=*(const __attribute__((address_space(3))) bf16x8*)(kp+6144); kf[7]=*(const __attribute__((address_space(3))) bf16x8*)(kp+6656);
}
__device__ __forceinline__ void kload2(bf16x8*kf,lds_cptr kp,int j){ kf[2*j]=*(const __attribute__((address_space(3))) bf16x8*)(kp+j*2048); kf[2*j+1]=*(const __attribute__((address_space(3))) bf16x8*)(kp+j*2048+512); }
__device__ __forceinline__ s16x4 vtr(lds_cptr p){ return __builtin_bit_cast(s16x4,__builtin_amdgcn_ds_read_tr16_b64_v4i16((__attribute__((address_space(3))) v4i16_t*)p)); }
__device__ __forceinline__ float rowmax(const f32x16&p0,const f32x16&p1){
  float a=max3f(p0[0],p0[1],p1[0]),b=max3f(p0[2],p0[3],p1[1]);a=max3f(a,p1[2],p1[3]);
  #pragma unroll
  for(int r=4;r<16;r+=4){a=max3f(a,p0[r],p0[r+1]);b=max3f(b,p0[r+2],p0[r+3]);a=max3f(a,p1[r],p1[r+1]);b=max3f(b,p1[r+2],p1[r+3]);}
  const float m=max2f(a,b);
  auto rr=__builtin_amdgcn_permlane32_swap(__float_as_uint(m),__float_as_uint(m),false,false);
  return max2f(__uint_as_float(rr[0]),__uint_as_float(rr[1]));
}
__device__ __forceinline__ void pv(f32x16*o,int vb,bf16x8 pa0,bf16x8 pa1,bf16x8 pa2,bf16x8 pa3){
  #pragma unroll
  for(int d0=0;d0<2;++d0){s16x4 lo[4],hi[4];
    #pragma unroll
    for(int ks=0;ks<4;++ks){
      asm volatile("ds_read_b64_tr_b16 %0,%1 offset:%c2":"=&v"(lo[ks]):"v"(vb),"i"(d0*4096+ks*1024):"memory");
      asm volatile("ds_read_b64_tr_b16 %0,%1 offset:%c2":"=&v"(hi[ks]):"v"(vb),"i"(d0*4096+ks*1024+512):"memory");}
    asm volatile("s_waitcnt lgkmcnt(0)":::"memory");SBAR();
    #define PK(k) (bf16x8){lo[k][0],lo[k][1],lo[k][2],lo[k][3],hi[k][0],hi[k][1],hi[k][2],hi[k][3]}
    o[d0]=__builtin_amdgcn_mfma_f32_32x32x16_bf16(pa0,PK(0),o[d0],0,0,0);
    o[d0]=__builtin_amdgcn_mfma_f32_32x32x16_bf16(pa1,PK(1),o[d0],0,0,0);
    o[d0]=__builtin_amdgcn_mfma_f32_32x32x16_bf16(pa2,PK(2),o[d0],0,0,0);
    o[d0]=__builtin_amdgcn_mfma_f32_32x32x16_bf16(pa3,PK(3),o[d0],0,0,0);
    #undef PK
  }
}

#ifndef ATTN_STORE16
#define ATTN_STORE16(p,v) (*(u32x4*)(p)=(v))
#endif
template<int THRL> __device__ __forceinline__ void attn_unit(const bf16*Qu,const bf16*__restrict__ Kh,const bf16*__restrict__ Vh,bf16*Ou,const int NT,char*shm){
  const int tid=threadIdx.x,lane=tid&63,r32=lane&31,hi=lane>>5; const int wid=__builtin_amdgcn_readfirstlane(tid>>6);
  const bf16*Qw=Qu+(long)(wid*QBLK)*QP;
  const unsigned lds0=(unsigned)(uintptr_t)shm;
  float*wsf=(float*)(shm+LDS_WS)+wid*64;
  const bf16*ksrc=Kh+(long)lane*KP+wid*8;
  const bf16*vsrc=Vh+(long)(16*(wid&3)+(lane>>2))*KP+(wid>>2)*32+(lane&3)*8;
  const unsigned kdst=lds0+LDS_K+wid*1024, vdst=lds0+LDS_V+wid*1024;
  #define DMA_K(t,slot) glds16(ksrc+(long)(t)*KVBLK*KP,(unsigned)__builtin_amdgcn_readfirstlane(kdst+(slot)))
  #define DMA_V(t,slot) glds16(vsrc+(long)(t)*KVBLK*KP,(unsigned)__builtin_amdgcn_readfirstlane(vdst+(slot)))
  const int vb0=(int)(lds0+LDS_V)+((lane>>4)&1)*32+(lane&3)*8+(4*hi+((lane&15)>>2))*64;
  const char*Kbase=shm+LDS_K; bf16x8 kf[8];
  const lds_cptr shm3=(lds_cptr)shm; const lds_cptr kp0=shm3+LDS_K+hi*1024+r32*16; const lds_cptr vp0=shm3+LDS_V+((lane>>4)&1)*32+(lane&3)*8+(4*hi+((lane&15)>>2))*64;
  DMA_K(0,0);DMA_V(0,0);DMA_K(1,SLOTB);
  bf16x8 qr[4];
  #pragma unroll
  for(int d0=0;d0<4;++d0)qr[d0]=*reinterpret_cast<const bf16x8*>(&Qw[(long)r32*QP+d0*16+hi*8]);
  float mhat=0.f,l_reg=0.f;f32x16 o[2];o[0]=f32x16{};o[1]=f32x16{};f32x16 negm=f32x16{};asm volatile("":"+v"(negm));
  #define CMASK(P0,P1,t) do{}while(0)
  bool resc=false;
  #define START(P0,P1) do{ const float rm=rowmax(P0,P1); resc=false; \
    { const float dl=rm; mhat=fadd_s(mhat,dl); \
      _Pragma("unroll") for(int r=0;r<16;++r){P0[r]=fsub_s(P0[r],dl);P1[r]=fsub_s(P1[r],dl);} \
      _Pragma("unroll") for(int r=0;r<16;++r)negm[r]=-mhat; asm volatile("":"+v"(negm)); } \
    _Pragma("unroll") for(int r=0;r<16;++r)P0[r]=__builtin_amdgcn_exp2f(P0[r]); }while(0)
  #define RESC() do{ if(resc){ asm volatile("s_waitcnt lgkmcnt(0)":::"memory"); \
      _Pragma("unroll") for(int d_=0;d_<2;++d_) _Pragma("unroll") for(int r=0;r<16;++r)o[d_][r]*=wsf[crow(r,hi)]; } }while(0)
  f32x16 pA0,pA1,pB0,pB1;
  int sl_prev=0,sl_cur=0,sl_next=SLOTB;
  #define ROT() do{sl_prev=sl_cur;sl_cur=sl_next;sl_next=(sl_next==(NSLOT-1)*SLOTB)?0:sl_next+SLOTB;}while(0)
  DMA_K(2,2*SLOTB);
  WAIT_BAR(3);
  qkt(pA0,pA1,Kbase,qr,negm,r32,hi);asm volatile("s_nop 15\n\ts_nop 7":"+v"(pA0),"+v"(pA1));CMASK(pA0,pA1,0);
  START(pA0,pA1);
  _Pragma("unroll") for(int r=0;r<16;++r)pA1[r]=__builtin_amdgcn_exp2f(pA1[r]);
  WAIT_BAR(0);
  DMA_K(3,0);DMA_V(1,SLOTB);
  ROT();
  kload8(kf,kp0+sl_cur);
  WAIT_BAR(2);
  s16x4 vlo[8],vhi[8]; u32x4 pw0,pw1,pw2,pw3;
  #define PKW(P,B) cvtpk_s(P[B],P[B+1])
  #define PAF(k) __builtin_bit_cast(bf16x8,pw##k)
  #define VFR(i) (bf16x8){vlo[i][0],vlo[i][1],vlo[i][2],vlo[i][3],vhi[i][0],vhi[i][1],vhi[i][2],vhi[i][3]}
  #define PIN(x) asm volatile("":"+v"(x))
  #define MX3(a,b,c) __builtin_fmaxf(__builtin_fmaxf((a),(b)),(c))
  #define GAPA(MF,A0,A1,A2,A3,W0,W1,PW) do{ MF; sacc+=A0; sacc+=A1; sacc+=A2; sacc+=A3; PIN(sacc); W0; W1; PIN(PW); SBAR(); }while(0)
  #define EX(v) __builtin_amdgcn_exp2f(v)
  #define GAPB(MF,X,B) do{ MF; X[B]=EX(X[B]); X[B+1]=EX(X[B+1]); X[B+2]=EX(X[B+2]); X[B+3]=EX(X[B+3]); PIN(X); SBAR(); }while(0)
  #define VRD(i) do{ vlo[i]=vtr(vp_+(((i)>>2)*4096+((i)&3)*1024)); vhi[i]=vtr(vp_+(((i)>>2)*4096+((i)&3)*1024+512)); }while(0)
  #define KRD(G,j) do{ if(G){ kload2(kf,kp0+sl_next,j); SBAR(); } }while(0)
  #define STEP(C0,C1,P0,P1,t,GK,GV,GL) do{ SBAR(); \
    const lds_cptr vp_=vp0+sl_prev; \
    VRD(0); SBAR(); float sacc=(P0[0]+P0[1]); \
    GAPA(C0=__builtin_amdgcn_mfma_f32_32x32x16_bf16(kf[0],qr[0],negm,0,0,0), P0[2],P0[3],P0[4],P0[5],     pw0[0]=PKW(P0,0), pw0[1]=PKW(P0,2), pw0); \
    VRD(4); SBAR(); GAPA(C1=__builtin_amdgcn_mfma_f32_32x32x16_bf16(kf[1],qr[0],negm,0,0,0), P0[6],P0[7],P0[8],P0[9],     pw0[2]=PKW(P0,4), pw0[3]=PKW(P0,6), pw0); \
    VRD(1); SBAR(); GAPA(C0=__builtin_amdgcn_mfma_f32_32x32x16_bf16(kf[2],qr[1],C0,0,0,0),   P0[10],P0[11],P0[12],P0[13], pw1[0]=PKW(P0,8), pw1[1]=PKW(P0,10), pw1); \
    VRD(5); SBAR(); GAPA(C1=__builtin_amdgcn_mfma_f32_32x32x16_bf16(kf[3],qr[1],C1,0,0,0),   P0[14],P0[15],P1[0],P1[1],   pw1[2]=PKW(P0,12),pw1[3]=PKW(P0,14), pw1); \
    VRD(2); SBAR(); GAPA(C0=__builtin_amdgcn_mfma_f32_32x32x16_bf16(kf[4],qr[2],C0,0,0,0),   P1[2],P1[3],P1[4],P1[5],     pw2[0]=PKW(P1,0), pw2[1]=PKW(P1,2), pw2); \
    VRD(6); SBAR(); GAPA(C1=__builtin_amdgcn_mfma_f32_32x32x16_bf16(kf[5],qr[2],C1,0,0,0),   P1[6],P1[7],P1[8],P1[9],     pw2[2]=PKW(P1,4), pw2[3]=PKW(P1,6), pw2); \
    VRD(3); SBAR(); GAPA(C0=__builtin_amdgcn_mfma_f32_32x32x16_bf16(kf[6],qr[3],C0,0,0,0),   P1[10],P1[11],P1[12],P1[13], pw3[0]=PKW(P1,8), pw3[1]=PKW(P1,10), pw3); \
    VRD(7); SBAR(); GAPA(C1=__builtin_amdgcn_mfma_f32_32x32x16_bf16(kf[7],qr[3],C1,0,0,0),   P1[14],P1[15],0.f,0.f,       pw3[2]=PKW(P1,12),pw3[3]=PKW(P1,14), pw3); \
    l_reg+=sacc; \
    if(GK){DMA_K((t)+3,sl_cur);} if(GV){DMA_V((t)+1,sl_next);} \
    CMASK(C0,C1,t); \
    { float a=MX3(C0[0],C0[1],C1[0]),b=MX3(C0[2],C0[3],C1[1]); a=MX3(a,C1[2],C1[3]); \
      _Pragma("unroll") for(int r=4;r<16;r+=4){a=MX3(a,C0[r],C0[r+1]);b=MX3(b,C0[r+2],C0[r+3]);a=MX3(a,C1[r],C1[r+1]);b=MX3(b,C1[r+2],C1[r+3]);} \
      float rm=__builtin_fmaxf(a,b); { auto rr=__builtin_amdgcn_permlane32_swap(__float_as_uint(rm),__float_as_uint(rm),false,false); rm=__builtin_fmaxf(__uint_as_float(rr[0]),__uint_as_float(rr[1])); } \
      resc=false; \
      if(__builtin_expect(__any(rm>(float)THRL),0)){ const float dl=__builtin_fmaxf(rm,0.f); mhat+=dl; \
        _Pragma("unroll") for(int r=0;r<16;++r){C0[r]-=dl;C1[r]-=dl;} \
        _Pragma("unroll") for(int r=0;r<16;++r)negm[r]=-mhat; asm volatile("":"+v"(negm)); \
        const float f=__builtin_amdgcn_exp2f(-dl); l_reg*=f; if(hi==0)wsf[r32]=f; resc=true; } } \
    SBAR(); \
    GAPB(o[0]=__builtin_amdgcn_mfma_f32_32x32x16_bf16(PAF(0),VFR(0),o[0],0,0,0), C0,0); \
    GAPB(o[1]=__builtin_amdgcn_mfma_f32_32x32x16_bf16(PAF(0),VFR(4),o[1],0,0,0), C0,4); \
    KRD(GL,0); GAPB(o[0]=__builtin_amdgcn_mfma_f32_32x32x16_bf16(PAF(1),VFR(1),o[0],0,0,0), C0,8); \
    KRD(GL,1); GAPB(o[1]=__builtin_amdgcn_mfma_f32_32x32x16_bf16(PAF(1),VFR(5),o[1],0,0,0), C0,12); \
    KRD(GL,2); GAPB(o[0]=__builtin_amdgcn_mfma_f32_32x32x16_bf16(PAF(2),VFR(2),o[0],0,0,0), C1,0); \
    KRD(GL,3); GAPB(o[1]=__builtin_amdgcn_mfma_f32_32x32x16_bf16(PAF(2),VFR(6),o[1],0,0,0), C1,4); \
    GAPB(o[0]=__builtin_amdgcn_mfma_f32_32x32x16_bf16(PAF(3),VFR(3),o[0],0,0,0), C1,8); \
    GAPB(o[1]=__builtin_amdgcn_mfma_f32_32x32x16_bf16(PAF(3),VFR(7),o[1],0,0,0), C1,12); \
    }while(0)
  int t=1;
  for(;t+5<NT;t+=2){
    STEP(pB0,pB1,pA0,pA1,t,true,true,true);     WAIT_BAR(2); RESC(); ROT();
    STEP(pA0,pA1,pB0,pB1,t+1,true,true,true);   WAIT_BAR(2); RESC(); ROT();
  }
  #define ENDW(tt) do{ if((tt)+3<NT){WAIT_BAR(2);} else if((tt)+2<NT){WAIT_BAR(1);} else {WAIT_BAR(0);} }while(0)
  for(;t+1<NT;t+=2){
    STEP(pB0,pB1,pA0,pA1,t,(t+3<NT),(t+1<NT),(t+1<NT));       ENDW(t);   RESC(); ROT();
    STEP(pA0,pA1,pB0,pB1,t+1,(t+4<NT),(t+2<NT),(t+2<NT));     ENDW(t+1); RESC(); ROT();
  }
  STEP(pB0,pB1,pA0,pA1,NT-1,false,false,false); RESC();
  { float sacc=pB0[0]+pB0[1]; _Pragma("unroll") for(int r=2;r<16;++r)sacc+=pB0[r]; _Pragma("unroll") for(int r=0;r<16;++r)sacc+=pB1[r]; l_reg+=sacc;
    pw0=(u32x4){PKW(pB0,0),PKW(pB0,2),PKW(pB0,4),PKW(pB0,6)};pw1=(u32x4){PKW(pB0,8),PKW(pB0,10),PKW(pB0,12),PKW(pB0,14)};pw2=(u32x4){PKW(pB1,0),PKW(pB1,2),PKW(pB1,4),PKW(pB1,6)};pw3=(u32x4){PKW(pB1,8),PKW(pB1,10),PKW(pB1,12),PKW(pB1,14)};
    SBAR(); pv(o,vb0+sl_cur,PAF(0),PAF(1),PAF(2),PAF(3)); }
  #undef PKW
  #undef PAF
  #undef VFR
  #undef PIN
  #undef MX3
  #undef GAPA
  #undef GAPB
  #undef EX
  #undef VRD
  #undef KRD
  #undef STEP
  #undef ENDW
  {auto rr=__builtin_amdgcn_permlane32_swap(__float_as_uint(l_reg),__float_as_uint(l_reg),false,false);l_reg=__uint_as_float(rr[0])+__uint_as_float(rr[1]);}
  if(hi==0)wsf[32+r32]=l_reg;asm volatile("s_waitcnt lgkmcnt(0)":::"memory");
  float rli[16];
  #pragma unroll
  for(int r=0;r<16;++r)rli[r]=__builtin_amdgcn_rcpf(wsf[32+crow(r,hi)]);
  bf16*Ow=Ou+(long)(wid*QBLK)*OP;
  { bf16*stg=(bf16*)(shm+LDS_OST)+wid*2048;
    #pragma unroll
    for(int r=0;r<16;++r){const int orow=crow(r,hi);
      #pragma unroll
      for(int d0=0;d0<2;++d0)stg[orow*64+d0*32+r32]=__float2bfloat16(o[d0][r]*rli[r]);}
    asm volatile("s_waitcnt lgkmcnt(0)":::"memory");
    #pragma unroll
    for(int i=0;i<4;++i){const int row=i*8+(lane>>3),ch=lane&7; const u32x4 v=*(const u32x4*)(stg+row*64+ch*8); ATTN_STORE16(Ow+(long)row*OP+ch*8,v);} }
  asm volatile("s_waitcnt lgkmcnt(0)\n\ts_barrier":::"memory");
  #undef DMA_K
  #undef DMA_V
  #undef CMASK
  #undef START
  #undef RESC
  #undef ROT
}
constexpr int ATTN_LDS_BYTES=LDS_BYTES;
#undef SBAR
#undef WAIT_BAR
}
#define GAS __attribute__((address_space(1)))
#define LAS __attribute__((address_space(3)))
typedef unsigned short bf16;
typedef unsigned v4u __attribute__((ext_vector_type(4)));
typedef unsigned v2u __attribute__((ext_vector_type(2)));
typedef float f32x4 __attribute__((ext_vector_type(4)));
typedef short bf16x8 __attribute__((ext_vector_type(8)));
constexpr int NWAVES = 8, NTHREADS = 512;
constexpr int RING_BYTES = 131072, LDS_BYTES = 147456;
#define LDS_WAIT() asm volatile("s_waitcnt lgkmcnt(0)" ::: "memory")
#define VM_WAIT() asm volatile("s_waitcnt vmcnt(0)" ::: "memory")
__device__ __forceinline__ unsigned f2bf(float f) { unsigned u = __builtin_bit_cast(unsigned, f); return (u + 0x7fffu + ((u >> 16) & 1u)) >> 16; }
__device__ __forceinline__ unsigned pk2(float lo, float hi) { return f2bf(lo) | (f2bf(hi) << 16); }
__device__ __forceinline__ float bf2f(unsigned short b) { return __builtin_bit_cast(float, ((unsigned)b) << 16); }
__device__ __forceinline__ float sigmoidf_(float x) { return 1.0f / (1.0f + __expf(-x)); }
__device__ __forceinline__ float siluf_(float x) { return x * sigmoidf_(x); }
__device__ __forceinline__ float wave_sum(float v) {
#pragma unroll
    for (int o = 1; o < 64; o <<= 1) v += __shfl_xor(v, o);
    return v;
}

constexpr size_t MiB = 1u << 20;
constexpr size_t WS_CTL = 0, WS_MOD = 1 * MiB;
constexpr size_t WS_WIN = 2 * MiB, WIN_BYTES = (size_t)PP * D * 2;
constexpr size_t WS_WOUT = WS_WIN + 2 * WIN_BYTES, WOUT_BYTES = (size_t)D * D * 2;
constexpr size_t WS_WUP = WS_WOUT + 2 * WOUT_BYTES, WUP_BYTES = (size_t)DFF * D * 2;
constexpr size_t WS_WDN = WS_WUP + 2 * WUP_BYTES, WDN_BYTES = (size_t)D * DFF * 2;
constexpr size_t WS_WPW = WS_WDN + 2 * WDN_BYTES, WPW_BYTES = (size_t)256 * 256 * 2;
static_assert(WS_WPW + 2 * WPW_BYTES <= 50 * MiB, "weights");
constexpr size_t WS_XC = 50 * MiB;
constexpr size_t WS_ACT = 54 * MiB;
constexpr size_t WS_P = 88 * MiB;
constexpr size_t WS_H = 88 * MiB;
constexpr size_t WS_QA = 182 * MiB;
constexpr size_t WS_KA = 191 * MiB, WS_VA = 196 * MiB;
constexpr size_t WS_KV = 201 * MiB;
constexpr size_t WS_DEC = 235 * MiB;
constexpr size_t WS_END = 256 * MiB;
static_assert(WS_P + (size_t)M * PP * 2 <= WS_QA && WS_H + (size_t)M * DFF * 2 <= WS_END && WS_ACT + (size_t)M * D * 2 <= WS_P, "ws map");

struct Args { const float* in[27]; float* out; unsigned char* ws; int ph_lo, ph_hi, layer, pad; };

template <class Map> __device__ __forceinline__ void transpose_item(const float* W, int K, int N, bf16* WT, LAS float* scr, int kb, int nb, int lane, Map srcc) {
    const int k0 = 64 * kb, n0 = 32 * nb; const int sc = srcc(n0 + (lane & 31));
#pragma unroll 8
    for (int i = 0; i < 32; ++i) { const int kk = 2 * i + (lane >> 5); scr[kk * 33 + (lane & 31)] = sc >= 0 ? W[(size_t)(k0 + kk) * N + sc] : 0.f; }
    LDS_WAIT(); asm volatile("" ::: "memory");
    const int c = lane & 7;
#pragma unroll
    for (int j = 0; j < 4; ++j) { const int n = (lane >> 3) + 8 * j; const LAS float* s = scr + (8 * c) * 33 + n;
        v4u o; o.x = pk2(s[0 * 33], s[1 * 33]); o.y = pk2(s[2 * 33], s[3 * 33]); o.z = pk2(s[4 * 33], s[5 * 33]); o.w = pk2(s[6 * 33], s[7 * 33]);
        *(GAS v4u*)(WT + (size_t)(n0 + n) * K + k0 + 8 * c) = o; }
    LDS_WAIT(); asm volatile("" ::: "memory");
}
struct MapId { __device__ __forceinline__ int operator()(int n) const { return n; } };
struct MapWin { __device__ __forceinline__ int operator()(int n) const { return n < 1280 ? n : (n < 2560 ? n + 16 : (n < 2576 ? n - 1280 : -1)); } };

__device__ __forceinline__ void ph_prologue(const Args& a, LAS unsigned char* lds, int tid, int lane, int wave, int bid, int G) {
    unsigned char* ws = a.ws;
    LAS float* scr = (LAS float*)(lds + wave * 16384);
    const int gw = bid * NWAVES + wave, NGW = G * NWAVES;
    constexpr int I_IN = (D / 64) * (PP / 32), I_OUT = (D / 64) * (D / 32), I_UP = (D / 64) * (DFF / 32), I_DN = (DFF / 64) * (D / 32), I_PW = (256 / 64) * (256 / 32);
    constexpr int I_L = I_IN + I_OUT + I_UP + I_DN + I_PW;
    for (int it = gw; it < DEPTH * I_L; it += NGW) {
        const int l = it / I_L; int r = it % I_L;
        if (r < I_IN) { transpose_item(a.in[8] + (size_t)l * D * PIN, D, PIN, (bf16*)(ws + WS_WIN + l * WIN_BYTES), scr, r / (PP / 32), r % (PP / 32), lane, MapWin()); continue; } r -= I_IN;
        if (r < I_OUT) { transpose_item(a.in[23] + (size_t)l * D * D, D, D, (bf16*)(ws + WS_WOUT + l * WOUT_BYTES), scr, r / (D / 32), r % (D / 32), lane, MapId()); continue; } r -= I_OUT;
        if (r < I_UP) { transpose_item(a.in[24] + (size_t)l * D * DFF, D, DFF, (bf16*)(ws + WS_WUP + l * WUP_BYTES), scr, r / (DFF / 32), r % (DFF / 32), lane, MapId()); continue; } r -= I_UP;
        if (r < I_DN) { transpose_item(a.in[25] + (size_t)l * DFF * D, DFF, D, (bf16*)(ws + WS_WDN + l * WDN_BYTES), scr, r / (D / 32), r % (D / 32), lane, MapId()); continue; } r -= I_DN;
        transpose_item(a.in[13] + (size_t)l * 256 * 256, 256, 256, (bf16*)(ws + WS_WPW + l * WPW_BYTES), scr, r / 8, r % 8, lane, MapId());
    }
    __syncthreads();
    LAS float* sil = (LAS float*)lds;
    LAS float* part = (LAS float*)(lds + NS * D * 4);
    float* MOD = (float*)(ws + WS_MOD);
    const float* c = a.in[1]; const float* cc = a.in[3]; const float* w_mod = a.in[4]; const float* b_mod = a.in[5];
    bool staged = false;
    for (int task = bid; task < DEPTH * (NMOD / 64); task += G) {
        if (!staged) { for (int i = tid; i < NS * D; i += NTHREADS) { const int s = i / D, k = i % D; const float v = s < NB ? c[s * D + k] : cc[k]; sil[i] = siluf_(v); } staged = true; __syncthreads(); }
        const int l = task / (NMOD / 64), c0 = (task % (NMOD / 64)) * 64;
        float acc[NS];
#pragma unroll
        for (int s = 0; s < NS; ++s) acc[s] = 0.f;
        const float* wp = w_mod + (size_t)l * D * NMOD + (size_t)(wave * 128) * NMOD + c0 + lane;
#pragma unroll 4
        for (int k = 0; k < 128; ++k) { const float wv = wp[(size_t)k * NMOD];
#pragma unroll
            for (int s = 0; s < NS; ++s) acc[s] += sil[s * D + wave * 128 + k] * wv; }
#pragma unroll
        for (int s = 0; s < NS; ++s) part[(wave * NS + s) * 64 + lane] = acc[s];
        __syncthreads();
        if (tid < NS * 64) { const int s = tid / 64, ln = tid % 64; float v = 0.f;
#pragma unroll
            for (int w = 0; w < 8; ++w) v += part[(w * NS + s) * 64 + ln];
            MOD[((size_t)l * NS + s) * NMOD + c0 + ln] = v + b_mod[(size_t)l * NMOD + c0 + ln]; }
        __syncthreads();
    }
}
__device__ __forceinline__ void ph_normmod(const float* xl, const float* xc, const float* g, const float* mod, int i_shift, int i_scale, bf16* XN, int nrows, int lane, int gw, int NGW) {
    for (int r = gw; r < nrows; r += NGW) {
        const float* xr = r < ML ? xl + (size_t)r * D : xc + (size_t)(r - ML) * D;
        const float* m = mod + (size_t)(r < ML ? r / SEQ : NB) * NMOD;
        f32x4 v[4]; float s = 0.f;
#pragma unroll
        for (int j = 0; j < 4; ++j) { v[j] = *(const f32x4*)(xr + 4 * lane + 256 * j); s += (v[j].x * v[j].x + v[j].y * v[j].y) + (v[j].z * v[j].z + v[j].w * v[j].w); }
        const float rs = 1.0f / sqrtf(wave_sum(s) * (1.0f / D) + EPS);
#pragma unroll
        for (int j = 0; j < 4; ++j) { const int c0 = 4 * lane + 256 * j;
            const f32x4 gg = *(const f32x4*)(g + c0), sc = *(const f32x4*)(m + i_scale * D + c0), sh = *(const f32x4*)(m + i_shift * D + c0);
            const f32x4 o = v[j] * rs * gg * (sc + 1.0f) + sh;
            v2u w; w.x = pk2(o.x, o.y); w.y = pk2(o.z, o.w); *(v2u*)(XN + (size_t)r * D + c0) = w; }
    }
}
__device__ __forceinline__ void ph_final(float* x, const float* g, int lane, int gw, int NGW) {
    for (int r = gw; r < ML; r += NGW) {
        float* xr = x + (size_t)r * D;
        f32x4 v[4]; float s = 0.f;
#pragma unroll
        for (int j = 0; j < 4; ++j) { v[j] = *(const f32x4*)(xr + 4 * lane + 256 * j); s += (v[j].x * v[j].x + v[j].y * v[j].y) + (v[j].z * v[j].z + v[j].w * v[j].w); }
        const float rs = 1.0f / sqrtf(wave_sum(s) * (1.0f / D) + EPS);
#pragma unroll
        for (int j = 0; j < 4; ++j) { const int c0 = 4 * lane + 256 * j; *(f32x4*)(xr + c0) = v[j] * rs * *(const f32x4*)(g + c0); }
    }
}
__device__ __forceinline__ void ph_attprep(const bf16* P, const float* qg, const float* kg, bf16* QA, bf16* KA, bf16* VA, int lane, int gw, int NGW) {
    const float gq = qg[lane], gk = kg[lane];
    const int kk = lane & 31; const float inv = exp2f(-(float)(kk & 15) * (13.287712379549449f / 16.0f));
    for (int r = gw; r < M; r += NGW) {
        const bool lat = r < ML; const int b = lat ? r / SEQ : (r - ML) / CTX, t = lat ? r % SEQ : (r - ML) % CTX;
        const bf16* pr = P + (size_t)r * PP;
        float cs = 1.f, sn = 0.f;
        if (lat) { const float ang = (float)(kk < 16 ? t / GRIDW : t % GRIDW) * inv; sincosf(ang, &sn, &cs); }
        const float sgn = lane < 32 ? -1.f : 1.f;
        const size_t krow = (size_t)b * KEYS + (lat ? CTX + t : t);
#pragma unroll
        for (int h = 0; h < 6; ++h) {
            const float x = bf2f(pr[(h < 4 ? OFF_AQ + h * 64 : OFF_AK + (h - 4) * 64) + lane]);
            const float rs = 1.0f / sqrtf(wave_sum(x * x) * (1.0f / 64) + EPS);
            const float v = x * rs * (h < 4 ? gq : gk);
            const float o = v * cs + sgn * __shfl_xor(v, 32) * sn;
            if (h < 4) QA[(size_t)r * 256 + h * 64 + lane] = (bf16)f2bf(o * (0.125f * 1.4426950408889634f));
            else KA[krow * 128 + (h - 4) * 64 + lane] = (bf16)f2bf(o);
        }
        VA[krow * 128 + lane] = pr[OFF_AV + lane]; VA[krow * 128 + 64 + lane] = pr[OFF_AV + 64 + lane];
    }
}
__device__ __forceinline__ void ph_attention(const bf16* QA, const bf16* KA, const bf16* VA, bf16* Y, bool need_ctx, char* lds, int bid, int G) {
    const int vcu = (G % 8 == 0) ? (bid % 8) * (G / 8) + bid / 8 : bid;
    const int NU = 256 + (need_ctx ? 16 : 0);
    for (int u = vcu; u < NU; u += G) {
        if (u < 256) { const int b = u >> 6, h = (u >> 4) & 3, qb = u & 15; const size_t row = (size_t)b * SEQ + qb * 256;
            attn_body::attn_unit<8>((const attn_body::bf16*)(QA + row * 256 + h * 64), (const attn_body::bf16*)(KA + (size_t)b * KEYS * 128 + (h >> 1) * 64), (const attn_body::bf16*)(VA + (size_t)b * KEYS * 128 + (h >> 1) * 64),
                                    (attn_body::bf16*)(Y + row * D + 512 + h * 64), KEYS / 64, lds); }
        else { const int b = (u - 256) >> 2, h = (u - 256) & 3; const size_t row = (size_t)ML + b * CTX;
            attn_body::attn_unit<8>((const attn_body::bf16*)(QA + row * 256 + h * 64), (const attn_body::bf16*)(KA + (size_t)b * KEYS * 128 + (h >> 1) * 64), (const attn_body::bf16*)(VA + (size_t)b * KEYS * 128 + (h >> 1) * 64),
                                    (attn_body::bf16*)(Y + row * D + 512 + h * 64), CTX / 64, lds); }
    }
}
__device__ __forceinline__ void ph_conv(const bf16* P, const float* w_dw, const float* b_dw, const float* ln_g, const float* ln_b, const bf16* PwT, const float* b_pw, bf16* Y, int nrows,
                                        LAS unsigned char* lds, int tid, int lane, int wave, int bid, int G) {
    typedef float f32x4_t __attribute__((ext_vector_type(4)));
    LAS float* U = (LAS float*)lds; LAS unsigned char* Zb = lds + 96256; constexpr int ZS = 528;
    const int nunits = nrows / 64;
    if (bid >= nunits) return;
    const int ch = tid & 255, half = tid >> 8;
    float wreg[31];
#pragma unroll
    for (int j = 0; j < 31; ++j) wreg[j] = w_dw[j * 256 + ch];
    const float bdw = b_dw[ch];
    const f32x4_t lg = *(const f32x4_t*)(ln_g + 4 * lane), lb = *(const f32x4_t*)(ln_b + 4 * lane);
    bf16x8 wf[2][8];
#pragma unroll
    for (int nt = 0; nt < 2; ++nt)
#pragma unroll
        for (int ks = 0; ks < 8; ++ks) wf[nt][ks] = *(const bf16x8*)(PwT + (size_t)(32 * wave + 16 * nt + (lane & 15)) * 256 + 32 * ks + 8 * (lane >> 4));
    const f32x4_t bp0 = *(const f32x4_t*)(b_pw + 32 * wave + 4 * (lane >> 4)), bp1 = *(const f32x4_t*)(b_pw + 32 * wave + 16 + 4 * (lane >> 4));
    for (int u = bid; u < nunits; u += G) {
        const int r0 = u * 64; int base, t0, T;
        if (r0 < ML) { base = (r0 / SEQ) * SEQ; t0 = r0 % SEQ; T = SEQ; } else { const int rc = r0 - ML; base = ML + (rc / CTX) * CTX; t0 = rc % CTX; T = CTX; }
        for (int i = tid >> 5; i < 94; i += 16) {
            const int tt = t0 - 15 + i, c8 = (tid & 31) * 8;
            f32x4_t o0 = {0.f, 0.f, 0.f, 0.f}, o1 = {0.f, 0.f, 0.f, 0.f};
            if (tt >= 0 && tt < T) {
                const bf16* pr = P + (size_t)(base + tt) * PP;
                const bf16x8 av = *(const bf16x8*)(pr + OFF_CA + c8), gv = *(const bf16x8*)(pr + OFF_CG + c8);
#pragma unroll
                for (int e = 0; e < 4; ++e) { o0[e] = bf2f((unsigned short)av[e]) * sigmoidf_(bf2f((unsigned short)gv[e])); o1[e] = bf2f((unsigned short)av[4 + e]) * sigmoidf_(bf2f((unsigned short)gv[4 + e])); }
            }
            *(LAS f32x4_t*)(U + i * 256 + c8) = o0; *(LAS f32x4_t*)(U + i * 256 + c8 + 4) = o1;
        }
        __syncthreads();
        float y[32];
        {
            float uu[62];
#pragma unroll
            for (int i = 0; i < 62; ++i) uu[i] = U[(32 * half + i) * 256 + ch];
#pragma unroll
            for (int t = 0; t < 32; ++t) { float acc = bdw;
#pragma unroll
                for (int j = 0; j < 31; ++j) acc += uu[t + j] * wreg[j];
                y[t] = acc; }
        }
        __syncthreads();
#pragma unroll
        for (int t = 0; t < 32; ++t) U[(32 * half + t) * 256 + ch] = y[t];
        __syncthreads();
#pragma unroll 2
        for (int q = 0; q < 8; ++q) { const int tok = 8 * wave + q;
            const f32x4_t v = *(LAS f32x4_t*)(U + tok * 256 + 4 * lane);
            const float mu = wave_sum((v.x + v.y) + (v.z + v.w)) * (1.0f / 256);
            const f32x4_t dv = v - mu;
            const float var = wave_sum((dv.x * dv.x + dv.y * dv.y) + (dv.z * dv.z + dv.w * dv.w)) * (1.0f / 256);
            const float rs = 1.0f / sqrtf(var + EPS);
            f32x4_t o = dv * rs * lg + lb;
#pragma unroll
            for (int e = 0; e < 4; ++e) o[e] = siluf_(o[e]);
            v2u w; w.x = pk2(o.x, o.y); w.y = pk2(o.z, o.w);
            *(LAS v2u*)(Zb + tok * ZS + 8 * lane) = w; }
        __syncthreads();
        f32x4_t acc[2][4];
#pragma unroll
        for (int nt = 0; nt < 2; ++nt)
#pragma unroll
            for (int tt = 0; tt < 4; ++tt) acc[nt][tt] = (f32x4_t){0.f, 0.f, 0.f, 0.f};
#pragma unroll
        for (int ks = 0; ks < 8; ++ks) {
            bf16x8 zf[4];
#pragma unroll
            for (int tt = 0; tt < 4; ++tt) zf[tt] = *(LAS bf16x8*)(Zb + (16 * tt + (lane & 15)) * ZS + 64 * ks + 16 * (lane >> 4));
#pragma unroll
            for (int nt = 0; nt < 2; ++nt)
#pragma unroll
                for (int tt = 0; tt < 4; ++tt) acc[nt][tt] = __builtin_amdgcn_mfma_f32_16x16x32_bf16(wf[nt][ks], zf[tt], acc[nt][tt], 0, 0, 0);
        }
#pragma unroll
        for (int tt = 0; tt < 4; ++tt) { bf16* yr = Y + (size_t)(r0 + 16 * tt + (lane & 15)) * D + 32 * wave + 4 * (lane >> 4);
            const f32x4_t a0 = acc[0][tt] + bp0, a1 = acc[1][tt] + bp1;
            v2u w0, w1; w0.x = pk2(a0.x, a0.y); w0.y = pk2(a0.z, a0.w); w1.x = pk2(a1.x, a1.y); w1.y = pk2(a1.z, a1.w);
            *(v2u*)yr = w0; *(v2u*)(yr + 16) = w1; }
        __syncthreads();
    }
}
typedef unsigned short act_t;
__device__ __forceinline__ float ldA(const act_t* p) { return __uint_as_float(((unsigned)*p) << 16); }
__device__ __forceinline__ void stA(act_t* p, float v) { *p = (act_t)f2bf(v); }
#define LAUNCH(k, n, ...) do { const long n_ = (long)(n); const int nb_ = (int)((n_ + 255) / 256); hipLaunchKernelGGL(k, dim3(nb_), dim3(256), 0, stream, __VA_ARGS__); } while (0)
#define GID ((long)blockIdx.x * blockDim.x + threadIdx.x)

__device__ __forceinline__ int row_slot(int r) { return r < ML ? r / SEQ : NB; }

struct GemmArgs {
    const act_t* A; int lda; const float* W; int ldw; int K; int N; int nrows;
    act_t* C; int ldc; const float* bias;
    const float* xin_l; const float* xin_c; float* xout_l; float* xout_c; const float* gate;
};
template <int MODE> __global__ void __launch_bounds__(256) k_gemm(GemmArgs a) {
    const long i = GID; const long total = (long)(a.nrows / 8) * a.N; if (i >= total) return;
    const int rg = (int)(i / a.N), n = (int)(i % a.N), r0 = rg * 8;
    float acc[8];
#pragma unroll
    for (int j = 0; j < 8; ++j) acc[j] = 0.f;
    const act_t* Ap = a.A + (size_t)r0 * a.lda;
    const float* Wp = a.W + n;
    for (int k = 0; k < a.K; ++k) {
        const float w = Wp[(size_t)k * a.ldw];
#pragma unroll
        for (int j = 0; j < 8; ++j) acc[j] += ldA(Ap + (size_t)j * a.lda + k) * w;
    }
#pragma unroll
    for (int j = 0; j < 8; ++j) {
        const int r = r0 + j;
        if (MODE == 0) stA(a.C + (size_t)r * a.ldc + n, acc[j] + (a.bias ? a.bias[n] : 0.f));
        else if (MODE == 1) { const float v = acc[j] > 0.f ? acc[j] : 0.f; stA(a.C + (size_t)r * a.ldc + n, v * v); }
        else {
            const float gte = a.gate[(size_t)row_slot(r) * NMOD + n];
            if (r < ML) a.xout_l[(size_t)r * D + n] = a.xin_l[(size_t)r * D + n] + gte * acc[j];
            else a.xout_c[(size_t)(r - ML) * D + n] = a.xin_c[(size_t)(r - ML) * D + n] + gte * acc[j];
        }
    }
}
__global__ void __launch_bounds__(256) k_conv_dw(const act_t* P, const float* w_dw  , const float* b_dw, float* CY, int nrows) {
    const long i = GID; if (i >= (long)nrows * 256) return;
    const int r = (int)(i / 256), ch = (int)(i % 256);
    int base, t, T;
    if (r < ML) { base = (r / SEQ) * SEQ; t = r % SEQ; T = SEQ; } else { const int rc = r - ML; base = ML + (rc / CTX) * CTX; t = rc % CTX; T = CTX; }
    float acc = b_dw[ch];
    for (int j = 0; j < 31; ++j) {
        const int tt = t - 15 + j;
        if (tt >= 0 && tt < T) {
            const act_t* p = P + (size_t)(base + tt) * PP;
            acc += ldA(p + OFF_CA + ch) * sigmoidf_(ldA(p + OFF_CG + ch)) * w_dw[j * 256 + ch];
        }
    }
    CY[i] = acc;
}
__global__ void __launch_bounds__(256) k_conv_ln(const float* CY, const float* ln_g, const float* ln_b, act_t* CZ, int nrows) {
    const long i = GID; if (i >= (long)nrows * 256) return;
    const int r = (int)(i / 256), ch = (int)(i % 256);
    const float* p = CY + (size_t)r * 256;
    float mu = 0.f; for (int k = 0; k < 256; ++k) mu += p[k]; mu *= (1.0f / 256);
    float var = 0.f; for (int k = 0; k < 256; ++k) { const float d = p[k] - mu; var += d * d; } var *= (1.0f / 256);
    const float y = (p[ch] - mu) * rsqrtf(var + EPS) * ln_g[ch] + ln_b[ch];
    stA(CZ + i, siluf_(y));
}
__global__ void __launch_bounds__(256) k_gla_gates(const act_t* P, const float* w_f, const float* b_f, const float* w_b, const float* b_b, act_t* LAF, act_t* LAB) {
    const long i = GID; if (i >= (long)M * 256) return;
    const int r = (int)(i / 256), dir = (int)((i / 128) & 1), hd = (int)(i % 128);
    const float* w = dir ? w_b : w_f; const float* b = dir ? b_b : b_f;
    float pre = b[hd];
    for (int j = 0; j < 16; ++j) pre += ldA(P + (size_t)r * PP + OFF_Z + j) * w[j * 128 + hd];
    const float ls = fminf(pre, 0.f) - log1pf(expf(-fabsf(pre)));
    stA((dir ? LAB : LAF) + (size_t)r * 128 + hd, ls * (1.0f / 16.0f));
}
__global__ void __launch_bounds__(256) k_ret_prep(const act_t* P, act_t* RQ, act_t* RK) {
    const long i = GID; if (i >= (long)M * 8) return;
    const int r = (int)(i / 8), h = (int)((i / 2) % 4), which = (int)(i & 1);
    const act_t* src = P + (size_t)r * PP + (which ? OFF_RK : OFF_RQ) + h * 32;
    act_t* dst = (which ? RK : RQ) + (size_t)r * 128 + h * 32;
    const float sc = which ? 0.17677669529663687f : 1.0f;
    const bool lat = r < ML; const int t = lat ? r % SEQ : 0;
    const float rid = (float)(t / GRIDW), cid = (float)(t % GRIDW);
    for (int k = 0; k < 16; ++k) {
        const float x1 = ldA(src + k) * sc, x2 = ldA(src + k + 16) * sc;
        float c = 1.f, s = 0.f;
        if (lat) { const float inv = powf(10000.0f, -(float)(k & 7) / 8.0f); const float ang = (k < 8 ? rid : cid) * inv; c = cosf(ang); s = sinf(ang); }
        stA(dst + k, x1 * c - x2 * s); stA(dst + k + 16, x2 * c + x1 * s);
    }
}
__global__ void __launch_bounds__(256) k_scan(const act_t* P, const act_t* LAF, const act_t* LAB, const act_t* RQ, const act_t* RK, float* OG, float* OR, int dir) {
    const long i = GID; if (i >= (long)2 * NB * 4 * 64) return;
    const int e = (int)(i % 64), h = (int)((i / 64) % 4), b = (int)((i / 256) % NB), mixer = (int)(i / (256 * NB));
    float S[32];
#pragma unroll
    for (int d = 0; d < 32; ++d) S[d] = 0.f;
    const float gamma = 1.0f - exp2f(-5.0f - (float)h);
    float* O = mixer ? OR : OG;
    const act_t* LA = dir ? LAB : LAF;
    for (int step = 0; step < CTX + SEQ; ++step) {
        int r;
        if (step < CTX) r = ML + b * CTX + (dir ? CTX - 1 - step : step);
        else { const int t = step - CTX; r = b * SEQ + (dir ? SEQ - 1 - t : t); }
        const act_t* pr = P + (size_t)r * PP;
        const float v = ldA(pr + (mixer ? OFF_RV : OFF_GV) + h * 64 + e);
        float o = 0.f;
#pragma unroll
        for (int d = 0; d < 32; ++d) {
            float q, k, a;
            if (mixer == 0) { q = ldA(pr + OFF_GQ + h * 32 + d) * 0.17677669529663687f; k = ldA(pr + OFF_GK + h * 32 + d); a = expf(ldA(LA + (size_t)r * 128 + h * 32 + d)); }
            else { q = ldA(RQ + (size_t)r * 128 + h * 32 + d); k = ldA(RK + (size_t)r * 128 + h * 32 + d); a = gamma; }
            S[d] = a * S[d] + k * v;
            o += q * S[d];
        }
        float* op = O + (size_t)r * 256 + h * 64 + e;
        if (dir) *op += o; else *op = o;
    }
}
__global__ void __launch_bounds__(256) k_scan_out(const float* OG, const float* OR, const act_t* P, const float* gn_gla, const float* gn_ret, act_t* Y, int nrows) {
    const long i = GID; if (i >= (long)nrows * 8) return;
    const int r = (int)(i / 8), h = (int)((i / 2) % 4), mixer = (int)(i & 1);
    const float* o = (mixer ? OR : OG) + (size_t)r * 256 + h * 64;
    const float* g = (mixer ? gn_ret : gn_gla) + h * 64;
    const act_t* gate = P + (size_t)r * PP + (mixer ? OFF_RG : OFF_GR) + h * 64;
    float ss = 0.f; for (int e = 0; e < 64; ++e) ss += o[e] * o[e];
    const float rs = rsqrtf(ss * (1.0f / 64) + EPS);
    act_t* y = Y + (size_t)r * D + (mixer ? 768 : 256) + h * 64;
    for (int e = 0; e < 64; ++e) stA(y + e, o[e] * rs * g[e] * siluf_(ldA(gate + e)));
}

enum { PH_PROLOG = 0, PH_NORM1, PH_INPROJ, PH_ATTPREP, PH_CONV, PH_ATT, PH_WOUT, PH_NORM2, PH_UP, PH_DOWN, PH_FINAL };
__global__ void __launch_bounds__(NTHREADS, 2) mk(Args a) {
    extern __shared__ __attribute__((aligned(16))) unsigned char lds_raw[];
    LAS unsigned char* lds = (LAS unsigned char*)lds_raw;
    const int tid = threadIdx.x, lane = tid & 63, wave = __builtin_amdgcn_readfirstlane(tid >> 6);
    const int bid = blockIdx.x, G = gridDim.x, gw = bid * NWAVES + wave, NGW = G * NWAVES;
    unsigned char* ws = a.ws;
    const int l = a.layer; const bool need_ctx = l < DEPTH - 1; const int nro = need_ctx ? M : ML;
    const float* mod = (const float*)(ws + WS_MOD) + (size_t)l * NS * NMOD;
    const float* xl = l == 0 ? a.in[0] : a.out; const float* xc = l == 0 ? a.in[2] : (const float*)(ws + WS_XC);
    float* XC = (float*)(ws + WS_XC);
    bf16* ACT = (bf16*)(ws + WS_ACT); bf16* P = (bf16*)(ws + WS_P); bf16* H = (bf16*)(ws + WS_H);
    const int lo = a.ph_lo, hi = a.ph_hi;
#define IN(k) (lo <= (k) && (k) < hi)
    if (IN(PH_PROLOG)) { ph_prologue(a, lds, tid, lane, wave, bid, G); }
    if (IN(PH_NORM1)) { ph_normmod(xl, xc, a.in[6] + l * D, mod, 0, 1, ACT, M, lane, gw, NGW); }
    if (IN(PH_INPROJ)) { { pg8::Gemm g{ACT, (const bf16*)(ws + WS_WIN + l * WIN_BYTES), M, PP, D}; pg8::StaticOrder S; S.init(M, PP, G, bid);
            pg8::EpiStore<0> E{P, PP}; pg8::gemm_phase<pg8::EpiStore<0>, pg8::StaticOrder, true, true>(lds, g, S, E); } }
    if (IN(PH_ATTPREP)) { ph_attprep(P, a.in[20] + l * 64, a.in[21] + l * 64, (bf16*)(ws + WS_QA), (bf16*)(ws + WS_KA), (bf16*)(ws + WS_VA), lane, gw, NGW); }
    if (IN(PH_CONV)) { ph_conv(P, a.in[9] + l * 31 * 256, a.in[10] + l * 256, a.in[11] + l * 256, a.in[12] + l * 256, (const bf16*)(ws + WS_WPW + l * WPW_BYTES), a.in[14] + l * 256, ACT, nro, lds, tid, lane, wave, bid, G); }
    if (IN(PH_ATT)) { ph_attention((const bf16*)(ws + WS_QA), (const bf16*)(ws + WS_KA), (const bf16*)(ws + WS_VA), ACT, need_ctx, (char*)lds_raw, bid, G); }
    if (IN(PH_WOUT)) { { pg8::Gemm g{ACT, (const bf16*)(ws + WS_WOUT + l * WOUT_BYTES), nro, D, D}; pg8::StaticOrder S; S.init(nro, D, G, bid);
            pg8::EpiResid E{xl, xc, a.out, XC, mod + 2 * D}; pg8::gemm_phase<pg8::EpiResid, pg8::StaticOrder, true, true>(lds, g, S, E); } }
    if (IN(PH_NORM2)) { ph_normmod(a.out, XC, a.in[7] + l * D, mod, 3, 4, ACT, nro, lane, gw, NGW); }
    if (IN(PH_UP)) { { pg8::Gemm g{ACT, (const bf16*)(ws + WS_WUP + l * WUP_BYTES), nro, DFF, D}; pg8::StaticOrder S; S.init(nro, DFF, G, bid);
            pg8::EpiStore<2> E{H, DFF}; pg8::gemm_phase<pg8::EpiStore<2>, pg8::StaticOrder, true, true>(lds, g, S, E); } }
    if (IN(PH_DOWN)) { { pg8::Gemm g{H, (const bf16*)(ws + WS_WDN + l * WDN_BYTES), nro, D, DFF}; pg8::StaticOrder S; S.init(nro, D, G, bid);
            pg8::EpiResid E{a.out, XC, a.out, XC, mod + 5 * D}; pg8::gemm_phase<pg8::EpiResid, pg8::StaticOrder, true, true>(lds, g, S, E); } }
    if (IN(PH_FINAL)) { ph_final(a.out, a.in[26], lane, gw, NGW); }
#undef IN
}
extern "C" void kernel_launch(void* const* d_in, const int* in_sizes, int n_in, void* d_out, int out_size, void* d_ws, size_t ws_size, hipStream_t stream) {
    static int grid = 0;
    if (grid == 0) {
        if (n_in != 27 || in_sizes[0] != ML * D || out_size != ML * D || ws_size < WS_END) { fprintf(stderr, "kernel_launch: unexpected shapes / workspace (n_in %d, ws %zu)\n", n_in, ws_size); grid = -1; return; }
        int dev = 0, cus = 0;
        if (hipGetDevice(&dev) != hipSuccess || hipDeviceGetAttribute(&cus, hipDeviceAttributeMultiprocessorCount, dev) != hipSuccess) { grid = -1; return; }
        if (hipFuncSetAttribute((const void*)mk, hipFuncAttributeMaxDynamicSharedMemorySize, LDS_BYTES) != hipSuccess) { fprintf(stderr, "kernel_launch: hipFuncSetAttribute failed\n"); grid = -1; return; }
        grid = cus;
    }
    if (grid < 0) return;
    Args a{};
    for (int i = 0; i < 27; ++i) a.in[i] = (const float*)d_in[i];
    a.out = (float*)d_out; a.ws = (unsigned char*)d_ws;
    auto run = [&](int ph, int l) { a.ph_lo = ph; a.ph_hi = ph + 1; a.layer = l; hipLaunchKernelGGL(mk, dim3(grid), dim3(NTHREADS), LDS_BYTES, stream, a); };
    char* ws = (char*)d_ws;
    const size_t NVB = 201 * MiB;
    act_t* Y = (act_t*)(ws + WS_ACT); act_t* P = (act_t*)(ws + WS_P);
    float* CY = (float*)(ws + NVB); act_t* CZ = (act_t*)(ws + NVB + 17 * MiB);
    act_t* LAF = (act_t*)(ws + NVB + 34 * MiB); act_t* LAB = (act_t*)(ws + NVB + 39 * MiB); act_t* RQ = (act_t*)(ws + NVB + 44 * MiB); act_t* RK = (act_t*)(ws + NVB + 49 * MiB);
    float* OG = CY; float* OR = (float*)(ws + NVB + 17 * MiB);
    const float* conv_w_dw = (const float*)d_in[9]; const float* conv_b_dw = (const float*)d_in[10]; const float* conv_ln_g = (const float*)d_in[11];
    const float* conv_ln_b = (const float*)d_in[12]; const float* conv_w_pw = (const float*)d_in[13]; const float* conv_b_pw = (const float*)d_in[14];
    const float* gla_w_a_f = (const float*)d_in[15]; const float* gla_b_a_f = (const float*)d_in[16]; const float* gla_w_a_b = (const float*)d_in[17]; const float* gla_b_a_b = (const float*)d_in[18];
    const float* gla_norm_g = (const float*)d_in[19]; const float* att_q_norm_g = (const float*)d_in[20]; const float* att_k_norm_g = (const float*)d_in[21]; const float* ret_norm_g = (const float*)d_in[22];
    run(PH_PROLOG, 0);
    for (int l = 0; l < DEPTH; ++l) {
        const bool need_ctx = l < DEPTH - 1; const int nro = need_ctx ? M : ML;
        run(PH_NORM1, l);
        run(PH_INPROJ, l);
        run(PH_CONV, l);
        LAUNCH(k_gla_gates, (long)M * 256, P, gla_w_a_f + l * 16 * 128, gla_b_a_f + l * 128, gla_w_a_b + l * 16 * 128, gla_b_a_b + l * 128, LAF, LAB);
        run(PH_ATTPREP, l);
        LAUNCH(k_ret_prep, (long)M * 8, P, RQ, RK);
        run(PH_ATT, l);
        LAUNCH(k_scan, (long)2 * NB * 4 * 64, P, LAF, LAB, RQ, RK, OG, OR, 0);
        LAUNCH(k_scan, (long)2 * NB * 4 * 64, P, LAF, LAB, RQ, RK, OG, OR, 1);
        LAUNCH(k_scan_out, (long)nro * 8, OG, OR, P, gla_norm_g + l * 256, ret_norm_g + l * 256, Y, nro);
        run(PH_WOUT, l); run(PH_NORM2, l); run(PH_UP, l); run(PH_DOWN, l);
    }
    run(PH_FINAL, 0);
}
```

```cpp
#include <hip/hip_runtime.h>
#include <hip/hip_cooperative_groups.h>
#include <cstdio>
#include <cstdint>
namespace cg = cooperative_groups;

constexpr int D = 1024, NB = 4, SEQ = 4096, CTX = 256, DFF = 4096, DEPTH = 2, GRIDW = 64;
constexpr int ML = NB * SEQ, MC = NB * CTX, M = ML + MC, NS = NB + 1, NMOD = 6 * D;
constexpr int PIN = 2576;
constexpr int PP = 2816;
constexpr int OFF_CA = 0, OFF_CG = 256, OFF_GQ = 512, OFF_GK = 640, OFF_GV = 768, OFF_GR = 1024, OFF_AQ = 1280, OFF_AK = 1536, OFF_AV = 1664,
              OFF_RQ = 1792, OFF_RK = 1920, OFF_RV = 2048, OFF_RG = 2304, OFF_Z = 2560;
constexpr float EPS = 1e-6f;
constexpr int KEYS = CTX + SEQ;
namespace pg8 {
#define PG8_LAS __attribute__((address_space(3)))
typedef unsigned short bf16_t;
typedef short bf16x8 __attribute__((ext_vector_type(8)));
typedef float f32x4 __attribute__((ext_vector_type(4)));
typedef unsigned u32x4 __attribute__((ext_vector_type(4)));
constexpr int BM = 256, BK = 64, HALF = 128, HTB = HALF * BK * 2  , STAGE_BYTES = 8 * HTB, NXCD = 8, WGM = 8;

__host__ __device__ __forceinline__ int lds_byte(int r, int c) { const int st = (r >> 4) * 2 + (c >> 5), rr = r & 15, cc = c & 31, ob = rr * 64 + cc * 2; return st * 1024 + (ob ^ (((ob >> 9) & 1) << 5)); }
__host__ __device__ __forceinline__ void stage_rc(int b, int& R, int& C) { const int st = b / 1024, sb = b % 1024, swz = sb ^ (((sb >> 9) & 1) << 5); R = (st >> 1) * 16 + swz / 64; C = (st & 1) * 32 + (swz % 64) / 2; }
__host__ __device__ __forceinline__ int perm32(int rho) { const int n = rho >> 4, i = rho & 15; return 8 * (i >> 2) + 4 * n + (i & 3); }

struct Unit { int pm, pn; };
struct Gemm { const bf16_t* A; const bf16_t* Bt; int M, N, K; };

struct StaticOrder {
    int nM, nN, nwg, G, c;
    __host__ __device__ void init(int M, int N, int G_, int c_) { nM = M / BM; nN = N / BM; nwg = nM * nN; G = G_; c = c_; }
    __host__ __device__ bool next(int i, Unit& u) const {
        const long L = (long)i * G + c; if (L >= nwg) return false;
        int wgid = (int)L; { const int q = nwg / NXCD, r = nwg % NXCD, xcd = wgid % NXCD, off = wgid / NXCD; wgid = (xcd < r ? xcd * (q + 1) : r * (q + 1) + (xcd - r) * q) + off; }
        const int nig = WGM * nN, gid = wgid / nig, fm = gid * WGM, gsz = (nM - fm) < WGM ? (nM - fm) : WGM;
        u.pm = fm + ((wgid % nig) % gsz); u.pn = (wgid % nig) / gsz; return true;
    }
    __device__ __forceinline__ void a_ready(const Unit&) const {}
    __device__ __forceinline__ void done(const Unit&) const {}
};

__device__ __forceinline__ unsigned cvt_pk_bf16(float lo, float hi) { unsigned r; asm volatile("v_cvt_pk_bf16_f32 %0, %1, %2" : "=v"(r) : "v"(lo), "v"(hi)); return r; }
typedef float f32x2 __attribute__((ext_vector_type(2)));
__device__ __forceinline__ f32x2 gelu_pk(f32x2 v) {
    const f32x2 av = __builtin_elementwise_abs(v), d = av * 0.2316418882f + 1.0f;
    f32x2 t; t.x = __builtin_amdgcn_rcpf(d.x); t.y = __builtin_amdgcn_rcpf(d.y);
    f32x2 q = t * 0.5307027145f + (-0.7265760135f); q = q * t + 0.7107068705f; q = q * t + (-0.142248368f); q = q * t + 0.127414796f; q = q * t;
    const f32x2 s = (v * v) * (-0.72134752044f);
    f32x2 e; e.x = __builtin_amdgcn_exp2f(s.x); e.y = __builtin_amdgcn_exp2f(s.y);
    const f32x2 m = v * (q * e), r = v - m;
    f32x2 o; o.x = v.x < 0.f ? m.x : r.x; o.y = v.y < 0.f ? m.y : r.y; return o;
}

template <int ACT  > struct EpiBf16 {
    static constexpr bool PERM = true, AFTER_DRAIN = false; static_assert(ACT == 0 || ACT == 1, "EpiBf16: ACT is 0 (none) or 1 (gelu_pk)");
    bf16_t* O; int ldc; const float* bias; int split_cols; size_t split_stride; float scale0;
    __device__ __forceinline__ void operator()(const f32x4 (&acc)[2][2][4][2], const Unit& u, int wr, int wc, int fr, int fq) const {
        const int row0 = u.pm * BM + wr * 64 + fr; int colt = u.pn * BM; bf16_t* base = O;
        float sc = 1.f; if (split_cols) { const int t = colt / split_cols; base += (size_t)t * split_stride; colt -= t * split_cols; if (t == 0) sc = scale0; }
        const int col0 = colt + wc * 32 + 8 * fq, bcol0 = u.pn * BM + wc * 32 + 8 * fq;
        f32x4 bv[2][2];
#pragma unroll
        for (int bj = 0; bj < 2; ++bj)
#pragma unroll
            for (int n = 0; n < 2; ++n) bv[bj][n] = bias ? *(const f32x4*)(bias + bcol0 + bj * HALF + 4 * n) : (f32x4){0.f, 0.f, 0.f, 0.f};
#pragma unroll
        for (int ai = 0; ai < 2; ++ai)
#pragma unroll
            for (int m = 0; m < 4; ++m) { bf16_t* rowp = base + (size_t)(row0 + ai * HALF + m * 16) * ldc + col0;
#pragma unroll
                for (int bj = 0; bj < 2; ++bj) { f32x4 v0 = acc[ai][bj][m][0] + bv[bj][0], v1 = acc[ai][bj][m][1] + bv[bj][1];
                    if (ACT == 1) { f32x2 a = gelu_pk((f32x2){v0[0], v0[1]}), b = gelu_pk((f32x2){v0[2], v0[3]}), c = gelu_pk((f32x2){v1[0], v1[1]}), d = gelu_pk((f32x2){v1[2], v1[3]});
                        v0 = (f32x4){a.x, a.y, b.x, b.y}; v1 = (f32x4){c.x, c.y, d.x, d.y}; }
                    v0 = v0 * sc; v1 = v1 * sc; u32x4 w; w.x = cvt_pk_bf16(v0[0], v0[1]); w.y = cvt_pk_bf16(v0[2], v0[3]); w.z = cvt_pk_bf16(v1[0], v1[1]); w.w = cvt_pk_bf16(v1[2], v1[3]);
                    *(u32x4*)(rowp + bj * HALF) = w; } }
    }
};

template <int ACT> struct EpiStore {
    static constexpr bool PERM = true, AFTER_DRAIN = false;
    bf16_t* O; int ldc;
    __device__ __forceinline__ void operator()(const f32x4 (&acc)[2][2][4][2], const Unit& u, int wr, int wc, int fr, int fq) const {
        const int row0 = u.pm * BM + wr * 64 + fr, col0 = u.pn * BM + wc * 32 + 8 * fq;
#pragma unroll
        for (int ai = 0; ai < 2; ++ai)
#pragma unroll
            for (int m = 0; m < 4; ++m) { bf16_t* rowp = O + (size_t)(row0 + ai * HALF + m * 16) * ldc + col0;
#pragma unroll
                for (int bj = 0; bj < 2; ++bj) { f32x4 v0 = acc[ai][bj][m][0], v1 = acc[ai][bj][m][1];
                    if (ACT == 2) {
#pragma unroll
                        for (int e = 0; e < 4; ++e) { const float a = v0[e] > 0.f ? v0[e] : 0.f, b = v1[e] > 0.f ? v1[e] : 0.f; v0[e] = a * a; v1[e] = b * b; } }
                    u32x4 w; w.x = cvt_pk_bf16(v0[0], v0[1]); w.y = cvt_pk_bf16(v0[2], v0[3]); w.z = cvt_pk_bf16(v1[0], v1[1]); w.w = cvt_pk_bf16(v1[2], v1[3]);
                    *(u32x4*)(rowp + bj * HALF) = w; } }
    }
};
struct EpiResid {
    static constexpr bool PERM = false, AFTER_DRAIN = false;
    const float* xin_l; const float* xin_c; float* xout_l; float* xout_c; const float* gate;
    __device__ __forceinline__ void operator()(const f32x4 (&acc)[2][2][4][2], const Unit& u, int wr, int wc, int fr, int fq) const {
        const int r0 = u.pm * BM; const bool lat = r0 < ML; const int slot = lat ? r0 / SEQ : NB;
        const float* xin = lat ? xin_l + (size_t)r0 * D : xin_c + (size_t)(r0 - ML) * D;
        float* xout = lat ? xout_l + (size_t)r0 * D : xout_c + (size_t)(r0 - ML) * D;
        const int col0 = wc * 32 + 4 * fq;
        const float* gp = gate + (size_t)slot * NMOD + u.pn * BM;
        xin += u.pn * BM; xout += u.pn * BM;
#pragma unroll
        for (int ai = 0; ai < 2; ++ai)
#pragma unroll
            for (int m = 0; m < 4; ++m) { const int off = (ai * HALF + wr * 64 + m * 16 + fr) * D + col0;
#pragma unroll
                for (int bj = 0; bj < 2; ++bj)
#pragma unroll
                    for (int n = 0; n < 2; ++n) { const f32x4 xi = *(const f32x4*)(xin + off + bj * HALF + n * 16); const f32x4 gv = *(const f32x4*)(gp + col0 + bj * HALF + n * 16);
                        *(f32x4*)(xout + off + bj * HALF + n * 16) = xi + gv * acc[ai][bj][m][n]; }
                asm volatile("" ::: "memory"); }
    }
};

template <class Epi, class Sched, bool ALIGN_EPI = false, bool SP2 = false>
__device__ __forceinline__ void gemm_phase(PG8_LAS unsigned char* lds, const Gemm g, const Sched& S, const Epi& E) {
    const int tid = threadIdx.x, wid = __builtin_amdgcn_readfirstlane(tid >> 6), lane = tid & 63, wr = wid >> 2, wc = wid & 3, fr = lane & 15, fq = lane >> 4;
    const int K = g.K, nt = K / BK;
    unsigned voffA[2], voffB[2];
#pragma unroll
    for (int i = 0; i < 2; ++i) { int R, C; stage_rc(tid * 16 + i * 8192, R, C); const int Rb = Epi::PERM ? ((R & ~31) + perm32(R & 31)) : R;
        voffA[i] = (unsigned)(R * K + C) * 2u; voffB[i] = (unsigned)(Rb * K + C) * 2u; }
    const size_t kstep = (size_t)(BK * 2);
    const size_t hstep = (size_t)HALF * K * 2;
    const size_t tstep = 2 * hstep;
    const unsigned ldsw = (unsigned)wid * 1024u;
    const int aoff = lds_byte(wr * 64 + fr, fq * 8), boff = lds_byte(wc * 32 + fr, fq * 8);
#define PG8_SA(b, h) (((b) * 2 + (h)) * HTB)
#define PG8_SB(b, h) ((4 + (b) * 2 + (h)) * HTB)
#define PG8_STAGE(bufoff, gbase, voff) do { _Pragma("unroll") for (int _i = 0; _i < 2; ++_i) \
        __builtin_amdgcn_global_load_lds((const unsigned*)((const char*)(gbase) + (voff)[_i]), (PG8_LAS unsigned*)(lds + (bufoff) + ldsw + _i * 8192), 16, 0, 0); } while (0)
#define PG8_LDA(dst, b, h) do { _Pragma("unroll") for (int m = 0; m < 4; ++m) _Pragma("unroll") for (int k = 0; k < 2; ++k) dst[m][k] = *(const PG8_LAS bf16x8*)(lds + PG8_SA(b, h) + aoff + m * 2048 + k * 1024); } while (0)
#define PG8_LDB(dst, b, h) do { _Pragma("unroll") for (int n = 0; n < 2; ++n) _Pragma("unroll") for (int k = 0; k < 2; ++k) dst[n][k] = *(const PG8_LAS bf16x8*)(lds + PG8_SB(b, h) + boff + n * 2048 + k * 1024); } while (0)
#define PG8_MMA(ai, bj, At, Bt) do { __builtin_amdgcn_s_setprio(1); _Pragma("unroll") for (int m = 0; m < 4; ++m) _Pragma("unroll") for (int n = 0; n < 2; ++n) _Pragma("unroll") for (int k = 0; k < 2; ++k) \
        acc[ai][bj][m][n] = __builtin_amdgcn_mfma_f32_16x16x32_bf16(Bt[n][k], At[m][k], acc[ai][bj][m][n], 0, 0, 0); __builtin_amdgcn_s_setprio(0); } while (0)
#define PG8_WAIT_V(n) asm volatile("s_waitcnt vmcnt(" #n ")" ::: "memory")
#define PG8_WAIT_L(n) asm volatile("s_waitcnt lgkmcnt(" #n ")" ::: "memory")
#define PG8_BAR __builtin_amdgcn_s_barrier()
#define PG8_SCHED __builtin_amdgcn_sched_barrier(0)
    Unit cur, nxt; int ui = 0;
    if (!S.next(0, cur)) return;
    f32x4 acc[2][2][4][2];
#pragma unroll
    for (int a = 0; a < 2; ++a)
#pragma unroll
        for (int b = 0; b < 2; ++b)
#pragma unroll
            for (int m = 0; m < 4; ++m)
#pragma unroll
                for (int n = 0; n < 2; ++n) acc[a][b][m][n] = (f32x4){0.f, 0.f, 0.f, 0.f};
    bf16x8 At[4][2], B0[2][2], B1[2][2];
    const char* cA = (const char*)g.A + (size_t)cur.pm * tstep; const char* cB = (const char*)g.Bt + (size_t)cur.pn * tstep;
    S.a_ready(cur);
    if constexpr (SP2) {
        PG8_STAGE(PG8_SB(0, 0), cB, voffB); PG8_STAGE(PG8_SB(0, 1), cB + hstep, voffB); PG8_STAGE(PG8_SA(0, 0), cA, voffA); PG8_STAGE(PG8_SA(0, 1), cA + hstep, voffA);
        if (wr == 1) PG8_BAR;
        PG8_WAIT_V(2); PG8_BAR;
        PG8_STAGE(PG8_SB(1, 0), cB + kstep, voffB); PG8_STAGE(PG8_SA(1, 0), cA + kstep, voffA); PG8_STAGE(PG8_SB(1, 1), cB + hstep + kstep, voffB);
        PG8_WAIT_V(6); PG8_BAR;
    } else {
        PG8_STAGE(PG8_SB(0, 0), cB, voffB); PG8_STAGE(PG8_SA(0, 0), cA, voffA); PG8_STAGE(PG8_SB(0, 1), cB + hstep, voffB); PG8_STAGE(PG8_SA(0, 1), cA + hstep, voffA);
        if (wr == 1) PG8_BAR;
        PG8_WAIT_V(4); PG8_BAR;
        PG8_STAGE(PG8_SB(1, 0), cB + kstep, voffB); PG8_STAGE(PG8_SA(1, 0), cA + kstep, voffA); PG8_STAGE(PG8_SB(1, 1), cB + hstep + kstep, voffB);
        PG8_WAIT_V(6); PG8_BAR;
    }
    for (;;) {
        const bool has_next = S.next(ui + 1, nxt);
        const char* nA = has_next ? (const char*)g.A + (size_t)nxt.pm * tstep : cA; const char* nB = has_next ? (const char*)g.Bt + (size_t)nxt.pn * tstep : cB;
        for (int t = 0; t < nt; t += 2) {
            const bool last = (t == nt - 2);
            const char* a1 = cA + (size_t)(t + 1) * kstep;
            const char* a2 = last ? nA : cA + (size_t)(t + 2) * kstep; const char* b2 = last ? nB : cB + (size_t)(t + 2) * kstep;
            const char* a3 = a2 + kstep; const char* b3 = b2 + kstep;
            if (last && has_next) S.a_ready(nxt);
            if constexpr (SP2) {
            PG8_LDB(B0, 0, 0); PG8_LDB(B1, 0, 1); PG8_SCHED; PG8_LDA(At, 0, 0); PG8_STAGE(PG8_SA(1, 1), a1 + hstep, voffA);
            PG8_WAIT_V(8); PG8_WAIT_L(0); PG8_BAR; PG8_MMA(0, 0, At, B0); PG8_MMA(0, 1, At, B1); PG8_BAR; PG8_SCHED;
            PG8_LDA(At, 0, 1); PG8_STAGE(PG8_SB(0, 0), b2, voffB); PG8_STAGE(PG8_SB(0, 1), b2 + hstep, voffB); PG8_STAGE(PG8_SA(0, 0), a2, voffA);
            PG8_WAIT_V(8); PG8_WAIT_L(0); PG8_BAR; PG8_MMA(1, 0, At, B0); PG8_MMA(1, 1, At, B1); PG8_BAR; PG8_SCHED;
            PG8_LDB(B0, 1, 0); PG8_LDB(B1, 1, 1); PG8_SCHED; PG8_LDA(At, 1, 0); PG8_STAGE(PG8_SA(0, 1), a2 + hstep, voffA);
            PG8_WAIT_V(8); PG8_WAIT_L(0); PG8_BAR; PG8_MMA(0, 0, At, B0); PG8_MMA(0, 1, At, B1); PG8_BAR; PG8_SCHED;
            PG8_LDA(At, 1, 1); PG8_STAGE(PG8_SB(1, 0), b3, voffB); PG8_STAGE(PG8_SB(1, 1), b3 + hstep, voffB); PG8_STAGE(PG8_SA(1, 0), a3, voffA);
            PG8_WAIT_V(8); PG8_WAIT_L(0); PG8_BAR; PG8_MMA(1, 0, At, B0); PG8_MMA(1, 1, At, B1); PG8_BAR; PG8_SCHED;
            } else {
            PG8_LDB(B0, 0, 0); PG8_SCHED; PG8_LDA(At, 0, 0); PG8_STAGE(PG8_SA(1, 1), a1 + hstep, voffA);
            PG8_WAIT_L(8); PG8_BAR; PG8_WAIT_L(0); PG8_MMA(0, 0, At, B0); PG8_BAR; PG8_SCHED;
            PG8_LDB(B1, 0, 1); PG8_STAGE(PG8_SB(0, 0), b2, voffB);
            PG8_BAR; PG8_WAIT_L(0); PG8_MMA(0, 1, At, B1); PG8_BAR;
            PG8_LDA(At, 0, 1); PG8_STAGE(PG8_SA(0, 0), a2, voffA);
            PG8_BAR; PG8_WAIT_L(0); PG8_MMA(1, 0, At, B0); PG8_BAR; PG8_SCHED;
            PG8_STAGE(PG8_SB(0, 1), b2 + hstep, voffB);
            PG8_WAIT_V(6); PG8_BAR; PG8_MMA(1, 1, At, B1); PG8_BAR;
            PG8_LDB(B0, 1, 0); PG8_SCHED; PG8_LDA(At, 1, 0); PG8_STAGE(PG8_SA(0, 1), a2 + hstep, voffA);
            PG8_WAIT_L(8); PG8_BAR; PG8_WAIT_L(0); PG8_MMA(0, 0, At, B0); PG8_BAR; PG8_SCHED;
            PG8_LDB(B1, 1, 1); PG8_STAGE(PG8_SB(1, 0), b3, voffB);
            PG8_BAR; PG8_WAIT_L(0); PG8_MMA(0, 1, At, B1); PG8_BAR;
            PG8_LDA(At, 1, 1); PG8_STAGE(PG8_SA(1, 0), a3, voffA);
            PG8_BAR; PG8_WAIT_L(0); PG8_MMA(1, 0, At, B0); PG8_BAR; PG8_SCHED;
            PG8_STAGE(PG8_SB(1, 1), b3 + hstep, voffB);
            PG8_WAIT_V(6); PG8_BAR; PG8_MMA(1, 1, At, B1); PG8_BAR;
            }
        }
        if constexpr (ALIGN_EPI) { if (wr == 0) PG8_BAR; }
        if constexpr (!Epi::AFTER_DRAIN) { E(acc, cur, wr, wc, fr, fq); S.done(cur); }
        if (!has_next) break;
#pragma unroll
        for (int a = 0; a < 2; ++a)
#pragma unroll
            for (int b = 0; b < 2; ++b)
#pragma unroll
                for (int m = 0; m < 4; ++m)
#pragma unroll
                    for (int n = 0; n < 2; ++n) acc[a][b][m][n] = (f32x4){0.f, 0.f, 0.f, 0.f};
        cur = nxt; cA = nA; cB = nB; ++ui;
        if constexpr (ALIGN_EPI) { if (wr == 1) PG8_BAR; }
    }
    PG8_WAIT_V(0);
    if constexpr (!ALIGN_EPI) { if (wr == 0) PG8_BAR; }
    PG8_BAR;
    if constexpr (Epi::AFTER_DRAIN) { E.fused(acc, cur, wr, wc, fr, fq, lds, wid, lane); S.done(cur); }
#undef PG8_SA
#undef PG8_SB
#undef PG8_STAGE
#undef PG8_LDA
#undef PG8_LDB
#undef PG8_MMA
#undef PG8_WAIT_V
#undef PG8_WAIT_L
#undef PG8_BAR
#undef PG8_SCHED
}
}
#include <hip/hip_bf16.h>
#include <cmath>
namespace attn_body {
using bf16=__hip_bfloat16;
using bf16x8=__attribute__((ext_vector_type(8)))short;
using s16x4=__attribute__((ext_vector_type(4)))short;
using f32x16=__attribute__((ext_vector_type(16)))float;
using u32x4=__attribute__((ext_vector_type(4)))unsigned;
constexpr int D=64;
constexpr int QP=256,KP=128,OP=1024;
constexpr int NW=8,QBLK=32,QB=QBLK*NW,KVBLK=64;
constexpr int ATTN_UNIT_ROWS=QB;
__device__ __forceinline__ int crow(int r,int hi){return (r&3)+8*(r>>2)+4*hi;}
#define SBAR() __builtin_amdgcn_sched_barrier(0)
__device__ __forceinline__ void cmask(f32x16&p0,f32x16&p1,int jb,int qrel,int hi){
  const float NEG=-INFINITY; int kb=64*jb+4*hi;
  #pragma unroll
  for(int r=0;r<16;++r){int kv=kb+(r&3)+8*(r>>2); if(kv>qrel)p0[r]=NEG; if(kv+32>qrel)p1[r]=NEG;}
}

constexpr int NSLOT=3, SLOTB=8192;
constexpr int LDS_K=0, LDS_V=NSLOT*SLOTB, LDS_WS=2*NSLOT*SLOTB, LDS_OST=LDS_WS+NW*64*4, LDS_BYTES=LDS_OST+NW*4096;
constexpr float C2=0.125f*1.4426950408889634f;
__device__ __forceinline__ void glds16(const void*gsrc,unsigned lds_dst){unsigned keep;
  asm volatile("s_mov_b32 %0, m0\n\ts_mov_b32 m0, %2\n\ts_nop 0\n\tglobal_load_lds_dwordx4 %1, off\n\ts_mov_b32 m0, %0":"=&s"(keep):"v"(gsrc),"s"(lds_dst):"memory");}
__device__ __forceinline__ float max3f(float a,float b,float c){float r;asm("v_max3_f32 %0, %1, %2, %3":"=v"(r):"v"(a),"v"(b),"v"(c));return r;}
__device__ __forceinline__ float max2f(float a,float b){float r;asm("v_max_f32_e32 %0, %1, %2":"=v"(r):"v"(a),"v"(b));return r;}
__device__ __forceinline__ float fadd_s(float a,float b){float r;asm("v_add_f32_e32 %0, %1, %2":"=v"(r):"v"(a),"v"(b));return r;}
__device__ __forceinline__ float fsub_s(float a,float b){float r;asm("v_sub_f32_e32 %0, %1, %2":"=v"(r):"v"(a),"v"(b));return r;}
typedef float f32x2_t __attribute__((ext_vector_type(2))); typedef __bf16 bf16x2_t __attribute__((ext_vector_type(2)));
__device__ __forceinline__ unsigned cvtpk_s(float lo,float hi){f32x2_t v={lo,hi};bf16x2_t b=__builtin_convertvector(v,bf16x2_t);return __builtin_bit_cast(unsigned,b);}
#define WAIT_BAR(N) asm volatile("s_waitcnt vmcnt(" #N ") lgkmcnt(0)\n\ts_barrier":::"memory")

__device__ __forceinline__ void qkt(f32x16&p0,f32x16&p1,const char*Kslot,const bf16x8*qr,const f32x16&negm,int r32,int hi){
  const char*kb=Kslot+hi*1024+r32*16;
  #pragma unroll
  for(int d0=0;d0<4;++d0){
    const bf16x8 b0=*reinterpret_cast<const bf16x8*>(kb+d0*2048);
    const bf16x8 b1=*reinterpret_cast<const bf16x8*>(kb+d0*2048+512);
    if(d0==0){p0=__builtin_amdgcn_mfma_f32_32x32x16_bf16(b0,qr[0],negm,0,0,0);p1=__builtin_amdgcn_mfma_f32_32x32x16_bf16(b1,qr[0],negm,0,0,0);}
    else{p0=__builtin_amdgcn_mfma_f32_32x32x16_bf16(b0,qr[d0],p0,0,0,0);p1=__builtin_amdgcn_mfma_f32_32x32x16_bf16(b1,qr[d0],p1,0,0,0);}}
}
typedef __attribute__((address_space(3))) const char* lds_cptr;
typedef short v4i16_t __attribute__((ext_vector_type(4)));
__device__ __forceinline__ void kload8(bf16x8*kf,lds_cptr kp){
  kf[0]=*(const __attribute__((address_space(3))) bf16x8*)(kp);      kf[1]=*(const __attribute__((address_space(3))) bf16x8*)(kp+512);
  kf[2]=*(const __attribute__((address_space(3))) bf16x8*)(kp+2048); kf[3]=*(const __attribute__((address_space(3))) bf16x8*)(kp+2560);
  kf[4]=*(const __attribute__((address_space(3))) bf16x8*)(kp+4096); kf[5]=*(const __attribute__((address_space(3))) bf16x8*)(kp+4608);
  kf[6]=*(const __attribute__((address_space(3))) bf16x8*)(kp+6144); kf[7]=*(const __attribute__((address_space(3))) bf16x8*)(kp+6656);
}
__device__ __forceinline__ void kload2(bf16x8*kf,lds_cptr kp,int j){ kf[2*j]=*(const __attribute__((address_space(3))) bf16x8*)(kp+j*2048); kf[2*j+1]=*(const __attribute__((address_space(3))) bf16x8*)(kp+j*2048+512); }
__device__ __forceinline__ s16x4 vtr(lds_cptr p){ return __builtin_bit_cast(s16x4,__builtin_amdgcn_ds_read_tr16_b64_v4i16((__attribute__((address_space(3))) v4i16_t*)p)); }
__device__ __forceinline__ float rowmax(const f32x16&p0,const f32x16&p1){
  float a=max3f(p0[0],p0[1],p1[0]),b=max3f(p0[2],p0[3],p1[1]);a=max3f(a,p1[2],p1[3]);
  #pragma unroll
  for(int r=4;r<16;r+=4){a=max3f(a,p0[r],p0[r+1]);b=max3f(b,p0[r+2],p0[r+3]);a=max3f(a,p1[r],p1[r+1]);b=max3f(b,p1[r+2],p1[r+3]);}
  const float m=max2f(a,b);
  auto rr=__builtin_amdgcn_permlane32_swap(__float_as_uint(m),__float_as_uint(m),false,false);
  return max2f(__uint_as_float(rr[0]),__uint_as_float(rr[1]));
}
__device__ __forceinline__ void pv(f32x16*o,int vb,bf16x8 pa0,bf16x8 pa1,bf16x8 pa2,bf16x8 pa3){
  #pragma unroll
  for(int d0=0;d0<2;++d0){s16x4 lo[4],hi[4];
    #pragma unroll
    for(int ks=0;ks<4;++ks){
      asm volatile("ds_read_b64_tr_b16 %0,%1 offset:%c2":"=&v"(lo[ks]):"v"(vb),"i"(d0*4096+ks*1024):"memory");
      asm volatile("ds_read_b64_tr_b16 %0,%1 offset:%c2":"=&v"(hi[ks]):"v"(vb),"i"(d0*4096+ks*1024+512):"memory");}
    asm volatile("s_waitcnt lgkmcnt(0)":::"memory");SBAR();
    #define PK(k) (bf16x8){lo[k][0],lo[k][1],lo[k][2],lo[k][3],hi[k][0],hi[k][1],hi[k][2],hi[k][3]}
    o[d0]=__builtin_amdgcn_mfma_f32_32x32x16_bf16(pa0,PK(0),o[d0],0,0,0);
    o[d0]=__builtin_amdgcn_mfma_f32_32x32x16_bf16(pa1,PK(1),o[d0],0,0,0);
    o[d0]=__builtin_amdgcn_mfma_f32_32x32x16_bf16(pa2,PK(2),o[d0],0,0,0);
    o[d0]=__builtin_amdgcn_mfma_f32_32x32x16_bf16(pa3,PK(3),o[d0],0,0,0);
    #undef PK
  }
}

#ifndef ATTN_STORE16
#define ATTN_STORE16(p,v) (*(u32x4*)(p)=(v))
#endif
template<int THRL> __device__ __forceinline__ void attn_unit(const bf16*Qu,const bf16*__restrict__ Kh,const bf16*__restrict__ Vh,bf16*Ou,const int NT,char*shm){
  const int tid=threadIdx.x,lane=tid&63,r32=lane&31,hi=lane>>5; const int wid=__builtin_amdgcn_readfirstlane(tid>>6);
  const bf16*Qw=Qu+(long)(wid*QBLK)*QP;
  const unsigned lds0=(unsigned)(uintptr_t)shm;
  float*wsf=(float*)(shm+LDS_WS)+wid*64;
  const bf16*ksrc=Kh+(long)lane*KP+wid*8;
  const bf16*vsrc=Vh+(long)(16*(wid&3)+(lane>>2))*KP+(wid>>2)*32+(lane&3)*8;
  const unsigned kdst=lds0+LDS_K+wid*1024, vdst=lds0+LDS_V+wid*1024;
  #define DMA_K(t,slot) glds16(ksrc+(long)(t)*KVBLK*KP,(unsigned)__builtin_amdgcn_readfirstlane(kdst+(slot)))
  #define DMA_V(t,slot) glds16(vsrc+(long)(t)*KVBLK*KP,(unsigned)__builtin_amdgcn_readfirstlane(vdst+(slot)))
  const int vb0=(int)(lds0+LDS_V)+((lane>>4)&1)*32+(lane&3)*8+(4*hi+((lane&15)>>2))*64;
  const char*Kbase=shm+LDS_K; bf16x8 kf[8];
  const lds_cptr shm3=(lds_cptr)shm; const lds_cptr kp0=shm3+LDS_K+hi*1024+r32*16; const lds_cptr vp0=shm3+LDS_V+((lane>>4)&1)*32+(lane&3)*8+(4*hi+((lane&15)>>2))*64;
  DMA_K(0,0);DMA_V(0,0);DMA_K(1,SLOTB);
  bf16x8 qr[4];
  #pragma unroll
  for(int d0=0;d0<4;++d0)qr[d0]=*reinterpret_cast<const bf16x8*>(&Qw[(long)r32*QP+d0*16+hi*8]);
  float mhat=0.f,l_reg=0.f;f32x16 o[2];o[0]=f32x16{};o[1]=f32x16{};f32x16 negm=f32x16{};asm volatile("":"+v"(negm));
  #define CMASK(P0,P1,t) do{}while(0)
  bool resc=false;
  #define START(P0,P1) do{ const float rm=rowmax(P0,P1); resc=false; \
    { const float dl=rm; mhat=fadd_s(mhat,dl); \
      _Pragma("unroll") for(int r=0;r<16;++r){P0[r]=fsub_s(P0[r],dl);P1[r]=fsub_s(P1[r],dl);} \
      _Pragma("unroll") for(int r=0;r<16;++r)negm[r]=-mhat; asm volatile("":"+v"(negm)); } \
    _Pragma("unroll") for(int r=0;r<16;++r)P0[r]=__builtin_amdgcn_exp2f(P0[r]); }while(0)
  #define RESC() do{ if(resc){ asm volatile("s_waitcnt lgkmcnt(0)":::"memory"); \
      _Pragma("unroll") for(int d_=0;d_<2;++d_) _Pragma("unroll") for(int r=0;r<16;++r)o[d_][r]*=wsf[crow(r,hi)]; } }while(0)
  f32x16 pA0,pA1,pB0,pB1;
  int sl_prev=0,sl_cur=0,sl_next=SLOTB;
  #define ROT() do{sl_prev=sl_cur;sl_cur=sl_next;sl_next=(sl_next==(NSLOT-1)*SLOTB)?0:sl_next+SLOTB;}while(0)
  DMA_K(2,2*SLOTB);
  WAIT_BAR(3);
  qkt(pA0,pA1,Kbase,qr,negm,r32,hi);asm volatile("s_nop 15\n\ts_nop 7":"+v"(pA0),"+v"(pA1));CMASK(pA0,pA1,0);
  START(pA0,pA1);
  _Pragma("unroll") for(int r=0;r<16;++r)pA1[r]=__builtin_amdgcn_exp2f(pA1[r]);
  WAIT_BAR(0);
  DMA_K(3,0);DMA_V(1,SLOTB);
  ROT();
  kload8(kf,kp0+sl_cur);
  WAIT_BAR(2);
  s16x4 vlo[8],vhi[8]; u32x4 pw0,pw1,pw2,pw3;
  #define PKW(P,B) cvtpk_s(P[B],P[B+1])
  #define PAF(k) __builtin_bit_cast(bf16x8,pw##k)
  #define VFR(i) (bf16x8){vlo[i][0],vlo[i][1],vlo[i][2],vlo[i][3],vhi[i][0],vhi[i][1],vhi[i][2],vhi[i][3]}
  #define PIN(x) asm volatile("":"+v"(x))
  #define MX3(a,b,c) __builtin_fmaxf(__builtin_fmaxf((a),(b)),(c))
  #define GAPA(MF,A0,A1,A2,A3,W0,W1,PW) do{ MF; sacc+=A0; sacc+=A1; sacc+=A2; sacc+=A3; PIN(sacc); W0; W1; PIN(PW); SBAR(); }while(0)
  #define EX(v) __builtin_amdgcn_exp2f(v)
  #define GAPB(MF,X,B) do{ MF; X[B]=EX(X[B]); X[B+1]=EX(X[B+1]); X[B+2]=EX(X[B+2]); X[B+3]=EX(X[B+3]); PIN(X); SBAR(); }while(0)
  #define VRD(i) do{ vlo[i]=vtr(vp_+(((i)>>2)*4096+((i)&3)*1024)); vhi[i]=vtr(vp_+(((i)>>2)*4096+((i)&3)*1024+512)); }while(0)
  #define KRD(G,j) do{ if(G){ kload2(kf,kp0+sl_next,j); SBAR(); } }while(0)
  #define STEP(C0,C1,P0,P1,t,GK,GV,GL) do{ SBAR(); \
    const lds_cptr vp_=vp0+sl_prev; \
    VRD(0); SBAR(); float sacc=(P0[0]+P0[1]); \
    GAPA(C0=__builtin_amdgcn_mfma_f32_32x32x16_bf16(kf[0],qr[0],negm,0,0,0), P0[2],P0[3],P0[4],P0[5],     pw0[0]=PKW(P0,0), pw0[1]=PKW(P0,2), pw0); \
    VRD(4); SBAR(); GAPA(C1=__builtin_amdgcn_mfma_f32_32x32x16_bf16(kf[1],qr[0],negm,0,0,0), P0[6],P0[7],P0[8],P0[9],     pw0[2]=PKW(P0,4), pw0[3]=PKW(P0,6), pw0); \
    VRD(1); SBAR(); GAPA(C0=__builtin_amdgcn_mfma_f32_32x32x16_bf16(kf[2],qr[1],C0,0,0,0),   P0[10],P0[11],P0[12],P0[13], pw1[0]=PKW(P0,8), pw1[1]=PKW(P0,10), pw1); \
    VRD(5); SBAR(); GAPA(C1=__builtin_amdgcn_mfma_f32_32x32x16_bf16(kf[3],qr[1],C1,0,0,0),   P0[14],P0[15],P1[0],P1[1],   pw1[2]=PKW(P0,12),pw1[3]=PKW(P0,14), pw1); \
    VRD(2); SBAR(); GAPA(C0=__builtin_amdgcn_mfma_f32_32x32x16_bf16(kf[4],qr[2],C0,0,0,0),   P1[2],P1[3],P1[4],P1[5],     pw2[0]=PKW(P1,0), pw2[1]=PKW(P1,2), pw2); \
    VRD(6); SBAR(); GAPA(C1=__builtin_amdgcn_mfma_f32_32x32x16_bf16(kf[5],qr[2],C1,0,0,0),   P1[6],P1[7],P1[8],P1[9],     pw2[2]=PKW(P1,4), pw2[3]=PKW(P1,6), pw2); \
    VRD(3); SBAR(); GAPA(C0=__builtin_amdgcn_mfma_f32_32x32x16_bf16(kf[6],qr[3],C0,0,0,0),   P1[10],P1[11],P1[12],P1[13], pw3[0]=PKW(P1,8), pw3[1]=PKW(P1,10), pw3); \
    VRD(7); SBAR(); GAPA(C1=__builtin_amdgcn_mfma_f32_32x32x16_bf16(kf[7],qr[3],C1,0,0,0),   P1[14],P1[15],0.f,0.f,       pw3[2]=PKW(P1,12),pw3[3]=PKW(P1,14), pw3); \
    l_reg+=sacc; \
    if(GK){DMA_K((t)+3,sl_cur);} if(GV){DMA_V((t)+1,sl_next);} \
    CMASK(C0,C1,t); \
    { float a=MX3(C0[0],C0[1],C1[0]),b=MX3(C0[2],C0[3],C1[1]); a=MX3(a,C1[2],C1[3]); \
      _Pragma("unroll") for(int r=4;r<16;r+=4){a=MX3(a,C0[r],C0[r+1]);b=MX3(b,C0[r+2],C0[r+3]);a=MX3(a,C1[r],C1[r+1]);b=MX3(b,C1[r+2],C1[r+3]);} \
      float rm=__builtin_fmaxf(a,b); { auto rr=__builtin_amdgcn_permlane32_swap(__float_as_uint(rm),__float_as_uint(rm),false,false); rm=__builtin_fmaxf(__uint_as_float(rr[0]),__uint_as_float(rr[1])); } \
      resc=false; \
      if(__builtin_expect(__any(rm>(float)THRL),0)){ const float dl=__builtin_fmaxf(rm,0.f); mhat+=dl; \
        _Pragma("unroll") for(int r=0;r<16;++r){C0[r]-=dl;C1[r]-=dl;} \
        _Pragma("unroll") for(int r=0;r<16;++r)negm[r]=-mhat; asm volatile("":"+v"(negm)); \
        const float f=__builtin_amdgcn_exp2f(-dl); l_reg*=f; if(hi==0)wsf[r32]=f; resc=true; } } \
    SBAR(); \
    GAPB(o[0]=__builtin_amdgcn_mfma_f32_32x32x16_bf16(PAF(0),VFR(0),o[0],0,0,0), C0,0); \
    GAPB(o[1]=__builtin_amdgcn_mfma_f32_32x32x16_bf16(PAF(0),VFR(4),o[1],0,0,0), C0,4); \
    KRD(GL,0); GAPB(o[0]=__builtin_amdgcn_mfma_f32_32x32x16_bf16(PAF(1),VFR(1),o[0],0,0,0), C0,8); \
    KRD(GL,1); GAPB(o[1]=__builtin_amdgcn_mfma_f32_32x32x16_bf16(PAF(1),VFR(5),o[1],0,0,0), C0,12); \
    KRD(GL,2); GAPB(o[0]=__builtin_amdgcn_mfma_f32_32x32x16_bf16(PAF(2),VFR(2),o[0],0,0,0), C1,0); \
    KRD(GL,3); GAPB(o[1]=__builtin_amdgcn_mfma_f32_32x32x16_bf16(PAF(2),VFR(6),o[1],0,0,0), C1,4); \
    GAPB(o[0]=__builtin_amdgcn_mfma_f32_32x32x16_bf16(PAF(3),VFR(3),o[0],0,0,0), C1,8); \
    GAPB(o[1]=__builtin_amdgcn_mfma_f32_32x32x16_bf16(PAF(3),VFR(7),o[1],0,0,0), C1,12); \
    }while(0)
  int t=1;
  for(;t+5<NT;t+=2){
    STEP(pB0,pB1,pA0,pA1,t,true,true,true);     WAIT_BAR(2); RESC(); ROT();
    STEP(pA0,pA1,pB0,pB1,t+1,true,true,true);   WAIT_BAR(2); RESC(); ROT();
  }
  #define ENDW(tt) do{ if((tt)+3<NT){WAIT_BAR(2);} else if((tt)+2<NT){WAIT_BAR(1);} else {WAIT_BAR(0);} }while(0)
  for(;t+1<NT;t+=2){
    STEP(pB0,pB1,pA0,pA1,t,(t+3<NT),(t+1<NT),(t+1<NT));       ENDW(t);   RESC(); ROT();
    STEP(pA0,pA1,pB0,pB1,t+1,(t+4<NT),(t+2<NT),(t+2<NT));     ENDW(t+1); RESC(); ROT();
  }
  STEP(pB0,pB1,pA0,pA1,NT-1,false,false,false); RESC();
  { float sacc=pB0[0]+pB0[1]; _Pragma("unroll") for(int r=2;r<16;++r)sacc+=pB0[r]; _Pragma("unroll") for(int r=0;r<16;++r)sacc+=pB1[r]; l_reg+=sacc;
    pw0=(u32x4){PKW(pB0,0),PKW(pB0,2),PKW(pB0,4),PKW(pB0,6)};pw1=(u32x4){PKW(pB0,8),PKW(pB0,10),PKW(pB0,12),PKW(pB0,14)};pw2=(u32x4){PKW(pB1,0),PKW(pB1,2),PKW(pB1,4),PKW(pB1,6)};pw3=(u32x4){PKW(pB1,8),PKW(pB1,10),PKW(pB1,12),PKW(pB1,14)};
    SBAR(); pv(o,vb0+sl_cur,PAF(0),PAF(1),PAF(2),PAF(3)); }
  #undef PKW
  #undef PAF
  #undef VFR
  #undef PIN
  #undef MX3
  #undef GAPA
  #undef GAPB
  #undef EX
  #undef VRD
  #undef KRD
  #undef STEP
  #undef ENDW
  {auto rr=__builtin_amdgcn_permlane32_swap(__float_as_uint(l_reg),__float_as_uint(l_reg),false,false);l_reg=__uint_as_float(rr[0])+__uint_as_float(rr[1]);}
  if(hi==0)wsf[32+r32]=l_reg;asm volatile("s_waitcnt lgkmcnt(0)":::"memory");
  float rli[16];
  #pragma unroll
  for(int r=0;r<16;++r)rli[r]=__builtin_amdgcn_rcpf(wsf[32+crow(r,hi)]);
  bf16*Ow=Ou+(long)(wid*QBLK)*OP;
  { bf16*stg=(bf16*)(shm+LDS_OST)+wid*2048;
    #pragma unroll
    for(int r=0;r<16;++r){const int orow=crow(r,hi);
      #pragma unroll
      for(int d0=0;d0<2;++d0)stg[orow*64+d0*32+r32]=__float2bfloat16(o[d0][r]*rli[r]);}
    asm volatile("s_waitcnt lgkmcnt(0)":::"memory");
    #pragma unroll
    for(int i=0;i<4;++i){const int row=i*8+(lane>>3),ch=lane&7; const u32x4 v=*(const u32x4*)(stg+row*64+ch*8); ATTN_STORE16(Ow+(long)row*OP+ch*8,v);} }
  asm volatile("s_waitcnt lgkmcnt(0)\n\ts_barrier":::"memory");
  #undef DMA_K
  #undef DMA_V
  #undef CMASK
  #undef START
  #undef RESC
  #undef ROT
}
constexpr int ATTN_LDS_BYTES=LDS_BYTES;
#undef SBAR
#undef WAIT_BAR
}
#define GAS __attribute__((address_space(1)))
#define LAS __attribute__((address_space(3)))
typedef unsigned short bf16;
typedef unsigned v4u __attribute__((ext_vector_type(4)));
typedef unsigned v2u __attribute__((ext_vector_type(2)));
typedef float f32x4 __attribute__((ext_vector_type(4)));
typedef short bf16x8 __attribute__((ext_vector_type(8)));
constexpr int NWAVES = 8, NTHREADS = 512;
constexpr int RING_BYTES = 131072, LDS_BYTES = 147456;
#define LDS_WAIT() asm volatile("s_waitcnt lgkmcnt(0)" ::: "memory")
#define VM_WAIT() asm volatile("s_waitcnt vmcnt(0)" ::: "memory")
__device__ __forceinline__ unsigned f2bf(float f) { unsigned u = __builtin_bit_cast(unsigned, f); return (u + 0x7fffu + ((u >> 16) & 1u)) >> 16; }
__device__ __forceinline__ unsigned pk2(float lo, float hi) { return f2bf(lo) | (f2bf(hi) << 16); }
__device__ __forceinline__ float bf2f(unsigned short b) { return __builtin_bit_cast(float, ((unsigned)b) << 16); }
__device__ __forceinline__ float sigmoidf_(float x) { return 1.0f / (1.0f + __expf(-x)); }
__device__ __forceinline__ float siluf_(float x) { return x * sigmoidf_(x); }
__device__ __forceinline__ float wave_sum(float v) {
#pragma unroll
    for (int o = 1; o < 64; o <<= 1) v += __shfl_xor(v, o);
    return v;
}

constexpr size_t MiB = 1u << 20;
constexpr size_t WS_CTL = 0, WS_MOD = 1 * MiB;
constexpr size_t WS_WIN = 2 * MiB, WIN_BYTES = (size_t)PP * D * 2;
constexpr size_t WS_WOUT = WS_WIN + 2 * WIN_BYTES, WOUT_BYTES = (size_t)D * D * 2;
constexpr size_t WS_WUP = WS_WOUT + 2 * WOUT_BYTES, WUP_BYTES = (size_t)DFF * D * 2;
constexpr size_t WS_WDN = WS_WUP + 2 * WUP_BYTES, WDN_BYTES = (size_t)D * DFF * 2;
constexpr size_t WS_WPW = WS_WDN + 2 * WDN_BYTES, WPW_BYTES = (size_t)256 * 256 * 2;
static_assert(WS_WPW + 2 * WPW_BYTES <= 50 * MiB, "weights");
constexpr size_t WS_XC = 50 * MiB;
constexpr size_t WS_ACT = 54 * MiB;
constexpr size_t WS_P = 88 * MiB;
constexpr size_t WS_H = 88 * MiB;
constexpr size_t WS_QA = 182 * MiB;
constexpr size_t WS_KA = 191 * MiB, WS_VA = 196 * MiB;
constexpr size_t WS_KV = 201 * MiB;
constexpr size_t WS_DEC = 235 * MiB;
constexpr size_t WS_END = 256 * MiB;
static_assert(WS_P + (size_t)M * PP * 2 <= WS_QA && WS_H + (size_t)M * DFF * 2 <= WS_END && WS_ACT + (size_t)M * D * 2 <= WS_P, "ws map");

struct Args { const float* in[27]; float* out; unsigned char* ws; int ph_lo, ph_hi, layer, pad; };

template <class Map> __device__ __forceinline__ void transpose_item(const float* W, int K, int N, bf16* WT, LAS float* scr, int kb, int nb, int lane, Map srcc) {
    const int k0 = 64 * kb, n0 = 32 * nb; const int sc = srcc(n0 + (lane & 31));
#pragma unroll 8
    for (int i = 0; i < 32; ++i) { const int kk = 2 * i + (lane >> 5); scr[kk * 33 + (lane & 31)] = sc >= 0 ? W[(size_t)(k0 + kk) * N + sc] : 0.f; }
    LDS_WAIT(); asm volatile("" ::: "memory");
    const int c = lane & 7;
#pragma unroll
    for (int j = 0; j < 4; ++j) { const int n = (lane >> 3) + 8 * j; const LAS float* s = scr + (8 * c) * 33 + n;
        v4u o; o.x = pk2(s[0 * 33], s[1 * 33]); o.y = pk2(s[2 * 33], s[3 * 33]); o.z = pk2(s[4 * 33], s[5 * 33]); o.w = pk2(s[6 * 33], s[7 * 33]);
        *(GAS v4u*)(WT + (size_t)(n0 + n) * K + k0 + 8 * c) = o; }
    LDS_WAIT(); asm volatile("" ::: "memory");
}
struct MapId { __device__ __forceinline__ int operator()(int n) const { return n; } };
struct MapWin { __device__ __forceinline__ int operator()(int n) const { return n < 1280 ? n : (n < 2560 ? n + 16 : (n < 2576 ? n - 1280 : -1)); } };

__device__ __forceinline__ void ph_prologue(const Args& a, LAS unsigned char* lds, int tid, int lane, int wave, int bid, int G) {
    unsigned char* ws = a.ws;
    LAS float* scr = (LAS float*)(lds + wave * 16384);
    const int gw = bid * NWAVES + wave, NGW = G * NWAVES;
    constexpr int I_IN = (D / 64) * (PP / 32), I_OUT = (D / 64) * (D / 32), I_UP = (D / 64) * (DFF / 32), I_DN = (DFF / 64) * (D / 32), I_PW = (256 / 64) * (256 / 32);
    constexpr int I_L = I_IN + I_OUT + I_UP + I_DN + I_PW;
    for (int it = gw; it < DEPTH * I_L; it += NGW) {
        const int l = it / I_L; int r = it % I_L;
        if (r < I_IN) { transpose_item(a.in[8] + (size_t)l * D * PIN, D, PIN, (bf16*)(ws + WS_WIN + l * WIN_BYTES), scr, r / (PP / 32), r % (PP / 32), lane, MapWin()); continue; } r -= I_IN;
        if (r < I_OUT) { transpose_item(a.in[23] + (size_t)l * D * D, D, D, (bf16*)(ws + WS_WOUT + l * WOUT_BYTES), scr, r / (D / 32), r % (D / 32), lane, MapId()); continue; } r -= I_OUT;
        if (r < I_UP) { transpose_item(a.in[24] + (size_t)l * D * DFF, D, DFF, (bf16*)(ws + WS_WUP + l * WUP_BYTES), scr, r / (DFF / 32), r % (DFF / 32), lane, MapId()); continue; } r -= I_UP;
        if (r < I_DN) { transpose_item(a.in[25] + (size_t)l * DFF * D, DFF, D, (bf16*)(ws + WS_WDN + l * WDN_BYTES), scr, r / (D / 32), r % (D / 32), lane, MapId()); continue; } r -= I_DN;
        transpose_item(a.in[13] + (size_t)l * 256 * 256, 256, 256, (bf16*)(ws + WS_WPW + l * WPW_BYTES), scr, r / 8, r % 8, lane, MapId());
    }
    __syncthreads();
    LAS float* sil = (LAS float*)lds;
    LAS float* part = (LAS float*)(lds + NS * D * 4);
    float* MOD = (float*)(ws + WS_MOD);
    const float* c = a.in[1]; const float* cc = a.in[3]; const float* w_mod = a.in[4]; const float* b_mod = a.in[5];
    bool staged = false;
    for (int task = bid; task < DEPTH * (NMOD / 64); task += G) {
        if (!staged) { for (int i = tid; i < NS * D; i += NTHREADS) { const int s = i / D, k = i % D; const float v = s < NB ? c[s * D + k] : cc[k]; sil[i] = siluf_(v); } staged = true; __syncthreads(); }
        const int l = task / (NMOD / 64), c0 = (task % (NMOD / 64)) * 64;
        float acc[NS];
#pragma unroll
        for (int s = 0; s < NS; ++s) acc[s] = 0.f;
        const float* wp = w_mod + (size_t)l * D * NMOD + (size_t)(wave * 128) * NMOD + c0 + lane;
#pragma unroll 4
        for (int k = 0; k < 128; ++k) { const float wv = wp[(size_t)k * NMOD];
#pragma unroll
            for (int s = 0; s < NS; ++s) acc[s] += sil[s * D + wave * 128 + k] * wv; }
#pragma unroll
        for (int s = 0; s < NS; ++s) part[(wave * NS + s) * 64 + lane] = acc[s];
        __syncthreads();
        if (tid < NS * 64) { const int s = tid / 64, ln = tid % 64; float v = 0.f;
#pragma unroll
            for (int w = 0; w < 8; ++w) v += part[(w * NS + s) * 64 + ln];
            MOD[((size_t)l * NS + s) * NMOD + c0 + ln] = v + b_mod[(size_t)l * NMOD + c0 + ln]; }
        __syncthreads();
    }
}
__device__ __forceinline__ void ph_normmod(const float* xl, const float* xc, const float* g, const float* mod, int i_shift, int i_scale, bf16* XN, int nrows, int lane, int gw, int NGW) {
    for (int r = gw; r < nrows; r += NGW) {
        const float* xr = r < ML ? xl + (size_t)r * D : xc + (size_t)(r - ML) * D;
        const float* m = mod + (size_t)(r < ML ? r / SEQ : NB) * NMOD;
        f32x4 v[4]; float s = 0.f;
#pragma unroll
        for (int j = 0; j < 4; ++j) { v[j] = *(const f32x4*)(xr + 4 * lane + 256 * j); s += (v[j].x * v[j].x + v[j].y * v[j].y) + (v[j].z * v[j].z + v[j].w * v[j].w); }
        const float rs = 1.0f / sqrtf(wave_sum(s) * (1.0f / D) + EPS);
#pragma unroll
        for (int j = 0; j < 4; ++j) { const int c0 = 4 * lane + 256 * j;
            const f32x4 gg = *(const f32x4*)(g + c0), sc = *(const f32x4*)(m + i_scale * D + c0), sh = *(const f32x4*)(m + i_shift * D + c0);
            const f32x4 o = v[j] * rs * gg * (sc + 1.0f) + sh;
            v2u w; w.x = pk2(o.x, o.y); w.y = pk2(o.z, o.w); *(v2u*)(XN + (size_t)r * D + c0) = w; }
    }
}
__device__ __forceinline__ void ph_final(float* x, const float* g, int lane, int gw, int NGW) {
    for (int r = gw; r < ML; r += NGW) {
        float* xr = x + (size_t)r * D;
        f32x4 v[4]; float s = 0.f;
#pragma unroll
        for (int j = 0; j < 4; ++j) { v[j] = *(const f32x4*)(xr + 4 * lane + 256 * j); s += (v[j].x * v[j].x + v[j].y * v[j].y) + (v[j].z * v[j].z + v[j].w * v[j].w); }
        const float rs = 1.0f / sqrtf(wave_sum(s) * (1.0f / D) + EPS);
#pragma unroll
        for (int j = 0; j < 4; ++j) { const int c0 = 4 * lane + 256 * j; *(f32x4*)(xr + c0) = v[j] * rs * *(const f32x4*)(g + c0); }
    }
}
__device__ __forceinline__ void ph_attprep(const bf16* P, const float* qg, const float* kg, bf16* QA, bf16* KA, bf16* VA, int lane, int gw, int NGW) {
    const float gq = qg[lane], gk = kg[lane];
    const int kk = lane & 31; const float inv = exp2f(-(float)(kk & 15) * (13.287712379549449f / 16.0f));
    for (int r = gw; r < M; r += NGW) {
        const bool lat = r < ML; const int b = lat ? r / SEQ : (r - ML) / CTX, t = lat ? r % SEQ : (r - ML) % CTX;
        const bf16* pr = P + (size_t)r * PP;
        float cs = 1.f, sn = 0.f;
        if (lat) { const float ang = (float)(kk < 16 ? t / GRIDW : t % GRIDW) * inv; sincosf(ang, &sn, &cs); }
        const float sgn = lane < 32 ? -1.f : 1.f;
        const size_t krow = (size_t)b * KEYS + (lat ? CTX + t : t);
#pragma unroll
        for (int h = 0; h < 6; ++h) {
            const float x = bf2f(pr[(h < 4 ? OFF_AQ + h * 64 : OFF_AK + (h - 4) * 64) + lane]);
            const float rs = 1.0f / sqrtf(wave_sum(x * x) * (1.0f / 64) + EPS);
            const float v = x * rs * (h < 4 ? gq : gk);
            const float o = v * cs + sgn * __shfl_xor(v, 32) * sn;
            if (h < 4) QA[(size_t)r * 256 + h * 64 + lane] = (bf16)f2bf(o * (0.125f * 1.4426950408889634f));
            else KA[krow * 128 + (h - 4) * 64 + lane] = (bf16)f2bf(o);
        }
        VA[krow * 128 + lane] = pr[OFF_AV + lane]; VA[krow * 128 + 64 + lane] = pr[OFF_AV + 64 + lane];
    }
}
__device__ __forceinline__ void ph_attention(const bf16* QA, const bf16* KA, const bf16* VA, bf16* Y, bool need_ctx, char* lds, int bid, int G) {
    const int vcu = (G % 8 == 0) ? (bid % 8) * (G / 8) + bid / 8 : bid;
    const int NU = 256 + (need_ctx ? 16 : 0);
    for (int u = vcu; u < NU; u += G) {
        if (u < 256) { const int b = u >> 6, h = (u >> 4) & 3, qb = u & 15; const size_t row = (size_t)b * SEQ + qb * 256;
            attn_body::attn_unit<8>((const attn_body::bf16*)(QA + row * 256 + h * 64), (const attn_body::bf16*)(KA + (size_t)b * KEYS * 128 + (h >> 1) * 64), (const attn_body::bf16*)(VA + (size_t)b * KEYS * 128 + (h >> 1) * 64),
                                    (attn_body::bf16*)(Y + row * D + 512 + h * 64), KEYS / 64, lds); }
        else { const int b = (u - 256) >> 2, h = (u - 256) & 3; const size_t row = (size_t)ML + b * CTX;
            attn_body::attn_unit<8>((const attn_body::bf16*)(QA + row * 256 + h * 64), (const attn_body::bf16*)(KA + (size_t)b * KEYS * 128 + (h >> 1) * 64), (const attn_body::bf16*)(VA + (size_t)b * KEYS * 128 + (h >> 1) * 64),
                                    (attn_body::bf16*)(Y + row * D + 512 + h * 64), CTX / 64, lds); }
    }
}
__device__ __forceinline__ void ph_conv(const bf16* P, const float* w_dw, const float* b_dw, const float* ln_g, const float* ln_b, const bf16* PwT, const float* b_pw, bf16* Y, int nrows,
                                        LAS unsigned char* lds, int tid, int lane, int wave, int bid, int G) {
    typedef float f32x4_t __attribute__((ext_vector_type(4)));
    LAS float* U = (LAS float*)lds; LAS unsigned char* Zb = lds + 96256; constexpr int ZS = 528;
    const int nunits = nrows / 64;
    if (bid >= nunits) return;
    const int ch = tid & 255, half = tid >> 8;
    float wreg[31];
#pragma unroll
    for (int j = 0; j < 31; ++j) wreg[j] = w_dw[j * 256 + ch];
    const float bdw = b_dw[ch];
    const f32x4_t lg = *(const f32x4_t*)(ln_g + 4 * lane), lb = *(const f32x4_t*)(ln_b + 4 * lane);
    bf16x8 wf[2][8];
#pragma unroll
    for (int nt = 0; nt < 2; ++nt)
#pragma unroll
        for (int ks = 0; ks < 8; ++ks) wf[nt][ks] = *(const bf16x8*)(PwT + (size_t)(32 * wave + 16 * nt + (lane & 15)) * 256 + 32 * ks + 8 * (lane >> 4));
    const f32x4_t bp0 = *(const f32x4_t*)(b_pw + 32 * wave + 4 * (lane >> 4)), bp1 = *(const f32x4_t*)(b_pw + 32 * wave + 16 + 4 * (lane >> 4));
    for (int u = bid; u < nunits; u += G) {
        const int r0 = u * 64; int base, t0, T;
        if (r0 < ML) { base = (r0 / SEQ) * SEQ; t0 = r0 % SEQ; T = SEQ; } else { const int rc = r0 - ML; base = ML + (rc / CTX) * CTX; t0 = rc % CTX; T = CTX; }
        for (int i = tid >> 5; i < 94; i += 16) {
            const int tt = t0 - 15 + i, c8 = (tid & 31) * 8;
            f32x4_t o0 = {0.f, 0.f, 0.f, 0.f}, o1 = {0.f, 0.f, 0.f, 0.f};
            if (tt >= 0 && tt < T) {
                const bf16* pr = P + (size_t)(base + tt) * PP;
                const bf16x8 av = *(const bf16x8*)(pr + OFF_CA + c8), gv = *(const bf16x8*)(pr + OFF_CG + c8);
#pragma unroll
                for (int e = 0; e < 4; ++e) { o0[e] = bf2f((unsigned short)av[e]) * sigmoidf_(bf2f((unsigned short)gv[e])); o1[e] = bf2f((unsigned short)av[4 + e]) * sigmoidf_(bf2f((unsigned short)gv[4 + e])); }
            }
            *(LAS f32x4_t*)(U + i * 256 + c8) = o0; *(LAS f32x4_t*)(U + i * 256 + c8 + 4) = o1;
        }
        __syncthreads();
        float y[32];
        {
            float uu[62];
#pragma unroll
            for (int i = 0; i < 62; ++i) uu[i] = U[(32 * half + i) * 256 + ch];
#pragma unroll
            for (int t = 0; t < 32; ++t) { float acc = bdw;
#pragma unroll
                for (int j = 0; j < 31; ++j) acc += uu[t + j] * wreg[j];
                y[t] = acc; }
        }
        __syncthreads();
#pragma unroll
        for (int t = 0; t < 32; ++t) U[(32 * half + t) * 256 + ch] = y[t];
        __syncthreads();
#pragma unroll 2
        for (int q = 0; q < 8; ++q) { const int tok = 8 * wave + q;
            const f32x4_t v = *(LAS f32x4_t*)(U + tok * 256 + 4 * lane);
            const float mu = wave_sum((v.x + v.y) + (v.z + v.w)) * (1.0f / 256);
            const f32x4_t dv = v - mu;
            const float var = wave_sum((dv.x * dv.x + dv.y * dv.y) + (dv.z * dv.z + dv.w * dv.w)) * (1.0f / 256);
            const float rs = 1.0f / sqrtf(var + EPS);
            f32x4_t o = dv * rs * lg + lb;
#pragma unroll
            for (int e = 0; e < 4; ++e) o[e] = siluf_(o[e]);
            v2u w; w.x = pk2(o.x, o.y); w.y = pk2(o.z, o.w);
            *(LAS v2u*)(Zb + tok * ZS + 8 * lane) = w; }
        __syncthreads();
        f32x4_t acc[2][4];
#pragma unroll
        for (int nt = 0; nt < 2; ++nt)
#pragma unroll
            for (int tt = 0; tt < 4; ++tt) acc[nt][tt] = (f32x4_t){0.f, 0.f, 0.f, 0.f};
#pragma unroll
        for (int ks = 0; ks < 8; ++ks) {
            bf16x8 zf[4];
#pragma unroll
            for (int tt = 0; tt < 4; ++tt) zf[tt] = *(LAS bf16x8*)(Zb + (16 * tt + (lane & 15)) * ZS + 64 * ks + 16 * (lane >> 4));
#pragma unroll
            for (int nt = 0; nt < 2; ++nt)
#pragma unroll
                for (int tt = 0; tt < 4; ++tt) acc[nt][tt] = __builtin_amdgcn_mfma_f32_16x16x32_bf16(wf[nt][ks], zf[tt], acc[nt][tt], 0, 0, 0);
        }
#pragma unroll
        for (int tt = 0; tt < 4; ++tt) { bf16* yr = Y + (size_t)(r0 + 16 * tt + (lane & 15)) * D + 32 * wave + 4 * (lane >> 4);
            const f32x4_t a0 = acc[0][tt] + bp0, a1 = acc[1][tt] + bp1;
            v2u w0, w1; w0.x = pk2(a0.x, a0.y); w0.y = pk2(a0.z, a0.w); w1.x = pk2(a1.x, a1.y); w1.y = pk2(a1.z, a1.w);
            *(v2u*)yr = w0; *(v2u*)(yr + 16) = w1; }
        __syncthreads();
    }
}
constexpr int NSLOT = (CTX + SEQ) / 64, NCHAIN = 2 * 2 * NB * 4;
constexpr size_t WS_ROPE = 256 * 1024;
constexpr int SL_QD = 0, SL_KI = 10240, SL_SC = 20480, SL_VT = 38912, SL_ST = 48128, SL_TOT = 58368, SL_ZS = 60416, SL_OX = 64512, SL_END = 80896;
template <int MODE> __device__ __forceinline__ void scan_units(const Args& a, int l, bool need_ctx, LAS unsigned char* lds, int tid, int lane, int wave, int bid, int G) {
    typedef float f32x4_t __attribute__((ext_vector_type(4)));
    typedef float f32x2_t __attribute__((ext_vector_type(2)));
    unsigned char* ws = a.ws;
    const bf16* P = (const bf16*)(ws + WS_P); bf16* Y = (bf16*)(ws + WS_ACT);
    float* KV = (float*)(ws + WS_KV); float* DEC = (float*)(ws + WS_DEC);
    const f32x2_t* ROPE = (const f32x2_t*)(ws + WS_ROPE);
    const int slot_lo = (MODE == 3 && !need_ctx) ? 4 : 0, nsl = NSLOT - slot_lo, nunits = 2 * NB * 4 * nsl;
    const int col = lane, dir = col >> 5, d = col & 31, seg = wave, g = lane >> 4, li = lane & 15;
    for (int u = bid; u < nunits; u += G) {
        const int mixer = u / (NB * 4 * nsl), rem = u % (NB * 4 * nsl), b = rem / (4 * nsl), h = (rem / nsl) & 3, slot = slot_lo + rem % nsl;
        const bool lat = slot >= 4; const int t0 = lat ? (slot - 4) * 64 : slot * 64; const int r0 = lat ? b * SEQ + t0 : ML + b * CTX + t0;
        const int oq = mixer ? OFF_RQ : OFF_GQ, ok = mixer ? OFF_RK : OFF_GK, ov = mixer ? OFF_RV : OFF_GV, og = mixer ? OFF_RG : OFF_GR;
        float la[8];
        if (mixer == 0) {
            LAS float* zs = (LAS float*)(lds + SL_ZS) + wave * 128;
            zs[lane] = bf2f(P[(size_t)(r0 + 8 * seg + (lane >> 4)) * PP + OFF_Z + (lane & 15)]);
            zs[64 + lane] = bf2f(P[(size_t)(r0 + 8 * seg + 4 + (lane >> 4)) * PP + OFF_Z + (lane & 15)]);
            const float* wa = (dir ? a.in[17] : a.in[15]) + (size_t)l * 16 * 128 + h * 32 + d; const float ba = (dir ? a.in[18] : a.in[16])[l * 128 + h * 32 + d];
            float wv[16];
#pragma unroll
            for (int j = 0; j < 16; ++j) wv[j] = wa[j * 128];
            LDS_WAIT();
#pragma unroll
            for (int i = 0; i < 8; ++i) { float pre = ba;
#pragma unroll
                for (int j = 0; j < 16; ++j) pre += zs[i * 16 + j] * wv[j];
                la[i] = (fminf(pre, 0.f) - log1pf(expf(-fabsf(pre)))) * (1.0f / 16.0f); }
        } else {
            const float lg = log1pf(-exp2f(-5.0f - (float)h));
#pragma unroll
            for (int i = 0; i < 8; ++i) la[i] = lg;
        }
        float cum[8];
        if (dir == 0) { float r = 0.f;
#pragma unroll
            for (int i = 0; i < 8; ++i) { r += la[i]; cum[i] = r; } ((LAS float*)(lds + SL_TOT))[seg * 64 + col] = r; }
        else { float r = 0.f;
#pragma unroll
            for (int i = 7; i >= 0; --i) { r += la[i]; cum[i] = r; } ((LAS float*)(lds + SL_TOT))[seg * 64 + col] = r; }
        float qv[8], kv[8];
#pragma unroll
        for (int i = 0; i < 8; ++i) { const bf16* pr = P + (size_t)(r0 + 8 * seg + i) * PP;
            float q = bf2f(pr[oq + h * 32 + d]), k = bf2f(pr[ok + h * 32 + d]);
            if (mixer == 0) q *= 0.17677669529663687f;
            else { k *= 0.17677669529663687f;
                if (lat) { const float qp = bf2f(pr[oq + h * 32 + (d ^ 16)]), kp = bf2f(pr[ok + h * 32 + (d ^ 16)]) * 0.17677669529663687f;
                    const f32x2_t cs = ROPE[(size_t)(t0 + 8 * seg + i) * 16 + (d & 15)]; const float sg = d < 16 ? -1.f : 1.f;
                    q = q * cs.x + sg * qp * cs.y; k = k * cs.x + sg * kp * cs.y; } }
            qv[i] = q; kv[i] = k; }
        { v4u w; unsigned short vv[8];
#pragma unroll
            for (int i = 0; i < 8; ++i) vv[i] = P[(size_t)(r0 + 8 * wave + i) * PP + ov + h * 64 + lane];
            w.x = vv[0] | ((unsigned)vv[1] << 16); w.y = vv[2] | ((unsigned)vv[3] << 16); w.z = vv[4] | ((unsigned)vv[5] << 16); w.w = vv[6] | ((unsigned)vv[7] << 16);
            *(LAS v4u*)(lds + SL_VT + lane * 144 + wave * 16) = w; }
        const int chain_f = ((mixer * 2 + 0) * NB + b) * 4 + h, chain_b = ((mixer * 2 + 1) * NB + b) * 4 + h;
        if (MODE == 3) {
#pragma unroll
            for (int dd = 0; dd < 2; ++dd) { const float* S = KV + ((size_t)(dd ? chain_b : chain_f) * NSLOT + slot) * 2048;
                const f32x4_t s4 = *(const f32x4_t*)(S + tid * 4); v2u w; w.x = pk2(s4.x, s4.y); w.y = pk2(s4.z, s4.w);
                *(LAS v2u*)(lds + SL_ST + dd * 5120 + (tid >> 3) * 80 + (tid & 7) * 8) = w; }
        }
        __syncthreads();
        {
            const LAS float* tot = (const LAS float*)(lds + SL_TOT); float off = 0.f, total = 0.f;
#pragma unroll
            for (int s2 = 0; s2 < 8; ++s2) { const float tv = tot[s2 * 64 + col]; total += tv; if (dir == 0 ? (s2 < seg) : (s2 > seg)) off += tv; }
            if (MODE == 3) {
#pragma unroll
                for (int i = 0; i < 8; ++i) { const float c = cum[i] + off; const int s = 8 * seg + i;
                    *(LAS unsigned short*)(lds + SL_QD + dir * 5120 + s * 80 + d * 2) = (unsigned short)f2bf(qv[i] * expf(c));
                    *(LAS unsigned short*)(lds + SL_KI + dir * 5120 + s * 80 + d * 2) = (unsigned short)f2bf(kv[i] * expf(-c)); }
            } else {
                v4u w; unsigned short ke[8];
#pragma unroll
                for (int i = 0; i < 8; ++i) ke[i] = (unsigned short)f2bf(kv[i] * expf(total - (cum[i] + off)));
                w.x = ke[0] | ((unsigned)ke[1] << 16); w.y = ke[2] | ((unsigned)ke[3] << 16); w.z = ke[4] | ((unsigned)ke[5] << 16); w.w = ke[6] | ((unsigned)ke[7] << 16);
                *(LAS v4u*)(lds + SL_KI + dir * 4608 + d * 144 + seg * 16) = w;
                if (seg == 0) DEC[((size_t)(dir ? chain_b : chain_f) * NSLOT + slot) * 32 + d] = expf(total);
            }
        }
        __syncthreads();
        const int wdir = wave >> 2, wt = wave & 3;
        if (MODE == 1) {
            f32x4_t acc[2] = {(f32x4_t){0.f, 0.f, 0.f, 0.f}, (f32x4_t){0.f, 0.f, 0.f, 0.f}};
#pragma unroll
            for (int ks = 0; ks < 2; ++ks) { const bf16x8 af = *(LAS bf16x8*)(lds + SL_VT + (16 * wt + li) * 144 + 64 * ks + 16 * g);
#pragma unroll
                for (int dt = 0; dt < 2; ++dt) { const bf16x8 bfr = *(LAS bf16x8*)(lds + SL_KI + wdir * 4608 + (16 * dt + li) * 144 + 64 * ks + 16 * g);
                    acc[dt] = __builtin_amdgcn_mfma_f32_16x16x32_bf16(af, bfr, acc[dt], 0, 0, 0); } }
            float* dst = KV + ((size_t)(wdir ? chain_b : chain_f) * NSLOT + slot) * 2048;
#pragma unroll
            for (int dt = 0; dt < 2; ++dt)
#pragma unroll
                for (int r = 0; r < 4; ++r) dst[(16 * wt + 4 * g + r) * 32 + 16 * dt + li] = acc[dt][r];
        } else {
            const int ct = wt;
            const bf16x8 qf = *(LAS bf16x8*)(lds + SL_QD + wdir * 5120 + (16 * ct + li) * 80 + 16 * g);
#pragma unroll
            for (int st = 0; st < 4; ++st) {
                f32x4_t sc = {0.f, 0.f, 0.f, 0.f};
                const bool live = wdir == 0 ? (st <= ct) : (st >= ct);
                if (live) { const bf16x8 kf = *(LAS bf16x8*)(lds + SL_KI + wdir * 5120 + (16 * st + li) * 80 + 16 * g);
                    sc = __builtin_amdgcn_mfma_f32_16x16x32_bf16(kf, qf, sc, 0, 0, 0);
                    if (st == ct) {
#pragma unroll
                        for (int r = 0; r < 4; ++r) { const int s = 4 * g + r, c = li; if (wdir == 0 ? (s > c) : (s < c)) sc[r] = 0.f; } } }
                v2u w; w.x = pk2(sc[0], sc[1]); w.y = pk2(sc[2], sc[3]);
                *(LAS v2u*)(lds + SL_SC + wdir * 9216 + (16 * ct + li) * 144 + (16 * st + 4 * g) * 2) = w; }
            LDS_WAIT();
            f32x4_t acc[4];
#pragma unroll
            for (int et = 0; et < 4; ++et) acc[et] = (f32x4_t){0.f, 0.f, 0.f, 0.f};
            const bf16x8 s0 = *(LAS bf16x8*)(lds + SL_SC + wdir * 9216 + (16 * ct + li) * 144 + 16 * g), s1 = *(LAS bf16x8*)(lds + SL_SC + wdir * 9216 + (16 * ct + li) * 144 + 64 + 16 * g);
#pragma unroll
            for (int et = 0; et < 4; ++et) {
                const bf16x8 v0 = *(LAS bf16x8*)(lds + SL_VT + (16 * et + li) * 144 + 16 * g), v1 = *(LAS bf16x8*)(lds + SL_VT + (16 * et + li) * 144 + 64 + 16 * g);
                const bf16x8 stf = *(LAS bf16x8*)(lds + SL_ST + wdir * 5120 + (16 * et + li) * 80 + 16 * g);
                acc[et] = __builtin_amdgcn_mfma_f32_16x16x32_bf16(v0, s0, acc[et], 0, 0, 0);
                acc[et] = __builtin_amdgcn_mfma_f32_16x16x32_bf16(v1, s1, acc[et], 0, 0, 0);
                acc[et] = __builtin_amdgcn_mfma_f32_16x16x32_bf16(stf, qf, acc[et], 0, 0, 0); }
            LAS float* ox = (LAS float*)(lds + SL_OX) + ct * 1024;
            if (wdir == 1) {
#pragma unroll
                for (int et = 0; et < 4; ++et)
#pragma unroll
                    for (int r = 0; r < 4; ++r) ox[(et * 4 + r) * 64 + lane] = acc[et][r]; }
            __syncthreads();
            if (wdir == 0) {
                float ss = 0.f;
#pragma unroll
                for (int et = 0; et < 4; ++et)
#pragma unroll
                    for (int r = 0; r < 4; ++r) { acc[et][r] += ox[(et * 4 + r) * 64 + lane]; ss += acc[et][r] * acc[et][r]; }
                ss += __shfl_xor(ss, 16); ss += __shfl_xor(ss, 32);
                const float rs = 1.0f / sqrtf(ss * (1.0f / 64) + EPS);
                const int row = r0 + 16 * ct + li; const float* ng = (mixer ? a.in[22] : a.in[19]) + l * 256 + h * 64;
#pragma unroll
                for (int et = 0; et < 4; ++et) { const int e0 = 16 * et + 4 * g;
                    const v2u gt = *(const v2u*)(P + (size_t)row * PP + og + h * 64 + e0); const f32x4_t gn = *(const f32x4_t*)(ng + e0);
                    const float g0 = bf2f((unsigned short)(gt.x & 0xffff)), g1 = bf2f((unsigned short)(gt.x >> 16)), g2 = bf2f((unsigned short)(gt.y & 0xffff)), g3 = bf2f((unsigned short)(gt.y >> 16));
                    v2u w; w.x = pk2(acc[et][0] * rs * gn.x * siluf_(g0), acc[et][1] * rs * gn.y * siluf_(g1)); w.y = pk2(acc[et][2] * rs * gn.z * siluf_(g2), acc[et][3] * rs * gn.w * siluf_(g3));
                    *(v2u*)(Y + (size_t)row * D + (mixer ? 768 : 256) + h * 64 + e0) = w; }
            }
        }
        __syncthreads();
    }
}
__device__ __forceinline__ void ph_scan_state(unsigned char* ws, int tid, int bid, int G) {
    float* KV = (float*)(ws + WS_KV); const float* DEC = (const float*)(ws + WS_DEC);
    for (int gid = bid * NTHREADS + tid; gid < NCHAIN * 2048; gid += G * NTHREADS) {
        const int chain = gid >> 11, idx = gid & 2047, d = idx & 31, dir = (chain / (NB * 4)) & 1;
        float* kv = KV + (size_t)chain * NSLOT * 2048 + idx; const float* dc = DEC + (size_t)chain * NSLOT * 32 + d;
        float S = 0.f;
#pragma unroll 4
        for (int i = 0; i < NSLOT; ++i) {
            const int slot = dir == 0 ? i : (i < 4 ? 3 - i : NSLOT + 3 - i);
            const float kvv = kv[(size_t)slot * 2048], dv = dc[slot * 32];
            kv[(size_t)slot * 2048] = S; S = dv * S + kvv;
        }
    }
}
__device__ __forceinline__ void ph_rope_table(unsigned char* ws, int tid, int bid, int G) {
    typedef float f32x2_t __attribute__((ext_vector_type(2)));
    f32x2_t* ROPE = (f32x2_t*)(ws + WS_ROPE);
    for (int i = bid * NTHREADS + tid; i < SEQ * 16; i += G * NTHREADS) { const int t = i >> 4, k = i & 15;
        const float inv = exp2f(-(float)(k & 7) * (13.287712379549449f / 8.0f)); const float ang = (float)(k < 8 ? t / GRIDW : t % GRIDW) * inv;
        float s, c; sincosf(ang, &s, &c); ROPE[i] = (f32x2_t){c, s}; }
}
enum { PH_PROLOG = 0, PH_NORM1, PH_INPROJ, PH_ATTPREP, PH_CONV, PH_SCAN1, PH_SCAN2, PH_ATT, PH_SCAN3, PH_WOUT, PH_NORM2, PH_UP, PH_DOWN, PH_FINAL };
__global__ void __launch_bounds__(NTHREADS, 2) mk(Args a) {
    extern __shared__ __attribute__((aligned(16))) unsigned char lds_raw[];
    LAS unsigned char* lds = (LAS unsigned char*)lds_raw;
    const int tid = threadIdx.x, lane = tid & 63, wave = __builtin_amdgcn_readfirstlane(tid >> 6);
    const int bid = blockIdx.x, G = gridDim.x, gw = bid * NWAVES + wave, NGW = G * NWAVES;
    unsigned char* ws = a.ws;
    const int l = a.layer; const bool need_ctx = l < DEPTH - 1; const int nro = need_ctx ? M : ML;
    const float* mod = (const float*)(ws + WS_MOD) + (size_t)l * NS * NMOD;
    const float* xl = l == 0 ? a.in[0] : a.out; const float* xc = l == 0 ? a.in[2] : (const float*)(ws + WS_XC);
    float* XC = (float*)(ws + WS_XC);
    bf16* ACT = (bf16*)(ws + WS_ACT); bf16* P = (bf16*)(ws + WS_P); bf16* H = (bf16*)(ws + WS_H);
    const int lo = a.ph_lo, hi = a.ph_hi;
#define IN(k) (lo <= (k) && (k) < hi)
    if (IN(PH_PROLOG)) { ph_rope_table(ws, tid, bid, G); ph_prologue(a, lds, tid, lane, wave, bid, G); }
    if (IN(PH_NORM1)) { ph_normmod(xl, xc, a.in[6] + l * D, mod, 0, 1, ACT, M, lane, gw, NGW); }
    if (IN(PH_INPROJ)) { { pg8::Gemm g{ACT, (const bf16*)(ws + WS_WIN + l * WIN_BYTES), M, PP, D}; pg8::StaticOrder S; S.init(M, PP, G, bid);
            pg8::EpiStore<0> E{P, PP}; pg8::gemm_phase<pg8::EpiStore<0>, pg8::StaticOrder, true, true>(lds, g, S, E); } }
    if (IN(PH_ATTPREP)) { ph_attprep(P, a.in[20] + l * 64, a.in[21] + l * 64, (bf16*)(ws + WS_QA), (bf16*)(ws + WS_KA), (bf16*)(ws + WS_VA), lane, gw, NGW); }
    if (IN(PH_CONV)) { ph_conv(P, a.in[9] + l * 31 * 256, a.in[10] + l * 256, a.in[11] + l * 256, a.in[12] + l * 256, (const bf16*)(ws + WS_WPW + l * WPW_BYTES), a.in[14] + l * 256, ACT, nro, lds, tid, lane, wave, bid, G); }
    if (IN(PH_SCAN1)) { scan_units<1>(a, l, need_ctx, lds, tid, lane, wave, bid, G); }
    if (IN(PH_SCAN2)) { ph_scan_state(ws, tid, bid, G); }
    if (IN(PH_ATT)) { ph_attention((const bf16*)(ws + WS_QA), (const bf16*)(ws + WS_KA), (const bf16*)(ws + WS_VA), ACT, need_ctx, (char*)lds_raw, bid, G); }
    if (IN(PH_SCAN3)) { scan_units<3>(a, l, need_ctx, lds, tid, lane, wave, bid, G); }
    if (IN(PH_WOUT)) { { pg8::Gemm g{ACT, (const bf16*)(ws + WS_WOUT + l * WOUT_BYTES), nro, D, D}; pg8::StaticOrder S; S.init(nro, D, G, bid);
            pg8::EpiResid E{xl, xc, a.out, XC, mod + 2 * D}; pg8::gemm_phase<pg8::EpiResid, pg8::StaticOrder, true, true>(lds, g, S, E); } }
    if (IN(PH_NORM2)) { ph_normmod(a.out, XC, a.in[7] + l * D, mod, 3, 4, ACT, nro, lane, gw, NGW); }
    if (IN(PH_UP)) { { pg8::Gemm g{ACT, (const bf16*)(ws + WS_WUP + l * WUP_BYTES), nro, DFF, D}; pg8::StaticOrder S; S.init(nro, DFF, G, bid);
            pg8::EpiStore<2> E{H, DFF}; pg8::gemm_phase<pg8::EpiStore<2>, pg8::StaticOrder, true, true>(lds, g, S, E); } }
    if (IN(PH_DOWN)) { { pg8::Gemm g{H, (const bf16*)(ws + WS_WDN + l * WDN_BYTES), nro, D, DFF}; pg8::StaticOrder S; S.init(nro, D, G, bid);
            pg8::EpiResid E{a.out, XC, a.out, XC, mod + 5 * D}; pg8::gemm_phase<pg8::EpiResid, pg8::StaticOrder, true, true>(lds, g, S, E); } }
    if (IN(PH_FINAL)) { ph_final(a.out, a.in[26], lane, gw, NGW); }
#undef IN
}
extern "C" void kernel_launch(void* const* d_in, const int* in_sizes, int n_in, void* d_out, int out_size, void* d_ws, size_t ws_size, hipStream_t stream) {
    static int grid = 0;
    if (grid == 0) {
        if (n_in != 27 || in_sizes[0] != ML * D || out_size != ML * D || ws_size < WS_END) { fprintf(stderr, "kernel_launch: unexpected shapes / workspace (n_in %d, ws %zu)\n", n_in, ws_size); grid = -1; return; }
        int dev = 0, cus = 0;
        if (hipGetDevice(&dev) != hipSuccess || hipDeviceGetAttribute(&cus, hipDeviceAttributeMultiprocessorCount, dev) != hipSuccess) { grid = -1; return; }
        if (hipFuncSetAttribute((const void*)mk, hipFuncAttributeMaxDynamicSharedMemorySize, LDS_BYTES) != hipSuccess) { fprintf(stderr, "kernel_launch: hipFuncSetAttribute failed\n"); grid = -1; return; }
        grid = cus;
    }
    if (grid < 0) return;
    Args a{};
    for (int i = 0; i < 27; ++i) a.in[i] = (const float*)d_in[i];
    a.out = (float*)d_out; a.ws = (unsigned char*)d_ws;
    auto run = [&](int ph, int l) { a.ph_lo = ph; a.ph_hi = ph + 1; a.layer = l; hipLaunchKernelGGL(mk, dim3(grid), dim3(NTHREADS), LDS_BYTES, stream, a); };
    char* ws = (char*)d_ws;
    run(PH_PROLOG, 0);
    for (int l = 0; l < DEPTH; ++l) {
        const bool need_ctx = l < DEPTH - 1; const int nro = need_ctx ? M : ML;
        run(PH_NORM1, l);
        run(PH_INPROJ, l);
        run(PH_CONV, l);
        run(PH_ATTPREP, l); run(PH_SCAN1, l); run(PH_SCAN2, l); run(PH_ATT, l); run(PH_SCAN3, l);
        run(PH_WOUT, l); run(PH_NORM2, l); run(PH_UP, l); run(PH_DOWN, l);
    }
    run(PH_FINAL, 0);
}
```

```cpp
#include <hip/hip_runtime.h>
#include <hip/hip_cooperative_groups.h>
#include <cstdio>
#include <cstdint>
namespace cg = cooperative_groups;

constexpr int D = 1024, NB = 4, SEQ = 4096, CTX = 256, DFF = 4096, DEPTH = 2, GRIDW = 64;
constexpr int ML = NB * SEQ, MC = NB * CTX, M = ML + MC, NS = NB + 1, NMOD = 6 * D;
constexpr int PIN = 2576;
constexpr int PP = 2816;
constexpr int OFF_CA = 0, OFF_CG = 256, OFF_GQ = 512, OFF_GK = 640, OFF_GV = 768, OFF_GR = 1024, OFF_AQ = 1280, OFF_AK = 1536, OFF_AV = 1664,
              OFF_RQ = 1792, OFF_RK = 1920, OFF_RV = 2048, OFF_RG = 2304, OFF_Z = 2560;
constexpr float EPS = 1e-6f;
constexpr int KEYS = CTX + SEQ;
namespace pg8 {
#define PG8_LAS __attribute__((address_space(3)))
typedef unsigned short bf16_t;
typedef short bf16x8 __attribute__((ext_vector_type(8)));
typedef float f32x4 __attribute__((ext_vector_type(4)));
typedef unsigned u32x4 __attribute__((ext_vector_type(4)));
constexpr int BM = 256, BK = 64, HALF = 128, HTB = HALF * BK * 2  , STAGE_BYTES = 8 * HTB, NXCD = 8, WGM = 8;

__host__ __device__ __forceinline__ int lds_byte(int r, int c) { const int st = (r >> 4) * 2 + (c >> 5), rr = r & 15, cc = c & 31, ob = rr * 64 + cc * 2; return st * 1024 + (ob ^ (((ob >> 9) & 1) << 5)); }
__host__ __device__ __forceinline__ void stage_rc(int b, int& R, int& C) { const int st = b / 1024, sb = b % 1024, swz = sb ^ (((sb >> 9) & 1) << 5); R = (st >> 1) * 16 + swz / 64; C = (st & 1) * 32 + (swz % 64) / 2; }
__host__ __device__ __forceinline__ int perm32(int rho) { const int n = rho >> 4, i = rho & 15; return 8 * (i >> 2) + 4 * n + (i & 3); }

struct Unit { int pm, pn; };
struct Gemm { const bf16_t* A; const bf16_t* Bt; int M, N, K; };

struct StaticOrder {
    int nM, nN, nwg, G, c;
    __host__ __device__ void init(int M, int N, int G_, int c_) { nM = M / BM; nN = N / BM; nwg = nM * nN; G = G_; c = c_; }
    __host__ __device__ bool next(int i, Unit& u) const {
        const long L = (long)i * G + c; if (L >= nwg) return false;
        int wgid = (int)L; { const int q = nwg / NXCD, r = nwg % NXCD, xcd = wgid % NXCD, off = wgid / NXCD; wgid = (xcd < r ? xcd * (q + 1) : r * (q + 1) + (xcd - r) * q) + off; }
        const int nig = WGM * nN, gid = wgid / nig, fm = gid * WGM, gsz = (nM - fm) < WGM ? (nM - fm) : WGM;
        u.pm = fm + ((wgid % nig) % gsz); u.pn = (wgid % nig) / gsz; return true;
    }
    __device__ __forceinline__ void a_ready(const Unit&) const {}
    __device__ __forceinline__ void done(const Unit&) const {}
};

__device__ __forceinline__ unsigned cvt_pk_bf16(float lo, float hi) { unsigned r; asm volatile("v_cvt_pk_bf16_f32 %0, %1, %2" : "=v"(r) : "v"(lo), "v"(hi)); return r; }
typedef float f32x2 __attribute__((ext_vector_type(2)));
__device__ __forceinline__ f32x2 gelu_pk(f32x2 v) {
    const f32x2 av = __builtin_elementwise_abs(v), d = av * 0.2316418882f + 1.0f;
    f32x2 t; t.x = __builtin_amdgcn_rcpf(d.x); t.y = __builtin_amdgcn_rcpf(d.y);
    f32x2 q = t * 0.5307027145f + (-0.7265760135f); q = q * t + 0.7107068705f; q = q * t + (-0.142248368f); q = q * t + 0.127414796f; q = q * t;
    const f32x2 s = (v * v) * (-0.72134752044f);
    f32x2 e; e.x = __builtin_amdgcn_exp2f(s.x); e.y = __builtin_amdgcn_exp2f(s.y);
    const f32x2 m = v * (q * e), r = v - m;
    f32x2 o; o.x = v.x < 0.f ? m.x : r.x; o.y = v.y < 0.f ? m.y : r.y; return o;
}

template <int ACT  > struct EpiBf16 {
    static constexpr bool PERM = true, AFTER_DRAIN = false; static_assert(ACT == 0 || ACT == 1, "EpiBf16: ACT is 0 (none) or 1 (gelu_pk)");
    bf16_t* O; int ldc; const float* bias; int split_cols; size_t split_stride; float scale0;
    __device__ __forceinline__ void operator()(const f32x4 (&acc)[2][2][4][2], const Unit& u, int wr, int wc, int fr, int fq) const {
        const int row0 = u.pm * BM + wr * 64 + fr; int colt = u.pn * BM; bf16_t* base = O;
        float sc = 1.f; if (split_cols) { const int t = colt / split_cols; base += (size_t)t * split_stride; colt -= t * split_cols; if (t == 0) sc = scale0; }
        const int col0 = colt + wc * 32 + 8 * fq, bcol0 = u.pn * BM + wc * 32 + 8 * fq;
        f32x4 bv[2][2];
#pragma unroll
        for (int bj = 0; bj < 2; ++bj)
#pragma unroll
            for (int n = 0; n < 2; ++n) bv[bj][n] = bias ? *(const f32x4*)(bias + bcol0 + bj * HALF + 4 * n) : (f32x4){0.f, 0.f, 0.f, 0.f};
#pragma unroll
        for (int ai = 0; ai < 2; ++ai)
#pragma unroll
            for (int m = 0; m < 4; ++m) { bf16_t* rowp = base + (size_t)(row0 + ai * HALF + m * 16) * ldc + col0;
#pragma unroll
                for (int bj = 0; bj < 2; ++bj) { f32x4 v0 = acc[ai][bj][m][0] + bv[bj][0], v1 = acc[ai][bj][m][1] + bv[bj][1];
                    if (ACT == 1) { f32x2 a = gelu_pk((f32x2){v0[0], v0[1]}), b = gelu_pk((f32x2){v0[2], v0[3]}), c = gelu_pk((f32x2){v1[0], v1[1]}), d = gelu_pk((f32x2){v1[2], v1[3]});
                        v0 = (f32x4){a.x, a.y, b.x, b.y}; v1 = (f32x4){c.x, c.y, d.x, d.y}; }
                    v0 = v0 * sc; v1 = v1 * sc; u32x4 w; w.x = cvt_pk_bf16(v0[0], v0[1]); w.y = cvt_pk_bf16(v0[2], v0[3]); w.z = cvt_pk_bf16(v1[0], v1[1]); w.w = cvt_pk_bf16(v1[2], v1[3]);
                    *(u32x4*)(rowp + bj * HALF) = w; } }
    }
};

template <int ACT> struct EpiStore {
    static constexpr bool PERM = true, AFTER_DRAIN = false;
    bf16_t* O; int ldc;
    __device__ __forceinline__ void operator()(const f32x4 (&acc)[2][2][4][2], const Unit& u, int wr, int wc, int fr, int fq) const {
        const int row0 = u.pm * BM + wr * 64 + fr, col0 = u.pn * BM + wc * 32 + 8 * fq;
#pragma unroll
        for (int ai = 0; ai < 2; ++ai)
#pragma unroll
            for (int m = 0; m < 4; ++m) { bf16_t* rowp = O + (size_t)(row0 + ai * HALF + m * 16) * ldc + col0;
#pragma unroll
                for (int bj = 0; bj < 2; ++bj) { f32x4 v0 = acc[ai][bj][m][0], v1 = acc[ai][bj][m][1];
                    if (ACT == 2) {
#pragma unroll
                        for (int e = 0; e < 4; ++e) { const float a = v0[e] > 0.f ? v0[e] : 0.f, b = v1[e] > 0.f ? v1[e] : 0.f; v0[e] = a * a; v1[e] = b * b; } }
                    u32x4 w; w.x = cvt_pk_bf16(v0[0], v0[1]); w.y = cvt_pk_bf16(v0[2], v0[3]); w.z = cvt_pk_bf16(v1[0], v1[1]); w.w = cvt_pk_bf16(v1[2], v1[3]);
                    *(u32x4*)(rowp + bj * HALF) = w; } }
    }
};
struct EpiResid {
    static constexpr bool PERM = false, AFTER_DRAIN = false;
    const float* xin_l; const float* xin_c; float* xout_l; float* xout_c; const float* gate;
    __device__ __forceinline__ void operator()(const f32x4 (&acc)[2][2][4][2], const Unit& u, int wr, int wc, int fr, int fq) const {
        const int r0 = u.pm * BM; const bool lat = r0 < ML; const int slot = lat ? r0 / SEQ : NB;
        const float* xin = lat ? xin_l + (size_t)r0 * D : xin_c + (size_t)(r0 - ML) * D;
        float* xout = lat ? xout_l + (size_t)r0 * D : xout_c + (size_t)(r0 - ML) * D;
        const int col0 = wc * 32 + 4 * fq;
        const float* gp = gate + (size_t)slot * NMOD + u.pn * BM;
        xin += u.pn * BM; xout += u.pn * BM;
#pragma unroll
        for (int ai = 0; ai < 2; ++ai)
#pragma unroll
            for (int m = 0; m < 4; ++m) { const int off = (ai * HALF + wr * 64 + m * 16 + fr) * D + col0;
#pragma unroll
                for (int bj = 0; bj < 2; ++bj)
#pragma unroll
                    for (int n = 0; n < 2; ++n) { const f32x4 xi = *(const f32x4*)(xin + off + bj * HALF + n * 16); const f32x4 gv = *(const f32x4*)(gp + col0 + bj * HALF + n * 16);
                        *(f32x4*)(xout + off + bj * HALF + n * 16) = xi + gv * acc[ai][bj][m][n]; }
                asm volatile("" ::: "memory"); }
    }
};

template <class Epi, class Sched, bool ALIGN_EPI = false, bool SP2 = false>
__device__ __forceinline__ void gemm_phase(PG8_LAS unsigned char* lds, const Gemm g, const Sched& S, const Epi& E, const int tid) {
    const int wid = __builtin_amdgcn_readfirstlane(tid >> 6), lane = tid & 63, wr = wid >> 2, wc = wid & 3, fr = lane & 15, fq = lane >> 4;
    const int K = g.K, nt = K / BK;
    unsigned voffA[2], voffB[2];
#pragma unroll
    for (int i = 0; i < 2; ++i) { int R, C; stage_rc(tid * 16 + i * 8192, R, C); const int Rb = Epi::PERM ? ((R & ~31) + perm32(R & 31)) : R;
        voffA[i] = (unsigned)(R * K + C) * 2u; voffB[i] = (unsigned)(Rb * K + C) * 2u; }
    const size_t kstep = (size_t)(BK * 2);
    const size_t hstep = (size_t)HALF * K * 2;
    const size_t tstep = 2 * hstep;
    const unsigned ldsw = (unsigned)wid * 1024u;
    const int aoff = lds_byte(wr * 64 + fr, fq * 8), boff = lds_byte(wc * 32 + fr, fq * 8);
#define PG8_SA(b, h) (((b) * 2 + (h)) * HTB)
#define PG8_SB(b, h) ((4 + (b) * 2 + (h)) * HTB)
#define PG8_STAGE(bufoff, gbase, voff) do { _Pragma("unroll") for (int _i = 0; _i < 2; ++_i) \
        __builtin_amdgcn_global_load_lds((const unsigned*)((const char*)(gbase) + (voff)[_i]), (PG8_LAS unsigned*)(lds + (bufoff) + ldsw + _i * 8192), 16, 0, 0); } while (0)
#define PG8_LDA(dst, b, h) do { _Pragma("unroll") for (int m = 0; m < 4; ++m) _Pragma("unroll") for (int k = 0; k < 2; ++k) dst[m][k] = *(const PG8_LAS bf16x8*)(lds + PG8_SA(b, h) + aoff + m * 2048 + k * 1024); } while (0)
#define PG8_LDB(dst, b, h) do { _Pragma("unroll") for (int n = 0; n < 2; ++n) _Pragma("unroll") for (int k = 0; k < 2; ++k) dst[n][k] = *(const PG8_LAS bf16x8*)(lds + PG8_SB(b, h) + boff + n * 2048 + k * 1024); } while (0)
#define PG8_MMA(ai, bj, At, Bt) do { __builtin_amdgcn_s_setprio(1); _Pragma("unroll") for (int m = 0; m < 4; ++m) _Pragma("unroll") for (int n = 0; n < 2; ++n) _Pragma("unroll") for (int k = 0; k < 2; ++k) \
        acc[ai][bj][m][n] = __builtin_amdgcn_mfma_f32_16x16x32_bf16(Bt[n][k], At[m][k], acc[ai][bj][m][n], 0, 0, 0); __builtin_amdgcn_s_setprio(0); } while (0)
#define PG8_WAIT_V(n) asm volatile("s_waitcnt vmcnt(" #n ")" ::: "memory")
#define PG8_WAIT_L(n) asm volatile("s_waitcnt lgkmcnt(" #n ")" ::: "memory")
#define PG8_BAR __builtin_amdgcn_s_barrier()
#define PG8_SCHED __builtin_amdgcn_sched_barrier(0)
    Unit cur, nxt; int ui = 0;
    if (!S.next(0, cur)) return;
    f32x4 acc[2][2][4][2];
#pragma unroll
    for (int a = 0; a < 2; ++a)
#pragma unroll
        for (int b = 0; b < 2; ++b)
#pragma unroll
            for (int m = 0; m < 4; ++m)
#pragma unroll
                for (int n = 0; n < 2; ++n) acc[a][b][m][n] = (f32x4){0.f, 0.f, 0.f, 0.f};
    bf16x8 At[4][2], B0[2][2], B1[2][2];
    const char* cA = (const char*)g.A + (size_t)cur.pm * tstep; const char* cB = (const char*)g.Bt + (size_t)cur.pn * tstep;
    S.a_ready(cur);
    if constexpr (SP2) {
        PG8_STAGE(PG8_SB(0, 0), cB, voffB); PG8_STAGE(PG8_SB(0, 1), cB + hstep, voffB); PG8_STAGE(PG8_SA(0, 0), cA, voffA); PG8_STAGE(PG8_SA(0, 1), cA + hstep, voffA);
        if (wr == 1) PG8_BAR;
        PG8_WAIT_V(2); PG8_BAR;
        PG8_STAGE(PG8_SB(1, 0), cB + kstep, voffB); PG8_STAGE(PG8_SA(1, 0), cA + kstep, voffA); PG8_STAGE(PG8_SB(1, 1), cB + hstep + kstep, voffB);
        PG8_WAIT_V(6); PG8_BAR;
    } else {
        PG8_STAGE(PG8_SB(0, 0), cB, voffB); PG8_STAGE(PG8_SA(0, 0), cA, voffA); PG8_STAGE(PG8_SB(0, 1), cB + hstep, voffB); PG8_STAGE(PG8_SA(0, 1), cA + hstep, voffA);
        if (wr == 1) PG8_BAR;
        PG8_WAIT_V(4); PG8_BAR;
        PG8_STAGE(PG8_SB(1, 0), cB + kstep, voffB); PG8_STAGE(PG8_SA(1, 0), cA + kstep, voffA); PG8_STAGE(PG8_SB(1, 1), cB + hstep + kstep, voffB);
        PG8_WAIT_V(6); PG8_BAR;
    }
    for (;;) {
        const bool has_next = S.next(ui + 1, nxt);
        const char* nA = has_next ? (const char*)g.A + (size_t)nxt.pm * tstep : cA; const char* nB = has_next ? (const char*)g.Bt + (size_t)nxt.pn * tstep : cB;
        for (int t = 0; t < nt; t += 2) {
            const bool last = (t == nt - 2);
            const char* a1 = cA + (size_t)(t + 1) * kstep;
            const char* a2 = last ? nA : cA + (size_t)(t + 2) * kstep; const char* b2 = last ? nB : cB + (size_t)(t + 2) * kstep;
            const char* a3 = a2 + kstep; const char* b3 = b2 + kstep;
            if (last && has_next) S.a_ready(nxt);
            if constexpr (SP2) {
            PG8_LDB(B0, 0, 0); PG8_LDB(B1, 0, 1); PG8_SCHED; PG8_LDA(At, 0, 0); PG8_STAGE(PG8_SA(1, 1), a1 + hstep, voffA);
            PG8_WAIT_V(8); PG8_WAIT_L(0); PG8_BAR; PG8_MMA(0, 0, At, B0); PG8_MMA(0, 1, At, B1); PG8_BAR; PG8_SCHED;
            PG8_LDA(At, 0, 1); PG8_STAGE(PG8_SB(0, 0), b2, voffB); PG8_STAGE(PG8_SB(0, 1), b2 + hstep, voffB); PG8_STAGE(PG8_SA(0, 0), a2, voffA);
            PG8_WAIT_V(8); PG8_WAIT_L(0); PG8_BAR; PG8_MMA(1, 0, At, B0); PG8_MMA(1, 1, At, B1); PG8_BAR; PG8_SCHED;
            PG8_LDB(B0, 1, 0); PG8_LDB(B1, 1, 1); PG8_SCHED; PG8_LDA(At, 1, 0); PG8_STAGE(PG8_SA(0, 1), a2 + hstep, voffA);
            PG8_WAIT_V(8); PG8_WAIT_L(0); PG8_BAR; PG8_MMA(0, 0, At, B0); PG8_MMA(0, 1, At, B1); PG8_BAR; PG8_SCHED;
            PG8_LDA(At, 1, 1); PG8_STAGE(PG8_SB(1, 0), b3, voffB); PG8_STAGE(PG8_SB(1, 1), b3 + hstep, voffB); PG8_STAGE(PG8_SA(1, 0), a3, voffA);
            PG8_WAIT_V(8); PG8_WAIT_L(0); PG8_BAR; PG8_MMA(1, 0, At, B0); PG8_MMA(1, 1, At, B1); PG8_BAR; PG8_SCHED;
            } else {
            PG8_LDB(B0, 0, 0); PG8_SCHED; PG8_LDA(At, 0, 0); PG8_STAGE(PG8_SA(1, 1), a1 + hstep, voffA);
            PG8_WAIT_L(8); PG8_BAR; PG8_WAIT_L(0); PG8_MMA(0, 0, At, B0); PG8_BAR; PG8_SCHED;
            PG8_LDB(B1, 0, 1); PG8_STAGE(PG8_SB(0, 0), b2, voffB);
            PG8_BAR; PG8_WAIT_L(0); PG8_MMA(0, 1, At, B1); PG8_BAR;
            PG8_LDA(At, 0, 1); PG8_STAGE(PG8_SA(0, 0), a2, voffA);
            PG8_BAR; PG8_WAIT_L(0); PG8_MMA(1, 0, At, B0); PG8_BAR; PG8_SCHED;
            PG8_STAGE(PG8_SB(0, 1), b2 + hstep, voffB);
            PG8_WAIT_V(6); PG8_BAR; PG8_MMA(1, 1, At, B1); PG8_BAR;
            PG8_LDB(B0, 1, 0); PG8_SCHED; PG8_LDA(At, 1, 0); PG8_STAGE(PG8_SA(0, 1), a2 + hstep, voffA);
            PG8_WAIT_L(8); PG8_BAR; PG8_WAIT_L(0); PG8_MMA(0, 0, At, B0); PG8_BAR; PG8_SCHED;
            PG8_LDB(B1, 1, 1); PG8_STAGE(PG8_SB(1, 0), b3, voffB);
            PG8_BAR; PG8_WAIT_L(0); PG8_MMA(0, 1, At, B1); PG8_BAR;
            PG8_LDA(At, 1, 1); PG8_STAGE(PG8_SA(1, 0), a3, voffA);
            PG8_BAR; PG8_WAIT_L(0); PG8_MMA(1, 0, At, B0); PG8_BAR; PG8_SCHED;
            PG8_STAGE(PG8_SB(1, 1), b3 + hstep, voffB);
            PG8_WAIT_V(6); PG8_BAR; PG8_MMA(1, 1, At, B1); PG8_BAR;
            }
        }
        if constexpr (ALIGN_EPI) { if (wr == 0) PG8_BAR; }
        if constexpr (!Epi::AFTER_DRAIN) { E(acc, cur, wr, wc, fr, fq); S.done(cur); }
        if (!has_next) break;
#pragma unroll
        for (int a = 0; a < 2; ++a)
#pragma unroll
            for (int b = 0; b < 2; ++b)
#pragma unroll
                for (int m = 0; m < 4; ++m)
#pragma unroll
                    for (int n = 0; n < 2; ++n) acc[a][b][m][n] = (f32x4){0.f, 0.f, 0.f, 0.f};
        cur = nxt; cA = nA; cB = nB; ++ui;
        if constexpr (ALIGN_EPI) { if (wr == 1) PG8_BAR; }
    }
    PG8_WAIT_V(0);
    if constexpr (!ALIGN_EPI) { if (wr == 0) PG8_BAR; }
    PG8_BAR;
    if constexpr (Epi::AFTER_DRAIN) { E.fused(acc, cur, wr, wc, fr, fq, lds, wid, lane); S.done(cur); }
#undef PG8_SA
#undef PG8_SB
#undef PG8_STAGE
#undef PG8_LDA
#undef PG8_LDB
#undef PG8_MMA
#undef PG8_WAIT_V
#undef PG8_WAIT_L
#undef PG8_BAR
#undef PG8_SCHED
}
}
#include <hip/hip_bf16.h>
#include <cmath>
namespace attn_body {
using bf16=__hip_bfloat16;
using bf16x8=__attribute__((ext_vector_type(8)))short;
using s16x4=__attribute__((ext_vector_type(4)))short;
using f32x16=__attribute__((ext_vector_type(16)))float;
using u32x4=__attribute__((ext_vector_type(4)))unsigned;
constexpr int D=64;
constexpr int QP=256,KP=128,OP=1024;
constexpr int NW=8,QBLK=32,QB=QBLK*NW,KVBLK=64;
constexpr int ATTN_UNIT_ROWS=QB;
__device__ __forceinline__ int crow(int r,int hi){return (r&3)+8*(r>>2)+4*hi;}
#define SBAR() __builtin_amdgcn_sched_barrier(0)
__device__ __forceinline__ void cmask(f32x16&p0,f32x16&p1,int jb,int qrel,int hi){
  const float NEG=-INFINITY; int kb=64*jb+4*hi;
  #pragma unroll
  for(int r=0;r<16;++r){int kv=kb+(r&3)+8*(r>>2); if(kv>qrel)p0[r]=NEG; if(kv+32>qrel)p1[r]=NEG;}
}

constexpr int NSLOT=3, SLOTB=8192;
constexpr int LDS_K=0, LDS_V=NSLOT*SLOTB, LDS_WS=2*NSLOT*SLOTB, LDS_OST=LDS_WS+NW*64*4, LDS_BYTES=LDS_OST+NW*4096;
constexpr float C2=0.125f*1.4426950408889634f;
__device__ __forceinline__ void glds16(const void*gsrc,unsigned lds_dst){unsigned keep;
  asm volatile("s_mov_b32 %0, m0\n\ts_mov_b32 m0, %2\n\ts_nop 0\n\tglobal_load_lds_dwordx4 %1, off\n\ts_mov_b32 m0, %0":"=&s"(keep):"v"(gsrc),"s"(lds_dst):"memory");}
__device__ __forceinline__ float max3f(float a,float b,float c){float r;asm("v_max3_f32 %0, %1, %2, %3":"=v"(r):"v"(a),"v"(b),"v"(c));return r;}
__device__ __forceinline__ float max2f(float a,float b){float r;asm("v_max_f32_e32 %0, %1, %2":"=v"(r):"v"(a),"v"(b));return r;}
__device__ __forceinline__ float fadd_s(float a,float b){float r;asm("v_add_f32_e32 %0, %1, %2":"=v"(r):"v"(a),"v"(b));return r;}
__device__ __forceinline__ float fsub_s(float a,float b){float r;asm("v_sub_f32_e32 %0, %1, %2":"=v"(r):"v"(a),"v"(b));return r;}
typedef float f32x2_t __attribute__((ext_vector_type(2))); typedef __bf16 bf16x2_t __attribute__((ext_vector_type(2)));
__device__ __forceinline__ unsigned cvtpk_s(float lo,float hi){f32x2_t v={lo,hi};bf16x2_t b=__builtin_convertvector(v,bf16x2_t);return __builtin_bit_cast(unsigned,b);}
#define WAIT_BAR(N) asm volatile("s_waitcnt vmcnt(" #N ") lgkmcnt(0)\n\ts_barrier":::"memory")

__device__ __forceinline__ void qkt(f32x16&p0,f32x16&p1,const char*Kslot,const bf16x8*qr,const f32x16&negm,int r32,int hi){
  const char*kb=Kslot+hi*1024+r32*16;
  #pragma unroll
  for(int d0=0;d0<4;++d0){
    const bf16x8 b0=*reinterpret_cast<const bf16x8*>(kb+d0*2048);
    const bf16x8 b1=*reinterpret_cast<const bf16x8*>(kb+d0*2048+512);
    if(d0==0){p0=__builtin_amdgcn_mfma_f32_32x32x16_bf16(b0,qr[0],negm,0,0,0);p1=__builtin_amdgcn_mfma_f32_32x32x16_bf16(b1,qr[0],negm,0,0,0);}
    else{p0=__builtin_amdgcn_mfma_f32_32x32x16_bf16(b0,qr[d0],p0,0,0,0);p1=__builtin_amdgcn_mfma_f32_32x32x16_bf16(b1,qr[d0],p1,0,0,0);}}
}
typedef __attribute__((address_space(3))) const char* lds_cptr;
typedef short v4i16_t __attribute__((ext_vector_type(4)));
__device__ __forceinline__ void kload8(bf16x8*kf,lds_cptr kp){
  kf[0]=*(const __attribute__((address_space(3))) bf16x8*)(kp);      kf[1]=*(const __attribute__((address_space(3))) bf16x8*)(kp+512);
  kf[2]=*(const __attribute__((address_space(3))) bf16x8*)(kp+2048); kf[3]=*(const __attribute__((address_space(3))) bf16x8*)(kp+2560);
  kf[4]=*(const __attribute__((address_space(3))) bf16x8*)(kp+4096); kf[5]=*(const __attribute__((address_space(3))) bf16x8*)(kp+4608);
  kf[6]=*(const __attribute__((address_space(3))) bf16x8*)(kp+6144); kf[7]=*(const __attribute__((address_space(3))) bf16x8*)(kp+6656);
}
__device__ __forceinline__ void kload2(bf16x8*kf,lds_cptr kp,int j){ kf[2*j]=*(const __attribute__((address_space(3))) bf16x8*)(kp+j*2048); kf[2*j+1]=*(const __attribute__((address_space(3))) bf16x8*)(kp+j*2048+512); }
__device__ __forceinline__ s16x4 vtr(lds_cptr p){ return __builtin_bit_cast(s16x4,__builtin_amdgcn_ds_read_tr16_b64_v4i16((__attribute__((address_space(3))) v4i16_t*)p)); }
__device__ __forceinline__ float rowmax(const f32x16&p0,const f32x16&p1){
  float a=max3f(p0[0],p0[1],p1[0]),b=max3f(p0[2],p0[3],p1[1]);a=max3f(a,p1[2],p1[3]);
  #pragma unroll
  for(int r=4;r<16;r+=4){a=max3f(a,p0[r],p0[r+1]);b=max3f(b,p0[r+2],p0[r+3]);a=max3f(a,p1[r],p1[r+1]);b=max3f(b,p1[r+2],p1[r+3]);}
  const float m=max2f(a,b);
  auto rr=__builtin_amdgcn_permlane32_swap(__float_as_uint(m),__float_as_uint(m),false,false);
  return max2f(__uint_as_float(rr[0]),__uint_as_float(rr[1]));
}
__device__ __forceinline__ void pv(f32x16*o,int vb,bf16x8 pa0,bf16x8 pa1,bf16x8 pa2,bf16x8 pa3){
  #pragma unroll
  for(int d0=0;d0<2;++d0){s16x4 lo[4],hi[4];
    #pragma unroll
    for(int ks=0;ks<4;++ks){
      asm volatile("ds_read_b64_tr_b16 %0,%1 offset:%c2":"=&v"(lo[ks]):"v"(vb),"i"(d0*4096+ks*1024):"memory");
      asm volatile("ds_read_b64_tr_b16 %0,%1 offset:%c2":"=&v"(hi[ks]):"v"(vb),"i"(d0*4096+ks*1024+512):"memory");}
    asm volatile("s_waitcnt lgkmcnt(0)":::"memory");SBAR();
    #define PK(k) (bf16x8){lo[k][0],lo[k][1],lo[k][2],lo[k][3],hi[k][0],hi[k][1],hi[k][2],hi[k][3]}
    o[d0]=__builtin_amdgcn_mfma_f32_32x32x16_bf16(pa0,PK(0),o[d0],0,0,0);
    o[d0]=__builtin_amdgcn_mfma_f32_32x32x16_bf16(pa1,PK(1),o[d0],0,0,0);
    o[d0]=__builtin_amdgcn_mfma_f32_32x32x16_bf16(pa2,PK(2),o[d0],0,0,0);
    o[d0]=__builtin_amdgcn_mfma_f32_32x32x16_bf16(pa3,PK(3),o[d0],0,0,0);
    #undef PK
  }
}

#ifndef ATTN_STORE16
#define ATTN_STORE16(p,v) (*(u32x4*)(p)=(v))
#endif
template<int THRL> __device__ __forceinline__ void attn_unit(const bf16*Qu,const bf16*__restrict__ Kh,const bf16*__restrict__ Vh,bf16*Ou,const int NT,char*shm,const int tid){
  const int lane=tid&63,r32=lane&31,hi=lane>>5; const int wid=__builtin_amdgcn_readfirstlane(tid>>6);
  const bf16*Qw=Qu+(long)(wid*QBLK)*QP;
  const unsigned lds0=(unsigned)(uintptr_t)shm;
  float*wsf=(float*)(shm+LDS_WS)+wid*64;
  const bf16*ksrc=Kh+(long)lane*KP+wid*8;
  const bf16*vsrc=Vh+(long)(16*(wid&3)+(lane>>2))*KP+(wid>>2)*32+(lane&3)*8;
  const unsigned kdst=lds0+LDS_K+wid*1024, vdst=lds0+LDS_V+wid*1024;
  #define DMA_K(t,slot) glds16(ksrc+(long)(t)*KVBLK*KP,(unsigned)__builtin_amdgcn_readfirstlane(kdst+(slot)))
  #define DMA_V(t,slot) glds16(vsrc+(long)(t)*KVBLK*KP,(unsigned)__builtin_amdgcn_readfirstlane(vdst+(slot)))
  const int vb0=(int)(lds0+LDS_V)+((lane>>4)&1)*32+(lane&3)*8+(4*hi+((lane&15)>>2))*64;
  const char*Kbase=shm+LDS_K; bf16x8 kf[8];
  const lds_cptr shm3=(lds_cptr)shm; const lds_cptr kp0=shm3+LDS_K+hi*1024+r32*16; const lds_cptr vp0=shm3+LDS_V+((lane>>4)&1)*32+(lane&3)*8+(4*hi+((lane&15)>>2))*64;
  DMA_K(0,0);DMA_V(0,0);DMA_K(1,SLOTB);
  bf16x8 qr[4];
  #pragma unroll
  for(int d0=0;d0<4;++d0)qr[d0]=*reinterpret_cast<const bf16x8*>(&Qw[(long)r32*QP+d0*16+hi*8]);
  float mhat=0.f,l_reg=0.f;f32x16 o[2];o[0]=f32x16{};o[1]=f32x16{};f32x16 negm=f32x16{};asm volatile("":"+v"(negm));
  #define CMASK(P0,P1,t) do{}while(0)
  bool resc=false;
  #define START(P0,P1) do{ const float rm=rowmax(P0,P1); resc=false; \
    { const float dl=rm; mhat=fadd_s(mhat,dl); \
      _Pragma("unroll") for(int r=0;r<16;++r){P0[r]=fsub_s(P0[r],dl);P1[r]=fsub_s(P1[r],dl);} \
      _Pragma("unroll") for(int r=0;r<16;++r)negm[r]=-mhat; asm volatile("":"+v"(negm)); } \
    _Pragma("unroll") for(int r=0;r<16;++r)P0[r]=__builtin_amdgcn_exp2f(P0[r]); }while(0)
  #define RESC() do{ if(resc){ asm volatile("s_waitcnt lgkmcnt(0)":::"memory"); \
      _Pragma("unroll") for(int d_=0;d_<2;++d_) _Pragma("unroll") for(int r=0;r<16;++r)o[d_][r]*=wsf[crow(r,hi)]; } }while(0)
  f32x16 pA0,pA1,pB0,pB1;
  int sl_prev=0,sl_cur=0,sl_next=SLOTB;
  #define ROT() do{sl_prev=sl_cur;sl_cur=sl_next;sl_next=(sl_next==(NSLOT-1)*SLOTB)?0:sl_next+SLOTB;}while(0)
  DMA_K(2,2*SLOTB);
  WAIT_BAR(3);
  qkt(pA0,pA1,Kbase,qr,negm,r32,hi);asm volatile("s_nop 15\n\ts_nop 7":"+v"(pA0),"+v"(pA1));CMASK(pA0,pA1,0);
  START(pA0,pA1);
  _Pragma("unroll") for(int r=0;r<16;++r)pA1[r]=__builtin_amdgcn_exp2f(pA1[r]);
  WAIT_BAR(0);
  DMA_K(3,0);DMA_V(1,SLOTB);
  ROT();
  kload8(kf,kp0+sl_cur);
  WAIT_BAR(2);
  s16x4 vlo[8],vhi[8]; u32x4 pw0,pw1,pw2,pw3;
  #define PKW(P,B) cvtpk_s(P[B],P[B+1])
  #define PAF(k) __builtin_bit_cast(bf16x8,pw##k)
  #define VFR(i) (bf16x8){vlo[i][0],vlo[i][1],vlo[i][2],vlo[i][3],vhi[i][0],vhi[i][1],vhi[i][2],vhi[i][3]}
  #define PIN(x) asm volatile("":"+v"(x))
  #define MX3(a,b,c) __builtin_fmaxf(__builtin_fmaxf((a),(b)),(c))
  #define GAPA(MF,A0,A1,A2,A3,W0,W1,PW) do{ MF; sacc+=A0; sacc+=A1; sacc+=A2; sacc+=A3; PIN(sacc); W0; W1; PIN(PW); SBAR(); }while(0)
  #define EX(v) __builtin_amdgcn_exp2f(v)
  #define GAPB(MF,X,B) do{ MF; X[B]=EX(X[B]); X[B+1]=EX(X[B+1]); X[B+2]=EX(X[B+2]); X[B+3]=EX(X[B+3]); PIN(X); SBAR(); }while(0)
  #define VRD(i) do{ vlo[i]=vtr(vp_+(((i)>>2)*4096+((i)&3)*1024)); vhi[i]=vtr(vp_+(((i)>>2)*4096+((i)&3)*1024+512)); }while(0)
  #define KRD(G,j) do{ if(G){ kload2(kf,kp0+sl_next,j); SBAR(); } }while(0)
  #define STEP(C0,C1,P0,P1,t,GK,GV,GL) do{ SBAR(); \
    const lds_cptr vp_=vp0+sl_prev; \
    VRD(0); SBAR(); float sacc=(P0[0]+P0[1]); \
    GAPA(C0=__builtin_amdgcn_mfma_f32_32x32x16_bf16(kf[0],qr[0],negm,0,0,0), P0[2],P0[3],P0[4],P0[5],     pw0[0]=PKW(P0,0), pw0[1]=PKW(P0,2), pw0); \
    VRD(4); SBAR(); GAPA(C1=__builtin_amdgcn_mfma_f32_32x32x16_bf16(kf[1],qr[0],negm,0,0,0), P0[6],P0[7],P0[8],P0[9],     pw0[2]=PKW(P0,4), pw0[3]=PKW(P0,6), pw0); \
    VRD(1); SBAR(); GAPA(C0=__builtin_amdgcn_mfma_f32_32x32x16_bf16(kf[2],qr[1],C0,0,0,0),   P0[10],P0[11],P0[12],P0[13], pw1[0]=PKW(P0,8), pw1[1]=PKW(P0,10), pw1); \
    VRD(5); SBAR(); GAPA(C1=__builtin_amdgcn_mfma_f32_32x32x16_bf16(kf[3],qr[1],C1,0,0,0),   P0[14],P0[15],P1[0],P1[1],   pw1[2]=PKW(P0,12),pw1[3]=PKW(P0,14), pw1); \
    VRD(2); SBAR(); GAPA(C0=__builtin_amdgcn_mfma_f32_32x32x16_bf16(kf[4],qr[2],C0,0,0,0),   P1[2],P1[3],P1[4],P1[5],     pw2[0]=PKW(P1,0), pw2[1]=PKW(P1,2), pw2); \
    VRD(6); SBAR(); GAPA(C1=__builtin_amdgcn_mfma_f32_32x32x16_bf16(kf[5],qr[2],C1,0,0,0),   P1[6],P1[7],P1[8],P1[9],     pw2[2]=PKW(P1,4), pw2[3]=PKW(P1,6), pw2); \
    VRD(3); SBAR(); GAPA(C0=__builtin_amdgcn_mfma_f32_32x32x16_bf16(kf[6],qr[3],C0,0,0,0),   P1[10],P1[11],P1[12],P1[13], pw3[0]=PKW(P1,8), pw3[1]=PKW(P1,10), pw3); \
    VRD(7); SBAR(); GAPA(C1=__builtin_amdgcn_mfma_f32_32x32x16_bf16(kf[7],qr[3],C1,0,0,0),   P1[14],P1[15],0.f,0.f,       pw3[2]=PKW(P1,12),pw3[3]=PKW(P1,14), pw3); \
    l_reg+=sacc; \
    if(GK){DMA_K((t)+3,sl_cur);} if(GV){DMA_V((t)+1,sl_next);} \
    CMASK(C0,C1,t); \
    { float a=MX3(C0[0],C0[1],C1[0]),b=MX3(C0[2],C0[3],C1[1]); a=MX3(a,C1[2],C1[3]); \
      _Pragma("unroll") for(int r=4;r<16;r+=4){a=MX3(a,C0[r],C0[r+1]);b=MX3(b,C0[r+2],C0[r+3]);a=MX3(a,C1[r],C1[r+1]);b=MX3(b,C1[r+2],C1[r+3]);} \
      float rm=__builtin_fmaxf(a,b); { auto rr=__builtin_amdgcn_permlane32_swap(__float_as_uint(rm),__float_as_uint(rm),false,false); rm=__builtin_fmaxf(__uint_as_float(rr[0]),__uint_as_float(rr[1])); } \
      resc=false; \
      if(__builtin_expect(__any(rm>(float)THRL),0)){ const float dl=__builtin_fmaxf(rm,0.f); mhat+=dl; \
        _Pragma("unroll") for(int r=0;r<16;++r){C0[r]-=dl;C1[r]-=dl;} \
        _Pragma("unroll") for(int r=0;r<16;++r)negm[r]=-mhat; asm volatile("":"+v"(negm)); \
        const float f=__builtin_amdgcn_exp2f(-dl); l_reg*=f; if(hi==0)wsf[r32]=f; resc=true; } } \
    SBAR(); \
    GAPB(o[0]=__builtin_amdgcn_mfma_f32_32x32x16_bf16(PAF(0),VFR(0),o[0],0,0,0), C0,0); \
    GAPB(o[1]=__builtin_amdgcn_mfma_f32_32x32x16_bf16(PAF(0),VFR(4),o[1],0,0,0), C0,4); \
    KRD(GL,0); GAPB(o[0]=__builtin_amdgcn_mfma_f32_32x32x16_bf16(PAF(1),VFR(1),o[0],0,0,0), C0,8); \
    KRD(GL,1); GAPB(o[1]=__builtin_amdgcn_mfma_f32_32x32x16_bf16(PAF(1),VFR(5),o[1],0,0,0), C0,12); \
    KRD(GL,2); GAPB(o[0]=__builtin_amdgcn_mfma_f32_32x32x16_bf16(PAF(2),VFR(2),o[0],0,0,0), C1,0); \
    KRD(GL,3); GAPB(o[1]=__builtin_amdgcn_mfma_f32_32x32x16_bf16(PAF(2),VFR(6),o[1],0,0,0), C1,4); \
    GAPB(o[0]=__builtin_amdgcn_mfma_f32_32x32x16_bf16(PAF(3),VFR(3),o[0],0,0,0), C1,8); \
    GAPB(o[1]=__builtin_amdgcn_mfma_f32_32x32x16_bf16(PAF(3),VFR(7),o[1],0,0,0), C1,12); \
    }while(0)
  int t=1;
  for(;t+5<NT;t+=2){
    STEP(pB0,pB1,pA0,pA1,t,true,true,true);     WAIT_BAR(2); RESC(); ROT();
    STEP(pA0,pA1,pB0,pB1,t+1,true,true,true);   WAIT_BAR(2); RESC(); ROT();
  }
  #define ENDW(tt) do{ if((tt)+3<NT){WAIT_BAR(2);} else if((tt)+2<NT){WAIT_BAR(1);} else {WAIT_BAR(0);} }while(0)
  for(;t+1<NT;t+=2){
    STEP(pB0,pB1,pA0,pA1,t,(t+3<NT),(t+1<NT),(t+1<NT));       ENDW(t);   RESC(); ROT();
    STEP(pA0,pA1,pB0,pB1,t+1,(t+4<NT),(t+2<NT),(t+2<NT));     ENDW(t+1); RESC(); ROT();
  }
  STEP(pB0,pB1,pA0,pA1,NT-1,false,false,false); RESC();
  { float sacc=pB0[0]+pB0[1]; _Pragma("unroll") for(int r=2;r<16;++r)sacc+=pB0[r]; _Pragma("unroll") for(int r=0;r<16;++r)sacc+=pB1[r]; l_reg+=sacc;
    pw0=(u32x4){PKW(pB0,0),PKW(pB0,2),PKW(pB0,4),PKW(pB0,6)};pw1=(u32x4){PKW(pB0,8),PKW(pB0,10),PKW(pB0,12),PKW(pB0,14)};pw2=(u32x4){PKW(pB1,0),PKW(pB1,2),PKW(pB1,4),PKW(pB1,6)};pw3=(u32x4){PKW(pB1,8),PKW(pB1,10),PKW(pB1,12),PKW(pB1,14)};
    SBAR(); pv(o,vb0+sl_cur,PAF(0),PAF(1),PAF(2),PAF(3)); }
  #undef PKW
  #undef PAF
  #undef VFR
  #undef PIN
  #undef MX3
  #undef GAPA
  #undef GAPB
  #undef EX
  #undef VRD
  #undef KRD
  #undef STEP
  #undef ENDW
  {auto rr=__builtin_amdgcn_permlane32_swap(__float_as_uint(l_reg),__float_as_uint(l_reg),false,false);l_reg=__uint_as_float(rr[0])+__uint_as_float(rr[1]);}
  if(hi==0)wsf[32+r32]=l_reg;asm volatile("s_waitcnt lgkmcnt(0)":::"memory");
  float rli[16];
  #pragma unroll
  for(int r=0;r<16;++r)rli[r]=__builtin_amdgcn_rcpf(wsf[32+crow(r,hi)]);
  bf16*Ow=Ou+(long)(wid*QBLK)*OP;
  { bf16*stg=(bf16*)(shm+LDS_OST)+wid*2048;
    #pragma unroll
    for(int r=0;r<16;++r){const int orow=crow(r,hi);
      #pragma unroll
      for(int d0=0;d0<2;++d0)stg[orow*64+d0*32+r32]=__float2bfloat16(o[d0][r]*rli[r]);}
    asm volatile("s_waitcnt lgkmcnt(0)":::"memory");
    #pragma unroll
    for(int i=0;i<4;++i){const int row=i*8+(lane>>3),ch=lane&7; const u32x4 v=*(const u32x4*)(stg+row*64+ch*8); ATTN_STORE16(Ow+(long)row*OP+ch*8,v);} }
  asm volatile("s_waitcnt lgkmcnt(0)\n\ts_barrier":::"memory");
  #undef DMA_K
  #undef DMA_V
  #undef CMASK
  #undef START
  #undef RESC
  #undef ROT
}
constexpr int ATTN_LDS_BYTES=LDS_BYTES;
#undef SBAR
#undef WAIT_BAR
}
#define GAS __attribute__((address_space(1)))
#define LAS __attribute__((address_space(3)))
typedef unsigned short bf16;
typedef unsigned v4u __attribute__((ext_vector_type(4)));
typedef unsigned v2u __attribute__((ext_vector_type(2)));
typedef float f32x4 __attribute__((ext_vector_type(4)));
typedef short bf16x8 __attribute__((ext_vector_type(8)));
constexpr int NWAVES = 8, NTHREADS = 512;
constexpr int RING_BYTES = 131072, LDS_BYTES = 147456;
#define LDS_WAIT() asm volatile("s_waitcnt lgkmcnt(0)" ::: "memory")
#define VM_WAIT() asm volatile("s_waitcnt vmcnt(0)" ::: "memory")
__device__ __forceinline__ unsigned f2bf(float f) { unsigned u = __builtin_bit_cast(unsigned, f); return (u + 0x7fffu + ((u >> 16) & 1u)) >> 16; }
__device__ __forceinline__ unsigned pk2(float lo, float hi) { return f2bf(lo) | (f2bf(hi) << 16); }
__device__ __forceinline__ float bf2f(unsigned short b) { return __builtin_bit_cast(float, ((unsigned)b) << 16); }
__device__ __forceinline__ float sigmoidf_(float x) { return 1.0f / (1.0f + __expf(-x)); }
__device__ __forceinline__ float siluf_(float x) { return x * sigmoidf_(x); }
__device__ __forceinline__ float wave_sum(float v) {
#pragma unroll
    for (int o = 1; o < 64; o <<= 1) v += __shfl_xor(v, o);
    return v;
}

constexpr size_t MiB = 1u << 20;
constexpr size_t WS_CTL = 0, WS_MOD = 1 * MiB;
constexpr size_t WS_WIN = 2 * MiB, WIN_BYTES = (size_t)PP * D * 2;
constexpr size_t WS_WOUT = WS_WIN + 2 * WIN_BYTES, WOUT_BYTES = (size_t)D * D * 2;
constexpr size_t WS_WUP = WS_WOUT + 2 * WOUT_BYTES, WUP_BYTES = (size_t)DFF * D * 2;
constexpr size_t WS_WDN = WS_WUP + 2 * WUP_BYTES, WDN_BYTES = (size_t)D * DFF * 2;
constexpr size_t WS_WPW = WS_WDN + 2 * WDN_BYTES, WPW_BYTES = (size_t)256 * 256 * 2;
static_assert(WS_WPW + 2 * WPW_BYTES <= 50 * MiB, "weights");
constexpr size_t WS_XC = 50 * MiB;
constexpr size_t WS_ACT = 54 * MiB;
constexpr size_t WS_P = 88 * MiB;
constexpr size_t WS_H = 88 * MiB;
constexpr size_t WS_QA = 182 * MiB;
constexpr size_t WS_KA = 191 * MiB, WS_VA = 196 * MiB;
constexpr size_t WS_KV = 201 * MiB;
constexpr size_t WS_DEC = 235 * MiB;
constexpr size_t WS_END = 256 * MiB;
static_assert(WS_P + (size_t)M * PP * 2 <= WS_QA && WS_H + (size_t)M * DFF * 2 <= WS_END && WS_ACT + (size_t)M * D * 2 <= WS_P, "ws map");

struct Args { const float* in[27]; float* out; unsigned char* ws; int ph_lo, ph_hi, layer, pad; };

template <class Map> __device__ __forceinline__ void transpose_item(const float* W, int K, int N, bf16* WT, LAS float* scr, int kb, int nb, int lane, Map srcc) {
    const int k0 = 64 * kb, n0 = 32 * nb; const int sc = srcc(n0 + (lane & 31));
#pragma unroll 8
    for (int i = 0; i < 32; ++i) { const int kk = 2 * i + (lane >> 5); scr[kk * 33 + (lane & 31)] = sc >= 0 ? W[(size_t)(k0 + kk) * N + sc] : 0.f; }
    LDS_WAIT(); asm volatile("" ::: "memory");
    const int c = lane & 7;
#pragma unroll
    for (int j = 0; j < 4; ++j) { const int n = (lane >> 3) + 8 * j; const LAS float* s = scr + (8 * c) * 33 + n;
        v4u o; o.x = pk2(s[0 * 33], s[1 * 33]); o.y = pk2(s[2 * 33], s[3 * 33]); o.z = pk2(s[4 * 33], s[5 * 33]); o.w = pk2(s[6 * 33], s[7 * 33]);
        *(GAS v4u*)(WT + (size_t)(n0 + n) * K + k0 + 8 * c) = o; }
    LDS_WAIT(); asm volatile("" ::: "memory");
}
struct MapId { __device__ __forceinline__ int operator()(int n) const { return n; } };
struct MapWin { __device__ __forceinline__ int operator()(int n) const { return n < 1280 ? n : (n < 2560 ? n + 16 : (n < 2576 ? n - 1280 : -1)); } };

__device__ __forceinline__ void ph_prologue(const Args& a, LAS unsigned char* lds, int tid, int lane, int wave, int bid, int G) {
    unsigned char* ws = a.ws;
    LAS float* scr = (LAS float*)(lds + wave * 16384);
    const int gw = bid * NWAVES + wave, NGW = G * NWAVES;
    constexpr int I_IN = (D / 64) * (PP / 32), I_OUT = (D / 64) * (D / 32), I_UP = (D / 64) * (DFF / 32), I_DN = (DFF / 64) * (D / 32), I_PW = (256 / 64) * (256 / 32);
    constexpr int I_L = I_IN + I_OUT + I_UP + I_DN + I_PW;
    for (int it = gw; it < DEPTH * I_L; it += NGW) {
        const int l = it / I_L; int r = it % I_L;
        if (r < I_IN) { transpose_item(a.in[8] + (size_t)l * D * PIN, D, PIN, (bf16*)(ws + WS_WIN + l * WIN_BYTES), scr, r / (PP / 32), r % (PP / 32), lane, MapWin()); continue; } r -= I_IN;
        if (r < I_OUT) { transpose_item(a.in[23] + (size_t)l * D * D, D, D, (bf16*)(ws + WS_WOUT + l * WOUT_BYTES), scr, r / (D / 32), r % (D / 32), lane, MapId()); continue; } r -= I_OUT;
        if (r < I_UP) { transpose_item(a.in[24] + (size_t)l * D * DFF, D, DFF, (bf16*)(ws + WS_WUP + l * WUP_BYTES), scr, r / (DFF / 32), r % (DFF / 32), lane, MapId()); continue; } r -= I_UP;
        if (r < I_DN) { transpose_item(a.in[25] + (size_t)l * DFF * D, DFF, D, (bf16*)(ws + WS_WDN + l * WDN_BYTES), scr, r / (D / 32), r % (D / 32), lane, MapId()); continue; } r -= I_DN;
        transpose_item(a.in[13] + (size_t)l * 256 * 256, 256, 256, (bf16*)(ws + WS_WPW + l * WPW_BYTES), scr, r / 8, r % 8, lane, MapId());
    }
    __syncthreads();
    LAS float* sil = (LAS float*)lds;
    LAS float* part = (LAS float*)(lds + NS * D * 4);
    float* MOD = (float*)(ws + WS_MOD);
    const float* c = a.in[1]; const float* cc = a.in[3]; const float* w_mod = a.in[4]; const float* b_mod = a.in[5];
    bool staged = false;
    for (int task = bid; task < DEPTH * (NMOD / 64); task += G) {
        if (!staged) { for (int i = tid; i < NS * D; i += NTHREADS) { const int s = i / D, k = i % D; const float v = s < NB ? c[s * D + k] : cc[k]; sil[i] = siluf_(v); } staged = true; __syncthreads(); }
        const int l = task / (NMOD / 64), c0 = (task % (NMOD / 64)) * 64;
        float acc[NS];
#pragma unroll
        for (int s = 0; s < NS; ++s) acc[s] = 0.f;
        const float* wp = w_mod + (size_t)l * D * NMOD + (size_t)(wave * 128) * NMOD + c0 + lane;
#pragma unroll 4
        for (int k = 0; k < 128; ++k) { const float wv = wp[(size_t)k * NMOD];
#pragma unroll
            for (int s = 0; s < NS; ++s) acc[s] += sil[s * D + wave * 128 + k] * wv; }
#pragma unroll
        for (int s = 0; s < NS; ++s) part[(wave * NS + s) * 64 + lane] = acc[s];
        __syncthreads();
        if (tid < NS * 64) { const int s = tid / 64, ln = tid % 64; float v = 0.f;
#pragma unroll
            for (int w = 0; w < 8; ++w) v += part[(w * NS + s) * 64 + ln];
            MOD[((size_t)l * NS + s) * NMOD + c0 + ln] = v + b_mod[(size_t)l * NMOD + c0 + ln]; }
        __syncthreads();
    }
}
__device__ __forceinline__ void ph_normmod(const float* xl, const float* xc, const float* g, const float* mod, int i_shift, int i_scale, bf16* XN, int nrows, int lane, int gw, int NGW) {
    for (int r = gw; r < nrows; r += NGW) {
        const float* xr = r < ML ? xl + (size_t)r * D : xc + (size_t)(r - ML) * D;
        const float* m = mod + (size_t)(r < ML ? r / SEQ : NB) * NMOD;
        f32x4 v[4]; float s = 0.f;
#pragma unroll
        for (int j = 0; j < 4; ++j) { v[j] = *(const f32x4*)(xr + 4 * lane + 256 * j); s += (v[j].x * v[j].x + v[j].y * v[j].y) + (v[j].z * v[j].z + v[j].w * v[j].w); }
        const float rs = 1.0f / sqrtf(wave_sum(s) * (1.0f / D) + EPS);
#pragma unroll
        for (int j = 0; j < 4; ++j) { const int c0 = 4 * lane + 256 * j;
            const f32x4 gg = *(const f32x4*)(g + c0), sc = *(const f32x4*)(m + i_scale * D + c0), sh = *(const f32x4*)(m + i_shift * D + c0);
            const f32x4 o = v[j] * rs * gg * (sc + 1.0f) + sh;
            v2u w; w.x = pk2(o.x, o.y); w.y = pk2(o.z, o.w); *(v2u*)(XN + (size_t)r * D + c0) = w; }
    }
}
__device__ __forceinline__ void ph_final(float* x, const float* g, int lane, int gw, int NGW) {
    for (int r = gw; r < ML; r += NGW) {
        float* xr = x + (size_t)r * D;
        f32x4 v[4]; float s = 0.f;
#pragma unroll
        for (int j = 0; j < 4; ++j) { v[j] = *(const f32x4*)(xr + 4 * lane + 256 * j); s += (v[j].x * v[j].x + v[j].y * v[j].y) + (v[j].z * v[j].z + v[j].w * v[j].w); }
        const float rs = 1.0f / sqrtf(wave_sum(s) * (1.0f / D) + EPS);
#pragma unroll
        for (int j = 0; j < 4; ++j) { const int c0 = 4 * lane + 256 * j; *(f32x4*)(xr + c0) = v[j] * rs * *(const f32x4*)(g + c0); }
    }
}
__device__ __forceinline__ void ph_attprep(const bf16* P, const float* qg, const float* kg, bf16* QA, bf16* KA, bf16* VA, int lane, int gw, int NGW) {
    const float gq = qg[lane], gk = kg[lane];
    const int kk = lane & 31; const float inv = exp2f(-(float)(kk & 15) * (13.287712379549449f / 16.0f));
    for (int r = gw; r < M; r += NGW) {
        const bool lat = r < ML; const int b = lat ? r / SEQ : (r - ML) / CTX, t = lat ? r % SEQ : (r - ML) % CTX;
        const bf16* pr = P + (size_t)r * PP;
        float cs = 1.f, sn = 0.f;
        if (lat) { const float ang = (float)(kk < 16 ? t / GRIDW : t % GRIDW) * inv; sincosf(ang, &sn, &cs); }
        const float sgn = lane < 32 ? -1.f : 1.f;
        const size_t krow = (size_t)b * KEYS + (lat ? CTX + t : t);
#pragma unroll
        for (int h = 0; h < 6; ++h) {
            const float x = bf2f(pr[(h < 4 ? OFF_AQ + h * 64 : OFF_AK + (h - 4) * 64) + lane]);
            const float rs = 1.0f / sqrtf(wave_sum(x * x) * (1.0f / 64) + EPS);
            const float v = x * rs * (h < 4 ? gq : gk);
            const float o = v * cs + sgn * __shfl_xor(v, 32) * sn;
            if (h < 4) QA[(size_t)r * 256 + h * 64 + lane] = (bf16)f2bf(o * (0.125f * 1.4426950408889634f));
            else KA[krow * 128 + (h - 4) * 64 + lane] = (bf16)f2bf(o);
        }
        VA[krow * 128 + lane] = pr[OFF_AV + lane]; VA[krow * 128 + 64 + lane] = pr[OFF_AV + 64 + lane];
    }
}
__device__ __forceinline__ void ph_attention(const bf16* QA, const bf16* KA, const bf16* VA, bf16* Y, bool need_ctx, char* lds, int bid, int G, int tid) {
    const int vcu = (G % 8 == 0) ? (bid % 8) * (G / 8) + bid / 8 : bid;
    const int NU = 256 + (need_ctx ? 16 : 0);
    for (int u = vcu; u < NU; u += G) {
        if (u < 256) { const int b = u >> 6, h = (u >> 4) & 3, qb = u & 15; const size_t row = (size_t)b * SEQ + qb * 256;
            attn_body::attn_unit<8>((const attn_body::bf16*)(QA + row * 256 + h * 64), (const attn_body::bf16*)(KA + (size_t)b * KEYS * 128 + (h >> 1) * 64), (const attn_body::bf16*)(VA + (size_t)b * KEYS * 128 + (h >> 1) * 64),
                                    (attn_body::bf16*)(Y + row * D + 512 + h * 64), KEYS / 64, lds, tid); }
        else { const int b = (u - 256) >> 2, h = (u - 256) & 3; const size_t row = (size_t)ML + b * CTX;
            attn_body::attn_unit<8>((const attn_body::bf16*)(QA + row * 256 + h * 64), (const attn_body::bf16*)(KA + (size_t)b * KEYS * 128 + (h >> 1) * 64), (const attn_body::bf16*)(VA + (size_t)b * KEYS * 128 + (h >> 1) * 64),
                                    (attn_body::bf16*)(Y + row * D + 512 + h * 64), CTX / 64, lds, tid); }
    }
}
__device__ __forceinline__ void ph_conv(const bf16* P, const float* w_dw, const float* b_dw, const float* ln_g, const float* ln_b, const bf16* PwT, const float* b_pw, bf16* Y, int nrows,
                                        LAS unsigned char* lds, int tid, int lane, int wave, int bid, int G) {
    typedef float f32x4_t __attribute__((ext_vector_type(4)));
    LAS float* U = (LAS float*)lds; LAS unsigned char* Zb = lds + 96256; constexpr int ZS = 528;
    const int nunits = nrows / 64;
    if (bid >= nunits) return;
    const int ch = tid & 255, half = tid >> 8;
    float wreg[31];
#pragma unroll
    for (int j = 0; j < 31; ++j) wreg[j] = w_dw[j * 256 + ch];
    const float bdw = b_dw[ch];
    const f32x4_t lg = *(const f32x4_t*)(ln_g + 4 * lane), lb = *(const f32x4_t*)(ln_b + 4 * lane);
    bf16x8 wf[2][8];
#pragma unroll
    for (int nt = 0; nt < 2; ++nt)
#pragma unroll
        for (int ks = 0; ks < 8; ++ks) wf[nt][ks] = *(const bf16x8*)(PwT + (size_t)(32 * wave + 16 * nt + (lane & 15)) * 256 + 32 * ks + 8 * (lane >> 4));
    const f32x4_t bp0 = *(const f32x4_t*)(b_pw + 32 * wave + 4 * (lane >> 4)), bp1 = *(const f32x4_t*)(b_pw + 32 * wave + 16 + 4 * (lane >> 4));
    for (int u = bid; u < nunits; u += G) {
        const int r0 = u * 64; int base, t0, T;
        if (r0 < ML) { base = (r0 / SEQ) * SEQ; t0 = r0 % SEQ; T = SEQ; } else { const int rc = r0 - ML; base = ML + (rc / CTX) * CTX; t0 = rc % CTX; T = CTX; }
        for (int i = tid >> 5; i < 94; i += 16) {
            const int tt = t0 - 15 + i, c8 = (tid & 31) * 8;
            f32x4_t o0 = {0.f, 0.f, 0.f, 0.f}, o1 = {0.f, 0.f, 0.f, 0.f};
            if (tt >= 0 && tt < T) {
                const bf16* pr = P + (size_t)(base + tt) * PP;
                const bf16x8 av = *(const bf16x8*)(pr + OFF_CA + c8), gv = *(const bf16x8*)(pr + OFF_CG + c8);
#pragma unroll
                for (int e = 0; e < 4; ++e) { o0[e] = bf2f((unsigned short)av[e]) * sigmoidf_(bf2f((unsigned short)gv[e])); o1[e] = bf2f((unsigned short)av[4 + e]) * sigmoidf_(bf2f((unsigned short)gv[4 + e])); }
            }
            *(LAS f32x4_t*)(U + i * 256 + c8) = o0; *(LAS f32x4_t*)(U + i * 256 + c8 + 4) = o1;
        }
        __syncthreads();
        float y[32];
        {
            float uu[62];
#pragma unroll
            for (int i = 0; i < 62; ++i) uu[i] = U[(32 * half + i) * 256 + ch];
#pragma unroll
            for (int t = 0; t < 32; ++t) { float acc = bdw;
#pragma unroll
                for (int j = 0; j < 31; ++j) acc += uu[t + j] * wreg[j];
                y[t] = acc; }
        }
        __syncthreads();
#pragma unroll
        for (int t = 0; t < 32; ++t) U[(32 * half + t) * 256 + ch] = y[t];
        __syncthreads();
#pragma unroll 2
        for (int q = 0; q < 8; ++q) { const int tok = 8 * wave + q;
            const f32x4_t v = *(LAS f32x4_t*)(U + tok * 256 + 4 * lane);
            const float mu = wave_sum((v.x + v.y) + (v.z + v.w)) * (1.0f / 256);
            const f32x4_t dv = v - mu;
            const float var = wave_sum((dv.x * dv.x + dv.y * dv.y) + (dv.z * dv.z + dv.w * dv.w)) * (1.0f / 256);
            const float rs = 1.0f / sqrtf(var + EPS);
            f32x4_t o = dv * rs * lg + lb;
#pragma unroll
            for (int e = 0; e < 4; ++e) o[e] = siluf_(o[e]);
            v2u w; w.x = pk2(o.x, o.y); w.y = pk2(o.z, o.w);
            *(LAS v2u*)(Zb + tok * ZS + 8 * lane) = w; }
        __syncthreads();
        f32x4_t acc[2][4];
#pragma unroll
        for (int nt = 0; nt < 2; ++nt)
#pragma unroll
            for (int tt = 0; tt < 4; ++tt) acc[nt][tt] = (f32x4_t){0.f, 0.f, 0.f, 0.f};
#pragma unroll
        for (int ks = 0; ks < 8; ++ks) {
            bf16x8 zf[4];
#pragma unroll
            for (int tt = 0; tt < 4; ++tt) zf[tt] = *(LAS bf16x8*)(Zb + (16 * tt + (lane & 15)) * ZS + 64 * ks + 16 * (lane >> 4));
#pragma unroll
            for (int nt = 0; nt < 2; ++nt)
#pragma unroll
                for (int tt = 0; tt < 4; ++tt) acc[nt][tt] = __builtin_amdgcn_mfma_f32_16x16x32_bf16(wf[nt][ks], zf[tt], acc[nt][tt], 0, 0, 0);
        }
#pragma unroll
        for (int tt = 0; tt < 4; ++tt) { bf16* yr = Y + (size_t)(r0 + 16 * tt + (lane & 15)) * D + 32 * wave + 4 * (lane >> 4);
            const f32x4_t a0 = acc[0][tt] + bp0, a1 = acc[1][tt] + bp1;
            v2u w0, w1; w0.x = pk2(a0.x, a0.y); w0.y = pk2(a0.z, a0.w); w1.x = pk2(a1.x, a1.y); w1.y = pk2(a1.z, a1.w);
            *(v2u*)yr = w0; *(v2u*)(yr + 16) = w1; }
        __syncthreads();
    }
}
constexpr int NSLOT = (CTX + SEQ) / 64, NCHAIN = 2 * 2 * NB * 4;
constexpr size_t WS_ROPE = 256 * 1024;
constexpr int SL_QD = 0, SL_KI = 10240, SL_SC = 20480, SL_VT = 38912, SL_ST = 48128, SL_TOT = 58368, SL_ZS = 60416, SL_OX = 64512, SL_END = 80896;
template <int MODE> __device__ __forceinline__ void scan_units(const Args& a, int l, bool need_ctx, LAS unsigned char* lds, int tid, int lane, int wave, int bid, int G) {
    typedef float f32x4_t __attribute__((ext_vector_type(4)));
    typedef float f32x2_t __attribute__((ext_vector_type(2)));
    unsigned char* ws = a.ws;
    const bf16* P = (const bf16*)(ws + WS_P); bf16* Y = (bf16*)(ws + WS_ACT);
    float* KV = (float*)(ws + WS_KV); float* DEC = (float*)(ws + WS_DEC);
    const f32x2_t* ROPE = (const f32x2_t*)(ws + WS_ROPE);
    const int slot_lo = (MODE == 3 && !need_ctx) ? 4 : 0, nsl = NSLOT - slot_lo, nunits = 2 * NB * 4 * nsl;
    const int col = lane, dir = col >> 5, d = col & 31, seg = wave, g = lane >> 4, li = lane & 15;
    for (int u = bid; u < nunits; u += G) {
        const int mixer = u / (NB * 4 * nsl), rem = u % (NB * 4 * nsl), b = rem / (4 * nsl), h = (rem / nsl) & 3, slot = slot_lo + rem % nsl;
        const bool lat = slot >= 4; const int t0 = lat ? (slot - 4) * 64 : slot * 64; const int r0 = lat ? b * SEQ + t0 : ML + b * CTX + t0;
        const int oq = mixer ? OFF_RQ : OFF_GQ, ok = mixer ? OFF_RK : OFF_GK, ov = mixer ? OFF_RV : OFF_GV, og = mixer ? OFF_RG : OFF_GR;
        float la[8];
        if (mixer == 0) {
            LAS float* zs = (LAS float*)(lds + SL_ZS) + wave * 128;
            zs[lane] = bf2f(P[(size_t)(r0 + 8 * seg + (lane >> 4)) * PP + OFF_Z + (lane & 15)]);
            zs[64 + lane] = bf2f(P[(size_t)(r0 + 8 * seg + 4 + (lane >> 4)) * PP + OFF_Z + (lane & 15)]);
            const float* wa = (dir ? a.in[17] : a.in[15]) + (size_t)l * 16 * 128 + h * 32 + d; const float ba = (dir ? a.in[18] : a.in[16])[l * 128 + h * 32 + d];
            float wv[16];
#pragma unroll
            for (int j = 0; j < 16; ++j) wv[j] = wa[j * 128];
            LDS_WAIT();
#pragma unroll
            for (int i = 0; i < 8; ++i) { float pre = ba;
#pragma unroll
                for (int j = 0; j < 16; ++j) pre += zs[i * 16 + j] * wv[j];
                la[i] = (fminf(pre, 0.f) - log1pf(expf(-fabsf(pre)))) * (1.0f / 16.0f); }
        } else {
            const float lg = log1pf(-exp2f(-5.0f - (float)h));
#pragma unroll
            for (int i = 0; i < 8; ++i) la[i] = lg;
        }
        float cum[8];
        if (dir == 0) { float r = 0.f;
#pragma unroll
            for (int i = 0; i < 8; ++i) { r += la[i]; cum[i] = r; } ((LAS float*)(lds + SL_TOT))[seg * 64 + col] = r; }
        else { float r = 0.f;
#pragma unroll
            for (int i = 7; i >= 0; --i) { r += la[i]; cum[i] = r; } ((LAS float*)(lds + SL_TOT))[seg * 64 + col] = r; }
        float qv[8], kv[8];
#pragma unroll
        for (int i = 0; i < 8; ++i) { const bf16* pr = P + (size_t)(r0 + 8 * seg + i) * PP;
            float q = bf2f(pr[oq + h * 32 + d]), k = bf2f(pr[ok + h * 32 + d]);
            if (mixer == 0) q *= 0.17677669529663687f;
            else { k *= 0.17677669529663687f;
                if (lat) { const float qp = bf2f(pr[oq + h * 32 + (d ^ 16)]), kp = bf2f(pr[ok + h * 32 + (d ^ 16)]) * 0.17677669529663687f;
                    const f32x2_t cs = ROPE[(size_t)(t0 + 8 * seg + i) * 16 + (d & 15)]; const float sg = d < 16 ? -1.f : 1.f;
                    q = q * cs.x + sg * qp * cs.y; k = k * cs.x + sg * kp * cs.y; } }
            qv[i] = q; kv[i] = k; }
        { v4u w; unsigned short vv[8];
#pragma unroll
            for (int i = 0; i < 8; ++i) vv[i] = P[(size_t)(r0 + 8 * wave + i) * PP + ov + h * 64 + lane];
            w.x = vv[0] | ((unsigned)vv[1] << 16); w.y = vv[2] | ((unsigned)vv[3] << 16); w.z = vv[4] | ((unsigned)vv[5] << 16); w.w = vv[6] | ((unsigned)vv[7] << 16);
            *(LAS v4u*)(lds + SL_VT + lane * 144 + wave * 16) = w; }
        const int chain_f = ((mixer * 2 + 0) * NB + b) * 4 + h, chain_b = ((mixer * 2 + 1) * NB + b) * 4 + h;
        if (MODE == 3) {
#pragma unroll
            for (int dd = 0; dd < 2; ++dd) { const float* S = KV + ((size_t)(dd ? chain_b : chain_f) * NSLOT + slot) * 2048;
                const f32x4_t s4 = *(const f32x4_t*)(S + tid * 4); v2u w; w.x = pk2(s4.x, s4.y); w.y = pk2(s4.z, s4.w);
                *(LAS v2u*)(lds + SL_ST + dd * 5120 + (tid >> 3) * 80 + (tid & 7) * 8) = w; }
        }
        __syncthreads();
        {
            const LAS float* tot = (const LAS float*)(lds + SL_TOT); float off = 0.f, total = 0.f;
#pragma unroll
            for (int s2 = 0; s2 < 8; ++s2) { const float tv = tot[s2 * 64 + col]; total += tv; if (dir == 0 ? (s2 < seg) : (s2 > seg)) off += tv; }
            if (MODE == 3) {
#pragma unroll
                for (int i = 0; i < 8; ++i) { const float c = cum[i] + off; const int s = 8 * seg + i;
                    *(LAS unsigned short*)(lds + SL_QD + dir * 5120 + s * 80 + d * 2) = (unsigned short)f2bf(qv[i] * expf(c));
                    *(LAS unsigned short*)(lds + SL_KI + dir * 5120 + s * 80 + d * 2) = (unsigned short)f2bf(kv[i] * expf(-c)); }
            } else {
                v4u w; unsigned short ke[8];
#pragma unroll
                for (int i = 0; i < 8; ++i) ke[i] = (unsigned short)f2bf(kv[i] * expf(total - (cum[i] + off)));
                w.x = ke[0] | ((unsigned)ke[1] << 16); w.y = ke[2] | ((unsigned)ke[3] << 16); w.z = ke[4] | ((unsigned)ke[5] << 16); w.w = ke[6] | ((unsigned)ke[7] << 16);
                *(LAS v4u*)(lds + SL_KI + dir * 4608 + d * 144 + seg * 16) = w;
                if (seg == 0) DEC[((size_t)(dir ? chain_b : chain_f) * NSLOT + slot) * 32 + d] = expf(total);
            }
        }
        __syncthreads();
        const int wdir = wave >> 2, wt = wave & 3;
        if (MODE == 1) {
            f32x4_t acc[2] = {(f32x4_t){0.f, 0.f, 0.f, 0.f}, (f32x4_t){0.f, 0.f, 0.f, 0.f}};
#pragma unroll
            for (int ks = 0; ks < 2; ++ks) { const bf16x8 af = *(LAS bf16x8*)(lds + SL_VT + (16 * wt + li) * 144 + 64 * ks + 16 * g);
#pragma unroll
                for (int dt = 0; dt < 2; ++dt) { const bf16x8 bfr = *(LAS bf16x8*)(lds + SL_KI + wdir * 4608 + (16 * dt + li) * 144 + 64 * ks + 16 * g);
                    acc[dt] = __builtin_amdgcn_mfma_f32_16x16x32_bf16(af, bfr, acc[dt], 0, 0, 0); } }
            float* dst = KV + ((size_t)(wdir ? chain_b : chain_f) * NSLOT + slot) * 2048;
#pragma unroll
            for (int dt = 0; dt < 2; ++dt)
#pragma unroll
                for (int r = 0; r < 4; ++r) dst[(16 * wt + 4 * g + r) * 32 + 16 * dt + li] = acc[dt][r];
        } else {
            const int ct = wt;
            const bf16x8 qf = *(LAS bf16x8*)(lds + SL_QD + wdir * 5120 + (16 * ct + li) * 80 + 16 * g);
#pragma unroll
            for (int st = 0; st < 4; ++st) {
                f32x4_t sc = {0.f, 0.f, 0.f, 0.f};
                const bool live = wdir == 0 ? (st <= ct) : (st >= ct);
                if (live) { const bf16x8 kf = *(LAS bf16x8*)(lds + SL_KI + wdir * 5120 + (16 * st + li) * 80 + 16 * g);
                    sc = __builtin_amdgcn_mfma_f32_16x16x32_bf16(kf, qf, sc, 0, 0, 0);
                    if (st == ct) {
#pragma unroll
                        for (int r = 0; r < 4; ++r) { const int s = 4 * g + r, c = li; if (wdir == 0 ? (s > c) : (s < c)) sc[r] = 0.f; } } }
                v2u w; w.x = pk2(sc[0], sc[1]); w.y = pk2(sc[2], sc[3]);
                *(LAS v2u*)(lds + SL_SC + wdir * 9216 + (16 * ct + li) * 144 + (16 * st + 4 * g) * 2) = w; }
            LDS_WAIT();
            f32x4_t acc[4];
#pragma unroll
            for (int et = 0; et < 4; ++et) acc[et] = (f32x4_t){0.f, 0.f, 0.f, 0.f};
            const bf16x8 s0 = *(LAS bf16x8*)(lds + SL_SC + wdir * 9216 + (16 * ct + li) * 144 + 16 * g), s1 = *(LAS bf16x8*)(lds + SL_SC + wdir * 9216 + (16 * ct + li) * 144 + 64 + 16 * g);
#pragma unroll
            for (int et = 0; et < 4; ++et) {
                const bf16x8 v0 = *(LAS bf16x8*)(lds + SL_VT + (16 * et + li) * 144 + 16 * g), v1 = *(LAS bf16x8*)(lds + SL_VT + (16 * et + li) * 144 + 64 + 16 * g);
                const bf16x8 stf = *(LAS bf16x8*)(lds + SL_ST + wdir * 5120 + (16 * et + li) * 80 + 16 * g);
                acc[et] = __builtin_amdgcn_mfma_f32_16x16x32_bf16(v0, s0, acc[et], 0, 0, 0);
                acc[et] = __builtin_amdgcn_mfma_f32_16x16x32_bf16(v1, s1, acc[et], 0, 0, 0);
                acc[et] = __builtin_amdgcn_mfma_f32_16x16x32_bf16(stf, qf, acc[et], 0, 0, 0); }
            LAS float* ox = (LAS float*)(lds + SL_OX) + ct * 1024;
            if (wdir == 1) {
#pragma unroll
                for (int et = 0; et < 4; ++et)
#pragma unroll
                    for (int r = 0; r < 4; ++r) ox[(et * 4 + r) * 64 + lane] = acc[et][r]; }
            __syncthreads();
            if (wdir == 0) {
                float ss = 0.f;
#pragma unroll
                for (int et = 0; et < 4; ++et)
#pragma unroll
                    for (int r = 0; r < 4; ++r) { acc[et][r] += ox[(et * 4 + r) * 64 + lane]; ss += acc[et][r] * acc[et][r]; }
                ss += __shfl_xor(ss, 16); ss += __shfl_xor(ss, 32);
                const float rs = 1.0f / sqrtf(ss * (1.0f / 64) + EPS);
                const int row = r0 + 16 * ct + li; const float* ng = (mixer ? a.in[22] : a.in[19]) + l * 256 + h * 64;
#pragma unroll
                for (int et = 0; et < 4; ++et) { const int e0 = 16 * et + 4 * g;
                    const v2u gt = *(const v2u*)(P + (size_t)row * PP + og + h * 64 + e0); const f32x4_t gn = *(const f32x4_t*)(ng + e0);
                    const float g0 = bf2f((unsigned short)(gt.x & 0xffff)), g1 = bf2f((unsigned short)(gt.x >> 16)), g2 = bf2f((unsigned short)(gt.y & 0xffff)), g3 = bf2f((unsigned short)(gt.y >> 16));
                    v2u w; w.x = pk2(acc[et][0] * rs * gn.x * siluf_(g0), acc[et][1] * rs * gn.y * siluf_(g1)); w.y = pk2(acc[et][2] * rs * gn.z * siluf_(g2), acc[et][3] * rs * gn.w * siluf_(g3));
                    *(v2u*)(Y + (size_t)row * D + (mixer ? 768 : 256) + h * 64 + e0) = w; }
            }
        }
        __syncthreads();
    }
}
__device__ __forceinline__ void ph_scan_state(unsigned char* ws, int tid, int bid, int G) {
    float* KV = (float*)(ws + WS_KV); const float* DEC = (const float*)(ws + WS_DEC);
    for (int gid = bid * NTHREADS + tid; gid < NCHAIN * 2048; gid += G * NTHREADS) {
        const int chain = gid >> 11, idx = gid & 2047, d = idx & 31, dir = (chain / (NB * 4)) & 1;
        float* kv = KV + (size_t)chain * NSLOT * 2048 + idx; const float* dc = DEC + (size_t)chain * NSLOT * 32 + d;
        float S = 0.f;
#pragma unroll 4
        for (int i = 0; i < NSLOT; ++i) {
            const int slot = dir == 0 ? i : (i < 4 ? 3 - i : NSLOT + 3 - i);
            const float kvv = kv[(size_t)slot * 2048], dv = dc[slot * 32];
            kv[(size_t)slot * 2048] = S; S = dv * S + kvv;
        }
    }
}
__device__ __forceinline__ void ph_rope_table(unsigned char* ws, int tid, int bid, int G) {
    typedef float f32x2_t __attribute__((ext_vector_type(2)));
    f32x2_t* ROPE = (f32x2_t*)(ws + WS_ROPE);
    for (int i = bid * NTHREADS + tid; i < SEQ * 16; i += G * NTHREADS) { const int t = i >> 4, k = i & 15;
        const float inv = exp2f(-(float)(k & 7) * (13.287712379549449f / 8.0f)); const float ang = (float)(k < 8 ? t / GRIDW : t % GRIDW) * inv;
        float s, c; sincosf(ang, &s, &c); ROPE[i] = (f32x2_t){c, s}; }
}
__global__ void __launch_bounds__(NTHREADS, 2) mk(Args a) {
    extern __shared__ __attribute__((aligned(16))) unsigned char lds_raw[];
    LAS unsigned char* lds = (LAS unsigned char*)lds_raw;
    cg::grid_group grid = cg::this_grid();
    int tid = threadIdx.x, lane = tid & 63, wave = __builtin_amdgcn_readfirstlane(tid >> 6);
    const int bid = blockIdx.x, G = gridDim.x, NGW = G * NWAVES; int gw = bid * NWAVES + wave;
#define FRESH() do { tid = threadIdx.x; asm volatile("" : "+v"(tid)); lane = tid & 63; wave = __builtin_amdgcn_readfirstlane(tid >> 6); gw = bid * NWAVES + wave; } while (0)
    unsigned char* ws = a.ws;
    float* XC = (float*)(ws + WS_XC);
    bf16* ACT = (bf16*)(ws + WS_ACT); bf16* P = (bf16*)(ws + WS_P); bf16* H = (bf16*)(ws + WS_H);
#define GSYNC() do { grid.sync(); FRESH(); } while (0)
    ph_rope_table(ws, tid, bid, G); ph_prologue(a, lds, tid, lane, wave, bid, G);
    GSYNC();
    for (int l = 0; l < DEPTH; ++l) {
        const bool need_ctx = l < DEPTH - 1; const int nro = need_ctx ? M : ML;
        const float* mod = (const float*)(ws + WS_MOD) + (size_t)l * NS * NMOD;
        const float* xl = l == 0 ? a.in[0] : a.out; const float* xc = l == 0 ? a.in[2] : (const float*)(ws + WS_XC);
        ph_normmod(xl, xc, a.in[6] + l * D, mod, 0, 1, ACT, M, lane, gw, NGW);
        GSYNC();
        { pg8::Gemm g{ACT, (const bf16*)(ws + WS_WIN + l * WIN_BYTES), M, PP, D}; pg8::StaticOrder S; S.init(M, PP, G, bid);
          pg8::EpiStore<0> E{P, PP}; pg8::gemm_phase<pg8::EpiStore<0>, pg8::StaticOrder, true, true>(lds, g, S, E, tid); }
        GSYNC();
        ph_conv(P, a.in[9] + l * 31 * 256, a.in[10] + l * 256, a.in[11] + l * 256, a.in[12] + l * 256, (const bf16*)(ws + WS_WPW + l * WPW_BYTES), a.in[14] + l * 256, ACT, nro, lds, tid, lane, wave, bid, G);
        __syncthreads(); FRESH();
        ph_attprep(P, a.in[20] + l * 64, a.in[21] + l * 64, (bf16*)(ws + WS_QA), (bf16*)(ws + WS_KA), (bf16*)(ws + WS_VA), lane, gw, NGW);
        FRESH();
        scan_units<1>(a, l, need_ctx, lds, tid, lane, wave, bid, G);
        GSYNC();
        ph_scan_state(ws, tid, bid, G);
        FRESH();
        ph_attention((const bf16*)(ws + WS_QA), (const bf16*)(ws + WS_KA), (const bf16*)(ws + WS_VA), ACT, need_ctx, (char*)lds_raw, bid, G, tid);
        GSYNC();
        scan_units<3>(a, l, need_ctx, lds, tid, lane, wave, bid, G);
        GSYNC();
        { pg8::Gemm g{ACT, (const bf16*)(ws + WS_WOUT + l * WOUT_BYTES), nro, D, D}; pg8::StaticOrder S; S.init(nro, D, G, bid);
          pg8::EpiResid E{xl, xc, a.out, XC, mod + 2 * D}; pg8::gemm_phase<pg8::EpiResid, pg8::StaticOrder, true, true>(lds, g, S, E, tid); }
        GSYNC();
        ph_normmod(a.out, XC, a.in[7] + l * D, mod, 3, 4, ACT, nro, lane, gw, NGW);
        GSYNC();
        { pg8::Gemm g{ACT, (const bf16*)(ws + WS_WUP + l * WUP_BYTES), nro, DFF, D}; pg8::StaticOrder S; S.init(nro, DFF, G, bid);
          pg8::EpiStore<2> E{H, DFF}; pg8::gemm_phase<pg8::EpiStore<2>, pg8::StaticOrder, true, true>(lds, g, S, E, tid); }
        GSYNC();
        { pg8::Gemm g{H, (const bf16*)(ws + WS_WDN + l * WDN_BYTES), nro, D, DFF}; pg8::StaticOrder S; S.init(nro, D, G, bid);
          pg8::EpiResid E{a.out, XC, a.out, XC, mod + 5 * D}; pg8::gemm_phase<pg8::EpiResid, pg8::StaticOrder, true, true>(lds, g, S, E, tid); }
        GSYNC();
    }
    ph_final(a.out, a.in[26], lane, gw, NGW);
}
extern "C" void kernel_launch(void* const* d_in, const int* in_sizes, int n_in, void* d_out, int out_size, void* d_ws, size_t ws_size, hipStream_t stream) {
    static int grid = 0;
    if (grid == 0) {
        if (n_in != 27 || in_sizes[0] != ML * D || out_size != ML * D || ws_size < WS_END) { fprintf(stderr, "kernel_launch: unexpected shapes / workspace (n_in %d, ws %zu)\n", n_in, ws_size); grid = -1; return; }
        int dev = 0, cus = 0, per_cu = 0;
        if (hipGetDevice(&dev) != hipSuccess || hipDeviceGetAttribute(&cus, hipDeviceAttributeMultiprocessorCount, dev) != hipSuccess) { grid = -1; return; }
        if (hipFuncSetAttribute((const void*)mk, hipFuncAttributeMaxDynamicSharedMemorySize, LDS_BYTES) != hipSuccess) { fprintf(stderr, "kernel_launch: hipFuncSetAttribute failed\n"); grid = -1; return; }
        if (hipOccupancyMaxActiveBlocksPerMultiprocessor(&per_cu, (const void*)mk, NTHREADS, LDS_BYTES) != hipSuccess || per_cu < 1) { fprintf(stderr, "kernel_launch: occupancy query says %d blocks per CU\n", per_cu); (void)hipGetLastError(); per_cu = 1; }
        grid = cus * (per_cu > 1 ? 1 : per_cu);
    }
    if (grid < 0) return;
    Args a{};
    for (int i = 0; i < 27; ++i) a.in[i] = (const float*)d_in[i];
    a.out = (float*)d_out; a.ws = (unsigned char*)d_ws;
    void* args[] = {&a};
    hipError_t e = hipLaunchCooperativeKernel((const void*)mk, dim3(grid), dim3(NTHREADS), args, LDS_BYTES, stream);
    if (e != hipSuccess) fprintf(stderr, "kernel_launch: cooperative launch failed: %s (grid %d)\n", hipGetErrorString(e), grid);
}
```

```cpp
#include <hip/hip_runtime.h>
#include <hip/hip_cooperative_groups.h>
#include <cstdio>
#include <cstdint>
namespace cg = cooperative_groups;

constexpr int D = 1024, NB = 4, SEQ = 4096, CTX = 256, DFF = 4096, DEPTH = 2, GRIDW = 64;
constexpr int ML = NB * SEQ, MC = NB * CTX, M = ML + MC, NS = NB + 1, NMOD = 6 * D;
constexpr int PIN = 2576;
constexpr int PP = 2816;
constexpr int OFF_CA = 0, OFF_CG = 256, OFF_GQ = 512, OFF_GK = 640, OFF_GV = 768, OFF_GR = 1024, OFF_AQ = 1280, OFF_AK = 1536, OFF_AV = 1664,
              OFF_RQ = 1792, OFF_RK = 1920, OFF_RV = 2048, OFF_RG = 2304, OFF_Z = 2560;
constexpr float EPS = 1e-6f;
constexpr int KEYS = CTX + SEQ;
namespace pg8 {
#define PG8_LAS __attribute__((address_space(3)))
typedef unsigned short bf16_t;
typedef short bf16x8 __attribute__((ext_vector_type(8)));
typedef float f32x4 __attribute__((ext_vector_type(4)));
typedef unsigned u32x4 __attribute__((ext_vector_type(4)));
constexpr int BM = 256, BK = 64, HALF = 128, HTB = HALF * BK * 2  , STAGE_BYTES = 8 * HTB, NXCD = 8, WGM = 8;

__host__ __device__ __forceinline__ int lds_byte(int r, int c) { const int st = (r >> 4) * 2 + (c >> 5), rr = r & 15, cc = c & 31, ob = rr * 64 + cc * 2; return st * 1024 + (ob ^ (((ob >> 9) & 1) << 5)); }
__host__ __device__ __forceinline__ void stage_rc(int b, int& R, int& C) { const int st = b / 1024, sb = b % 1024, swz = sb ^ (((sb >> 9) & 1) << 5); R = (st >> 1) * 16 + swz / 64; C = (st & 1) * 32 + (swz % 64) / 2; }
__host__ __device__ __forceinline__ int perm32(int rho) { const int n = rho >> 4, i = rho & 15; return 8 * (i >> 2) + 4 * n + (i & 3); }

struct Unit { int pm, pn; };
struct Gemm { const bf16_t* A; const bf16_t* Bt; int M, N, K; };

struct StaticOrder {
    int nM, nN, nwg, G, c;
    __host__ __device__ void init(int M, int N, int G_, int c_) { nM = M / BM; nN = N / BM; nwg = nM * nN; G = G_; c = c_; }
    __host__ __device__ bool next(int i, Unit& u) const {
        const long L = (long)i * G + c; if (L >= nwg) return false;
        int wgid = (int)L; { const int q = nwg / NXCD, r = nwg % NXCD, xcd = wgid % NXCD, off = wgid / NXCD; wgid = (xcd < r ? xcd * (q + 1) : r * (q + 1) + (xcd - r) * q) + off; }
        const int nig = WGM * nN, gid = wgid / nig, fm = gid * WGM, gsz = (nM - fm) < WGM ? (nM - fm) : WGM;
        u.pm = fm + ((wgid % nig) % gsz); u.pn = (wgid % nig) / gsz; return true;
    }
    __device__ __forceinline__ void a_ready(const Unit&) const {}
    __device__ __forceinline__ void done(const Unit&) const {}
};

__device__ __forceinline__ unsigned cvt_pk_bf16(float lo, float hi) { unsigned r; asm volatile("v_cvt_pk_bf16_f32 %0, %1, %2" : "=v"(r) : "v"(lo), "v"(hi)); return r; }
typedef float f32x2 __attribute__((ext_vector_type(2)));
__device__ __forceinline__ f32x2 gelu_pk(f32x2 v) {
    const f32x2 av = __builtin_elementwise_abs(v), d = av * 0.2316418882f + 1.0f;
    f32x2 t; t.x = __builtin_amdgcn_rcpf(d.x); t.y = __builtin_amdgcn_rcpf(d.y);
    f32x2 q = t * 0.5307027145f + (-0.7265760135f); q = q * t + 0.7107068705f; q = q * t + (-0.142248368f); q = q * t + 0.127414796f; q = q * t;
    const f32x2 s = (v * v) * (-0.72134752044f);
    f32x2 e; e.x = __builtin_amdgcn_exp2f(s.x); e.y = __builtin_amdgcn_exp2f(s.y);
    const f32x2 m = v * (q * e), r = v - m;
    f32x2 o; o.x = v.x < 0.f ? m.x : r.x; o.y = v.y < 0.f ? m.y : r.y; return o;
}

template <int ACT  > struct EpiBf16 {
    static constexpr bool PERM = true, AFTER_DRAIN = false; static_assert(ACT == 0 || ACT == 1, "EpiBf16: ACT is 0 (none) or 1 (gelu_pk)");
    bf16_t* O; int ldc; const float* bias; int split_cols; size_t split_stride; float scale0;
    __device__ __forceinline__ void operator()(const f32x4 (&acc)[2][2][4][2], const Unit& u, int wr, int wc, int fr, int fq) const {
        const int row0 = u.pm * BM + wr * 64 + fr; int colt = u.pn * BM; bf16_t* base = O;
        float sc = 1.f; if (split_cols) { const int t = colt / split_cols; base += (size_t)t * split_stride; colt -= t * split_cols; if (t == 0) sc = scale0; }
        const int col0 = colt + wc * 32 + 8 * fq, bcol0 = u.pn * BM + wc * 32 + 8 * fq;
        f32x4 bv[2][2];
#pragma unroll
        for (int bj = 0; bj < 2; ++bj)
#pragma unroll
            for (int n = 0; n < 2; ++n) bv[bj][n] = bias ? *(const f32x4*)(bias + bcol0 + bj * HALF + 4 * n) : (f32x4){0.f, 0.f, 0.f, 0.f};
#pragma unroll
        for (int ai = 0; ai < 2; ++ai)
#pragma unroll
            for (int m = 0; m < 4; ++m) { bf16_t* rowp = base + (size_t)(row0 + ai * HALF + m * 16) * ldc + col0;
#pragma unroll
                for (int bj = 0; bj < 2; ++bj) { f32x4 v0 = acc[ai][bj][m][0] + bv[bj][0], v1 = acc[ai][bj][m][1] + bv[bj][1];
                    if (ACT == 1) { f32x2 a = gelu_pk((f32x2){v0[0], v0[1]}), b = gelu_pk((f32x2){v0[2], v0[3]}), c = gelu_pk((f32x2){v1[0], v1[1]}), d = gelu_pk((f32x2){v1[2], v1[3]});
                        v0 = (f32x4){a.x, a.y, b.x, b.y}; v1 = (f32x4){c.x, c.y, d.x, d.y}; }
                    v0 = v0 * sc; v1 = v1 * sc; u32x4 w; w.x = cvt_pk_bf16(v0[0], v0[1]); w.y = cvt_pk_bf16(v0[2], v0[3]); w.z = cvt_pk_bf16(v1[0], v1[1]); w.w = cvt_pk_bf16(v1[2], v1[3]);
                    *(u32x4*)(rowp + bj * HALF) = w; } }
    }
};

template <int ACT> struct EpiStore {
    static constexpr bool PERM = true, AFTER_DRAIN = false;
    bf16_t* O; int ldc;
    __device__ __forceinline__ void operator()(const f32x4 (&acc)[2][2][4][2], const Unit& u, int wr, int wc, int fr, int fq) const {
        const int row0 = u.pm * BM + wr * 64 + fr, col0 = u.pn * BM + wc * 32 + 8 * fq;
#pragma unroll
        for (int ai = 0; ai < 2; ++ai)
#pragma unroll
            for (int m = 0; m < 4; ++m) { bf16_t* rowp = O + (size_t)(row0 + ai * HALF + m * 16) * ldc + col0;
#pragma unroll
                for (int bj = 0; bj < 2; ++bj) { f32x4 v0 = acc[ai][bj][m][0], v1 = acc[ai][bj][m][1];
                    if (ACT == 2) {
#pragma unroll
                        for (int e = 0; e < 4; ++e) { const float a = v0[e] > 0.f ? v0[e] : 0.f, b = v1[e] > 0.f ? v1[e] : 0.f; v0[e] = a * a; v1[e] = b * b; } }
                    u32x4 w; w.x = cvt_pk_bf16(v0[0], v0[1]); w.y = cvt_pk_bf16(v0[2], v0[3]); w.z = cvt_pk_bf16(v1[0], v1[1]); w.w = cvt_pk_bf16(v1[2], v1[3]);
                    *(u32x4*)(rowp + bj * HALF) = w; } }
    }
};
struct EpiResid {
    static constexpr bool PERM = false, AFTER_DRAIN = false;
    const float* xin_l; const float* xin_c; float* xout_l; float* xout_c; const float* gate;
    __device__ __forceinline__ void operator()(const f32x4 (&acc)[2][2][4][2], const Unit& u, int wr, int wc, int fr, int fq) const {
        const int r0 = u.pm * BM; const bool lat = r0 < ML; const int slot = lat ? r0 / SEQ : NB;
        const float* xin = lat ? xin_l + (size_t)r0 * D : xin_c + (size_t)(r0 - ML) * D;
        float* xout = lat ? xout_l + (size_t)r0 * D : xout_c + (size_t)(r0 - ML) * D;
        const int col0 = wc * 32 + 4 * fq;
        const float* gp = gate + (size_t)slot * NMOD + u.pn * BM;
        xin += u.pn * BM; xout += u.pn * BM;
#pragma unroll
        for (int ai = 0; ai < 2; ++ai)
#pragma unroll
            for (int m = 0; m < 4; ++m) { const int off = (ai * HALF + wr * 64 + m * 16 + fr) * D + col0;
#pragma unroll
                for (int bj = 0; bj < 2; ++bj)
#pragma unroll
                    for (int n = 0; n < 2; ++n) { const f32x4 xi = *(const f32x4*)(xin + off + bj * HALF + n * 16); const f32x4 gv = *(const f32x4*)(gp + col0 + bj * HALF + n * 16);
                        *(f32x4*)(xout + off + bj * HALF + n * 16) = xi + gv * acc[ai][bj][m][n]; }
                asm volatile("" ::: "memory"); }
    }
};

template <class Epi, class Sched, bool ALIGN_EPI = false, bool SP2 = false>
__device__ __forceinline__ void gemm_phase(PG8_LAS unsigned char* lds, const Gemm g, const Sched& S, const Epi& E, const int tid) {
    const int wid = __builtin_amdgcn_readfirstlane(tid >> 6), lane = tid & 63, wr = wid >> 2, wc = wid & 3, fr = lane & 15, fq = lane >> 4;
    const int K = g.K, nt = K / BK;
    unsigned voffA[2], voffB[2];
#pragma unroll
    for (int i = 0; i < 2; ++i) { int R, C; stage_rc(tid * 16 + i * 8192, R, C); const int Rb = Epi::PERM ? ((R & ~31) + perm32(R & 31)) : R;
        voffA[i] = (unsigned)(R * K + C) * 2u; voffB[i] = (unsigned)(Rb * K + C) * 2u; }
    const size_t kstep = (size_t)(BK * 2);
    const size_t hstep = (size_t)HALF * K * 2;
    const size_t tstep = 2 * hstep;
    const unsigned ldsw = (unsigned)wid * 1024u;
    const int aoff = lds_byte(wr * 64 + fr, fq * 8), boff = lds_byte(wc * 32 + fr, fq * 8);
#define PG8_SA(b, h) (((b) * 2 + (h)) * HTB)
#define PG8_SB(b, h) ((4 + (b) * 2 + (h)) * HTB)
#define PG8_STAGE(bufoff, gbase, voff) do { _Pragma("unroll") for (int _i = 0; _i < 2; ++_i) \
        __builtin_amdgcn_global_load_lds((const unsigned*)((const char*)(gbase) + (voff)[_i]), (PG8_LAS unsigned*)(lds + (bufoff) + ldsw + _i * 8192), 16, 0, 0); } while (0)
#define PG8_LDA(dst, b, h) do { _Pragma("unroll") for (int m = 0; m < 4; ++m) _Pragma("unroll") for (int k = 0; k < 2; ++k) dst[m][k] = *(const PG8_LAS bf16x8*)(lds + PG8_SA(b, h) + aoff + m * 2048 + k * 1024); } while (0)
#define PG8_LDB(dst, b, h) do { _Pragma("unroll") for (int n = 0; n < 2; ++n) _Pragma("unroll") for (int k = 0; k < 2; ++k) dst[n][k] = *(const PG8_LAS bf16x8*)(lds + PG8_SB(b, h) + boff + n * 2048 + k * 1024); } while (0)
#define PG8_MMA(ai, bj, At, Bt) do { __builtin_amdgcn_s_setprio(1); _Pragma("unroll") for (int m = 0; m < 4; ++m) _Pragma("unroll") for (int n = 0; n < 2; ++n) _Pragma("unroll") for (int k = 0; k < 2; ++k) \
        acc[ai][bj][m][n] = __builtin_amdgcn_mfma_f32_16x16x32_bf16(Bt[n][k], At[m][k], acc[ai][bj][m][n], 0, 0, 0); __builtin_amdgcn_s_setprio(0); } while (0)
#define PG8_WAIT_V(n) asm volatile("s_waitcnt vmcnt(" #n ")" ::: "memory")
#define PG8_WAIT_L(n) asm volatile("s_waitcnt lgkmcnt(" #n ")" ::: "memory")
#define PG8_BAR __builtin_amdgcn_s_barrier()
#define PG8_SCHED __builtin_amdgcn_sched_barrier(0)
    Unit cur, nxt; int ui = 0;
    if (!S.next(0, cur)) return;
    f32x4 acc[2][2][4][2];
#pragma unroll
    for (int a = 0; a < 2; ++a)
#pragma unroll
        for (int b = 0; b < 2; ++b)
#pragma unroll
            for (int m = 0; m < 4; ++m)
#pragma unroll
                for (int n = 0; n < 2; ++n) acc[a][b][m][n] = (f32x4){0.f, 0.f, 0.f, 0.f};
    bf16x8 At[4][2], B0[2][2], B1[2][2];
    const char* cA = (const char*)g.A + (size_t)cur.pm * tstep; const char* cB = (const char*)g.Bt + (size_t)cur.pn * tstep;
    S.a_ready(cur);
    if constexpr (SP2) {
        PG8_STAGE(PG8_SB(0, 0), cB, voffB); PG8_STAGE(PG8_SB(0, 1), cB + hstep, voffB); PG8_STAGE(PG8_SA(0, 0), cA, voffA); PG8_STAGE(PG8_SA(0, 1), cA + hstep, voffA);
        if (wr == 1) PG8_BAR;
        PG8_WAIT_V(2); PG8_BAR;
        PG8_STAGE(PG8_SB(1, 0), cB + kstep, voffB); PG8_STAGE(PG8_SA(1, 0), cA + kstep, voffA); PG8_STAGE(PG8_SB(1, 1), cB + hstep + kstep, voffB);
        PG8_WAIT_V(6); PG8_BAR;
    } else {
        PG8_STAGE(PG8_SB(0, 0), cB, voffB); PG8_STAGE(PG8_SA(0, 0), cA, voffA); PG8_STAGE(PG8_SB(0, 1), cB + hstep, voffB); PG8_STAGE(PG8_SA(0, 1), cA + hstep, voffA);
        if (wr == 1) PG8_BAR;
        PG8_WAIT_V(4); PG8_BAR;
        PG8_STAGE(PG8_SB(1, 0), cB + kstep, voffB); PG8_STAGE(PG8_SA(1, 0), cA + kstep, voffA); PG8_STAGE(PG8_SB(1, 1), cB + hstep + kstep, voffB);
        PG8_WAIT_V(6); PG8_BAR;
    }
    for (;;) {
        const bool has_next = S.next(ui + 1, nxt);
        const char* nA = has_next ? (const char*)g.A + (size_t)nxt.pm * tstep : cA; const char* nB = has_next ? (const char*)g.Bt + (size_t)nxt.pn * tstep : cB;
        for (int t = 0; t < nt; t += 2) {
            const bool last = (t == nt - 2);
            const char* a1 = cA + (size_t)(t + 1) * kstep;
            const char* a2 = last ? nA : cA + (size_t)(t + 2) * kstep; const char* b2 = last ? nB : cB + (size_t)(t + 2) * kstep;
            const char* a3 = a2 + kstep; const char* b3 = b2 + kstep;
            if (last && has_next) S.a_ready(nxt);
            if constexpr (SP2) {
            PG8_LDB(B0, 0, 0); PG8_LDB(B1, 0, 1); PG8_SCHED; PG8_LDA(At, 0, 0); PG8_STAGE(PG8_SA(1, 1), a1 + hstep, voffA);
            PG8_WAIT_V(8); PG8_WAIT_L(0); PG8_BAR; PG8_MMA(0, 0, At, B0); PG8_MMA(0, 1, At, B1); PG8_BAR; PG8_SCHED;
            PG8_LDA(At, 0, 1); PG8_STAGE(PG8_SB(0, 0), b2, voffB); PG8_STAGE(PG8_SB(0, 1), b2 + hstep, voffB); PG8_STAGE(PG8_SA(0, 0), a2, voffA);
            PG8_WAIT_V(8); PG8_WAIT_L(0); PG8_BAR; PG8_MMA(1, 0, At, B0); PG8_MMA(1, 1, At, B1); PG8_BAR; PG8_SCHED;
            PG8_LDB(B0, 1, 0); PG8_LDB(B1, 1, 1); PG8_SCHED; PG8_LDA(At, 1, 0); PG8_STAGE(PG8_SA(0, 1), a2 + hstep, voffA);
            PG8_WAIT_V(8); PG8_WAIT_L(0); PG8_BAR; PG8_MMA(0, 0, At, B0); PG8_MMA(0, 1, At, B1); PG8_BAR; PG8_SCHED;
            PG8_LDA(At, 1, 1); PG8_STAGE(PG8_SB(1, 0), b3, voffB); PG8_STAGE(PG8_SB(1, 1), b3 + hstep, voffB); PG8_STAGE(PG8_SA(1, 0), a3, voffA);
            PG8_WAIT_V(8); PG8_WAIT_L(0); PG8_BAR; PG8_MMA(1, 0, At, B0); PG8_MMA(1, 1, At, B1); PG8_BAR; PG8_SCHED;
            } else {
            PG8_LDB(B0, 0, 0); PG8_SCHED; PG8_LDA(At, 0, 0); PG8_STAGE(PG8_SA(1, 1), a1 + hstep, voffA);
            PG8_WAIT_L(8); PG8_BAR; PG8_WAIT_L(0); PG8_MMA(0, 0, At, B0); PG8_BAR; PG8_SCHED;
            PG8_LDB(B1, 0, 1); PG8_STAGE(PG8_SB(0, 0), b2, voffB);
            PG8_BAR; PG8_WAIT_L(0); PG8_MMA(0, 1, At, B1); PG8_BAR;
            PG8_LDA(At, 0, 1); PG8_STAGE(PG8_SA(0, 0), a2, voffA);
            PG8_BAR; PG8_WAIT_L(0); PG8_MMA(1, 0, At, B0); PG8_BAR; PG8_SCHED;
            PG8_STAGE(PG8_SB(0, 1), b2 + hstep, voffB);
            PG8_WAIT_V(6); PG8_BAR; PG8_MMA(1, 1, At, B1); PG8_BAR;
            PG8_LDB(B0, 1, 0); PG8_SCHED; PG8_LDA(At, 1, 0); PG8_STAGE(PG8_SA(0, 1), a2 + hstep, voffA);
            PG8_WAIT_L(8); PG8_BAR; PG8_WAIT_L(0); PG8_MMA(0, 0, At, B0); PG8_BAR; PG8_SCHED;
            PG8_LDB(B1, 1, 1); PG8_STAGE(PG8_SB(1, 0), b3, voffB);
            PG8_BAR; PG8_WAIT_L(0); PG8_MMA(0, 1, At, B1); PG8_BAR;
            PG8_LDA(At, 1, 1); PG8_STAGE(PG8_SA(1, 0), a3, voffA);
            PG8_BAR; PG8_WAIT_L(0); PG8_MMA(1, 0, At, B0); PG8_BAR; PG8_SCHED;
            PG8_STAGE(PG8_SB(1, 1), b3 + hstep, voffB);
            PG8_WAIT_V(6); PG8_BAR; PG8_MMA(1, 1, At, B1); PG8_BAR;
            }
        }
        if constexpr (ALIGN_EPI) { if (wr == 0) PG8_BAR; }
        if constexpr (!Epi::AFTER_DRAIN) { E(acc, cur, wr, wc, fr, fq); S.done(cur); }
        if (!has_next) break;
#pragma unroll
        for (int a = 0; a < 2; ++a)
#pragma unroll
            for (int b = 0; b < 2; ++b)
#pragma unroll
                for (int m = 0; m < 4; ++m)
#pragma unroll
                    for (int n = 0; n < 2; ++n) acc[a][b][m][n] = (f32x4){0.f, 0.f, 0.f, 0.f};
        cur = nxt; cA = nA; cB = nB; ++ui;
        if constexpr (ALIGN_EPI) { if (wr == 1) PG8_BAR; }
    }
    PG8_WAIT_V(0);
    if constexpr (!ALIGN_EPI) { if (wr == 0) PG8_BAR; }
    PG8_BAR;
    if constexpr (Epi::AFTER_DRAIN) { E.fused(acc, cur, wr, wc, fr, fq, lds, wid, lane); S.done(cur); }
#undef PG8_SA
#undef PG8_SB
#undef PG8_STAGE
#undef PG8_LDA
#undef PG8_LDB
#undef PG8_MMA
#undef PG8_WAIT_V
#undef PG8_WAIT_L
#undef PG8_BAR
#undef PG8_SCHED
}
}
#include <hip/hip_bf16.h>
#include <cmath>
namespace attn_body {
using bf16=__hip_bfloat16;
using bf16x8=__attribute__((ext_vector_type(8)))short;
using s16x4=__attribute__((ext_vector_type(4)))short;
using f32x16=__attribute__((ext_vector_type(16)))float;
using u32x4=__attribute__((ext_vector_type(4)))unsigned;
constexpr int D=64;
constexpr int QP=256,KP=128,OP=1024;
constexpr int NW=8,QBLK=32,QB=QBLK*NW,KVBLK=64;
constexpr int ATTN_UNIT_ROWS=QB;
__device__ __forceinline__ int crow(int r,int hi){return (r&3)+8*(r>>2)+4*hi;}
#define SBAR() __builtin_amdgcn_sched_barrier(0)
__device__ __forceinline__ void cmask(f32x16&p0,f32x16&p1,int jb,int qrel,int hi){
  const float NEG=-INFINITY; int kb=64*jb+4*hi;
  #pragma unroll
  for(int r=0;r<16;++r){int kv=kb+(r&3)+8*(r>>2); if(kv>qrel)p0[r]=NEG; if(kv+32>qrel)p1[r]=NEG;}
}

constexpr int NSLOT=3, SLOTB=8192;
constexpr int LDS_K=0, LDS_V=NSLOT*SLOTB, LDS_WS=2*NSLOT*SLOTB, LDS_OST=LDS_WS+NW*64*4, LDS_BYTES=LDS_OST+NW*4096;
constexpr float C2=0.125f*1.4426950408889634f;
__device__ __forceinline__ void glds16(const void*gsrc,unsigned lds_dst){unsigned keep;
  asm volatile("s_mov_b32 %0, m0\n\ts_mov_b32 m0, %2\n\ts_nop 0\n\tglobal_load_lds_dwordx4 %1, off\n\ts_mov_b32 m0, %0":"=&s"(keep):"v"(gsrc),"s"(lds_dst):"memory");}
__device__ __forceinline__ float max3f(float a,float b,float c){float r;asm("v_max3_f32 %0, %1, %2, %3":"=v"(r):"v"(a),"v"(b),"v"(c));return r;}
__device__ __forceinline__ float max2f(float a,float b){float r;asm("v_max_f32_e32 %0, %1, %2":"=v"(r):"v"(a),"v"(b));return r;}
__device__ __forceinline__ float fadd_s(float a,float b){float r;asm("v_add_f32_e32 %0, %1, %2":"=v"(r):"v"(a),"v"(b));return r;}
__device__ __forceinline__ float fsub_s(float a,float b){float r;asm("v_sub_f32_e32 %0, %1, %2":"=v"(r):"v"(a),"v"(b));return r;}
typedef float f32x2_t __attribute__((ext_vector_type(2))); typedef __bf16 bf16x2_t __attribute__((ext_vector_type(2)));
__device__ __forceinline__ unsigned cvtpk_s(float lo,float hi){f32x2_t v={lo,hi};bf16x2_t b=__builtin_convertvector(v,bf16x2_t);return __builtin_bit_cast(unsigned,b);}
#define WAIT_BAR(N) asm volatile("s_waitcnt vmcnt(" #N ") lgkmcnt(0)\n\ts_barrier":::"memory")

__device__ __forceinline__ void qkt(f32x16&p0,f32x16&p1,const char*Kslot,const bf16x8*qr,const f32x16&negm,int r32,int hi){
  const char*kb=Kslot+hi*1024+r32*16;
  #pragma unroll
  for(int d0=0;d0<4;++d0){
    const bf16x8 b0=*reinterpret_cast<const bf16x8*>(kb+d0*2048);
    const bf16x8 b1=*reinterpret_cast<const bf16x8*>(kb+d0*2048+512);
    if(d0==0){p0=__builtin_amdgcn_mfma_f32_32x32x16_bf16(b0,qr[0],negm,0,0,0);p1=__builtin_amdgcn_mfma_f32_32x32x16_bf16(b1,qr[0],negm,0,0,0);}
    else{p0=__builtin_amdgcn_mfma_f32_32x32x16_bf16(b0,qr[d0],p0,0,0,0);p1=__builtin_amdgcn_mfma_f32_32x32x16_bf16(b1,qr[d0],p1,0,0,0);}}
}
typedef __attribute__((address_space(3))) const char* lds_cptr;
typedef short v4i16_t __attribute__((ext_vector_type(4)));
__device__ __forceinline__ void kload8(bf16x8*kf,lds_cptr kp){
  kf[0]=*(const __attribute__((address_space(3))) bf16x8*)(kp);      kf[1]=*(const __attribute__((address_space(3))) bf16x8*)(kp+512);
  kf[2]=*(const __attribute__((address_space(3))) bf16x8*)(kp+2048); kf[3]=*(const __attribute__((address_space(3))) bf16x8*)(kp+2560);
  kf[4]=*(const __attribute__((address_space(3))) bf16x8*)(kp+4096); kf[5]=*(const __attribute__((address_space(3))) bf16x8*)(kp+4608);
  kf[6]=*(const __attribute__((address_space(3))) bf16x8*)(kp+6144); kf[7]=*(const __attribute__((address_space(3))) bf16x8*)(kp+6656);
}
__device__ __forceinline__ void kload2(bf16x8*kf,lds_cptr kp,int j){ kf[2*j]=*(const __attribute__((address_space(3))) bf16x8*)(kp+j*2048); kf[2*j+1]=*(const __attribute__((address_space(3))) bf16x8*)(kp+j*2048+512); }
__device__ __forceinline__ s16x4 vtr(lds_cptr p){ return __builtin_bit_cast(s16x4,__builtin_amdgcn_ds_read_tr16_b64_v4i16((__attribute__((address_space(3))) v4i16_t*)p)); }
__device__ __forceinline__ float rowmax(const f32x16&p0,const f32x16&p1){
  float a=max3f(p0[0],p0[1],p1[0]),b=max3f(p0[2],p0[3],p1[1]);a=max3f(a,p1[2],p1[3]);
  #pragma unroll
  for(int r=4;r<16;r+=4){a=max3f(a,p0[r],p0[r+1]);b=max3f(b,p0[r+2],p0[r+3]);a=max3f(a,p1[r],p1[r+1]);b=max3f(b,p1[r+2],p1[r+3]);}
  const float m=max2f(a,b);
  auto rr=__builtin_amdgcn_permlane32_swap(__float_as_uint(m),__float_as_uint(m),false,false);
  return max2f(__uint_as_float(rr[0]),__uint_as_float(rr[1]));
}
__device__ __forceinline__ void pv(f32x16*o,int vb,bf16x8 pa0,bf16x8 pa1,bf16x8 pa2,bf16x8 pa3){
  #pragma unroll
  for(int d0=0;d0<2;++d0){s16x4 lo[4],hi[4];
    #pragma unroll
    for(int ks=0;ks<4;++ks){
      asm volatile("ds_read_b64_tr_b16 %0,%1 offset:%c2":"=&v"(lo[ks]):"v"(vb),"i"(d0*4096+ks*1024):"memory");
      asm volatile("ds_read_b64_tr_b16 %0,%1 offset:%c2":"=&v"(hi[ks]):"v"(vb),"i"(d0*4096+ks*1024+512):"memory");}
    asm volatile("s_waitcnt lgkmcnt(0)":::"memory");SBAR();
    #define PK(k) (bf16x8){lo[k][0],lo[k][1],lo[k][2],lo[k][3],hi[k][0],hi[k][1],hi[k][2],hi[k][3]}
    o[d0]=__builtin_amdgcn_mfma_f32_32x32x16_bf16(pa0,PK(0),o[d0],0,0,0);
    o[d0]=__builtin_amdgcn_mfma_f32_32x32x16_bf16(pa1,PK(1),o[d0],0,0,0);
    o[d0]=__builtin_amdgcn_mfma_f32_32x32x16_bf16(pa2,PK(2),o[d0],0,0,0);
    o[d0]=__builtin_amdgcn_mfma_f32_32x32x16_bf16(pa3,PK(3),o[d0],0,0,0);
    #undef PK
  }
}

#ifndef ATTN_STORE16
#define ATTN_STORE16(p,v) (*(u32x4*)(p)=(v))
#endif
template<int THRL> __device__ __forceinline__ void attn_unit(const bf16*Qu,const bf16*__restrict__ Kh,const bf16*__restrict__ Vh,bf16*Ou,const int NT,char*shm,const int tid){
  const int lane=tid&63,r32=lane&31,hi=lane>>5; const int wid=__builtin_amdgcn_readfirstlane(tid>>6);
  const bf16*Qw=Qu+(long)(wid*QBLK)*QP;
  const unsigned lds0=(unsigned)(uintptr_t)shm;
  float*wsf=(float*)(shm+LDS_WS)+wid*64;
  const bf16*ksrc=Kh+(long)lane*KP+wid*8;
  const bf16*vsrc=Vh+(long)(16*(wid&3)+(lane>>2))*KP+(wid>>2)*32+(lane&3)*8;
  const unsigned kdst=lds0+LDS_K+wid*1024, vdst=lds0+LDS_V+wid*1024;
  #define DMA_K(t,slot) glds16(ksrc+(long)(t)*KVBLK*KP,(unsigned)__builtin_amdgcn_readfirstlane(kdst+(slot)))
  #define DMA_V(t,slot) glds16(vsrc+(long)(t)*KVBLK*KP,(unsigned)__builtin_amdgcn_readfirstlane(vdst+(slot)))
  const int vb0=(int)(lds0+LDS_V)+((lane>>4)&1)*32+(lane&3)*8+(4*hi+((lane&15)>>2))*64;
  const char*Kbase=shm+LDS_K; bf16x8 kf[8];
  const lds_cptr shm3=(lds_cptr)shm; const lds_cptr kp0=shm3+LDS_K+hi*1024+r32*16; const lds_cptr vp0=shm3+LDS_V+((lane>>4)&1)*32+(lane&3)*8+(4*hi+((lane&15)>>2))*64;
  DMA_K(0,0);DMA_V(0,0);DMA_K(1,SLOTB);
  bf16x8 qr[4];
  #pragma unroll
  for(int d0=0;d0<4;++d0)qr[d0]=*reinterpret_cast<const bf16x8*>(&Qw[(long)r32*QP+d0*16+hi*8]);
  float mhat=0.f,l_reg=0.f;f32x16 o[2];o[0]=f32x16{};o[1]=f32x16{};f32x16 negm=f32x16{};asm volatile("":"+v"(negm));
  #define CMASK(P0,P1,t) do{}while(0)
  bool resc=false;
  #define START(P0,P1) do{ const float rm=rowmax(P0,P1); resc=false; \
    { const float dl=rm; mhat=fadd_s(mhat,dl); \
      _Pragma("unroll") for(int r=0;r<16;++r){P0[r]=fsub_s(P0[r],dl);P1[r]=fsub_s(P1[r],dl);} \
      _Pragma("unroll") for(int r=0;r<16;++r)negm[r]=-mhat; asm volatile("":"+v"(negm)); } \
    _Pragma("unroll") for(int r=0;r<16;++r)P0[r]=__builtin_amdgcn_exp2f(P0[r]); }while(0)
  #define RESC() do{ if(resc){ asm volatile("s_waitcnt lgkmcnt(0)":::"memory"); \
      _Pragma("unroll") for(int d_=0;d_<2;++d_) _Pragma("unroll") for(int r=0;r<16;++r)o[d_][r]*=wsf[crow(r,hi)]; } }while(0)
  f32x16 pA0,pA1,pB0,pB1;
  int sl_prev=0,sl_cur=0,sl_next=SLOTB;
  #define ROT() do{sl_prev=sl_cur;sl_cur=sl_next;sl_next=(sl_next==(NSLOT-1)*SLOTB)?0:sl_next+SLOTB;}while(0)
  DMA_K(2,2*SLOTB);
  WAIT_BAR(3);
  qkt(pA0,pA1,Kbase,qr,negm,r32,hi);asm volatile("s_nop 15\n\ts_nop 7":"+v"(pA0),"+v"(pA1));CMASK(pA0,pA1,0);
  START(pA0,pA1);
  _Pragma("unroll") for(int r=0;r<16;++r)pA1[r]=__builtin_amdgcn_exp2f(pA1[r]);
  WAIT_BAR(0);
  DMA_K(3,0);DMA_V(1,SLOTB);
  ROT();
  kload8(kf,kp0+sl_cur);
  WAIT_BAR(2);
  s16x4 vlo[8],vhi[8]; u32x4 pw0,pw1,pw2,pw3;
  #define PKW(P,B) cvtpk_s(P[B],P[B+1])
  #define PAF(k) __builtin_bit_cast(bf16x8,pw##k)
  #define VFR(i) (bf16x8){vlo[i][0],vlo[i][1],vlo[i][2],vlo[i][3],vhi[i][0],vhi[i][1],vhi[i][2],vhi[i][3]}
  #define PIN(x) asm volatile("":"+v"(x))
  #define MX3(a,b,c) __builtin_fmaxf(__builtin_fmaxf((a),(b)),(c))
  #define GAPA(MF,A0,A1,A2,A3,W0,W1,PW) do{ MF; sacc+=A0; sacc+=A1; sacc+=A2; sacc+=A3; PIN(sacc); W0; W1; PIN(PW); SBAR(); }while(0)
  #define EX(v) __builtin_amdgcn_exp2f(v)
  #define GAPB(MF,X,B) do{ MF; X[B]=EX(X[B]); X[B+1]=EX(X[B+1]); X[B+2]=EX(X[B+2]); X[B+3]=EX(X[B+3]); PIN(X); SBAR(); }while(0)
  #define VRD(i) do{ vlo[i]=vtr(vp_+(((i)>>2)*4096+((i)&3)*1024)); vhi[i]=vtr(vp_+(((i)>>2)*4096+((i)&3)*1024+512)); }while(0)
  #define KRD(G,j) do{ if(G){ kload2(kf,kp0+sl_next,j); SBAR(); } }while(0)
  #define STEP(C0,C1,P0,P1,t,GK,GV,GL) do{ SBAR(); \
    const lds_cptr vp_=vp0+sl_prev; \
    VRD(0); SBAR(); float sacc=(P0[0]+P0[1]); \
    GAPA(C0=__builtin_amdgcn_mfma_f32_32x32x16_bf16(kf[0],qr[0],negm,0,0,0), P0[2],P0[3],P0[4],P0[5],     pw0[0]=PKW(P0,0), pw0[1]=PKW(P0,2), pw0); \
    VRD(4); SBAR(); GAPA(C1=__builtin_amdgcn_mfma_f32_32x32x16_bf16(kf[1],qr[0],negm,0,0,0), P0[6],P0[7],P0[8],P0[9],     pw0[2]=PKW(P0,4), pw0[3]=PKW(P0,6), pw0); \
    VRD(1); SBAR(); GAPA(C0=__builtin_amdgcn_mfma_f32_32x32x16_bf16(kf[2],qr[1],C0,0,0,0),   P0[10],P0[11],P0[12],P0[13], pw1[0]=PKW(P0,8), pw1[1]=PKW(P0,10), pw1); \
    VRD(5); SBAR(); GAPA(C1=__builtin_amdgcn_mfma_f32_32x32x16_bf16(kf[3],qr[1],C1,0,0,0),   P0[14],P0[15],P1[0],P1[1],   pw1[2]=PKW(P0,12),pw1[3]=PKW(P0,14), pw1); \
    VRD(2); SBAR(); GAPA(C0=__builtin_amdgcn_mfma_f32_32x32x16_bf16(kf[4],qr[2],C0,0,0,0),   P1[2],P1[3],P1[4],P1[5],     pw2[0]=PKW(P1,0), pw2[1]=PKW(P1,2), pw2); \
    VRD(6); SBAR(); GAPA(C1=__builtin_amdgcn_mfma_f32_32x32x16_bf16(kf[5],qr[2],C1,0,0,0),   P1[6],P1[7],P1[8],P1[9],     pw2[2]=PKW(P1,4), pw2[3]=PKW(P1,6), pw2); \
    VRD(3); SBAR(); GAPA(C0=__builtin_amdgcn_mfma_f32_32x32x16_bf16(kf[6],qr[3],C0,0,0,0),   P1[10],P1[11],P1[12],P1[13], pw3[0]=PKW(P1,8), pw3[1]=PKW(P1,10), pw3); \
    VRD(7); SBAR(); GAPA(C1=__builtin_amdgcn_mfma_f32_32x32x16_bf16(kf[7],qr[3],C1,0,0,0),   P1[14],P1[15],0.f,0.f,       pw3[2]=PKW(P1,12),pw3[3]=PKW(P1,14), pw3); \
    l_reg+=sacc; \
    if(GK){DMA_K((t)+3,sl_cur);} if(GV){DMA_V((t)+1,sl_next);} \
    CMASK(C0,C1,t); \
    { float a=MX3(C0[0],C0[1],C1[0]),b=MX3(C0[2],C0[3],C1[1]); a=MX3(a,C1[2],C1[3]); \
      _Pragma("unroll") for(int r=4;r<16;r+=4){a=MX3(a,C0[r],C0[r+1]);b=MX3(b,C0[r+2],C0[r+3]);a=MX3(a,C1[r],C1[r+1]);b=MX3(b,C1[r+2],C1[r+3]);} \
      float rm=__builtin_fmaxf(a,b); { auto rr=__builtin_amdgcn_permlane32_swap(__float_as_uint(rm),__float_as_uint(rm),false,false); rm=__builtin_fmaxf(__uint_as_float(rr[0]),__uint_as_float(rr[1])); } \
      resc=false; \
      if(__builtin_expect(__any(rm>(float)THRL),0)){ const float dl=__builtin_fmaxf(rm,0.f); mhat+=dl; \
        _Pragma("unroll") for(int r=0;r<16;++r){C0[r]-=dl;C1[r]-=dl;} \
        _Pragma("unroll") for(int r=0;r<16;++r)negm[r]=-mhat; asm volatile("":"+v"(negm)); \
        const float f=__builtin_amdgcn_exp2f(-dl); l_reg*=f; if(hi==0)wsf[r32]=f; resc=true; } } \
    SBAR(); \
    GAPB(o[0]=__builtin_amdgcn_mfma_f32_32x32x16_bf16(PAF(0),VFR(0),o[0],0,0,0), C0,0); \
    GAPB(o[1]=__builtin_amdgcn_mfma_f32_32x32x16_bf16(PAF(0),VFR(4),o[1],0,0,0), C0,4); \
    KRD(GL,0); GAPB(o[0]=__builtin_amdgcn_mfma_f32_32x32x16_bf16(PAF(1),VFR(1),o[0],0,0,0), C0,8); \
    KRD(GL,1); GAPB(o[1]=__builtin_amdgcn_mfma_f32_32x32x16_bf16(PAF(1),VFR(5),o[1],0,0,0), C0,12); \
    KRD(GL,2); GAPB(o[0]=__builtin_amdgcn_mfma_f32_32x32x16_bf16(PAF(2),VFR(2),o[0],0,0,0), C1,0); \
    KRD(GL,3); GAPB(o[1]=__builtin_amdgcn_mfma_f32_32x32x16_bf16(PAF(2),VFR(6),o[1],0,0,0), C1,4); \
    GAPB(o[0]=__builtin_amdgcn_mfma_f32_32x32x16_bf16(PAF(3),VFR(3),o[0],0,0,0), C1,8); \
    GAPB(o[1]=__builtin_amdgcn_mfma_f32_32x32x16_bf16(PAF(3),VFR(7),o[1],0,0,0), C1,12); \
    }while(0)
  int t=1;
  for(;t+5<NT;t+=2){
    STEP(pB0,pB1,pA0,pA1,t,true,true,true);     WAIT_BAR(2); RESC(); ROT();
    STEP(pA0,pA1,pB0,pB1,t+1,true,true,true);   WAIT_BAR(2); RESC(); ROT();
  }
  #define ENDW(tt) do{ if((tt)+3<NT){WAIT_BAR(2);} else if((tt)+2<NT){WAIT_BAR(1);} else {WAIT_BAR(0);} }while(0)
  for(;t+1<NT;t+=2){
    STEP(pB0,pB1,pA0,pA1,t,(t+3<NT),(t+1<NT),(t+1<NT));       ENDW(t);   RESC(); ROT();
    STEP(pA0,pA1,pB0,pB1,t+1,(t+4<NT),(t+2<NT),(t+2<NT));     ENDW(t+1); RESC(); ROT();
  }
  STEP(pB0,pB1,pA0,pA1,NT-1,false,false,false); RESC();
  { float sacc=pB0[0]+pB0[1]; _Pragma("unroll") for(int r=2;r<16;++r)sacc+=pB0[r]; _Pragma("unroll") for(int r=0;r<16;++r)sacc+=pB1[r]; l_reg+=sacc;
    pw0=(u32x4){PKW(pB0,0),PKW(pB0,2),PKW(pB0,4),PKW(pB0,6)};pw1=(u32x4){PKW(pB0,8),PKW(pB0,10),PKW(pB0,12),PKW(pB0,14)};pw2=(u32x4){PKW(pB1,0),PKW(pB1,2),PKW(pB1,4),PKW(pB1,6)};pw3=(u32x4){PKW(pB1,8),PKW(pB1,10),PKW(pB1,12),PKW(pB1,14)};
    SBAR(); pv(o,vb0+sl_cur,PAF(0),PAF(1),PAF(2),PAF(3)); }
  #undef PKW
  #undef PAF
  #undef VFR
  #undef PIN
  #undef MX3
  #undef GAPA
  #undef GAPB
  #undef EX
  #undef VRD
  #undef KRD
  #undef STEP
  #undef ENDW
  {auto rr=__builtin_amdgcn_permlane32_swap(__float_as_uint(l_reg),__float_as_uint(l_reg),false,false);l_reg=__uint_as_float(rr[0])+__uint_as_float(rr[1]);}
  if(hi==0)wsf[32+r32]=l_reg;asm volatile("s_waitcnt lgkmcnt(0)":::"memory");
  float rli[16];
  #pragma unroll
  for(int r=0;r<16;++r)rli[r]=__builtin_amdgcn_rcpf(wsf[32+crow(r,hi)]);
  bf16*Ow=Ou+(long)(wid*QBLK)*OP;
  { bf16*stg=(bf16*)(shm+LDS_OST)+wid*2048;
    #pragma unroll
    for(int r=0;r<16;++r){const int orow=crow(r,hi);
      #pragma unroll
      for(int d0=0;d0<2;++d0)stg[orow*64+d0*32+r32]=__float2bfloat16(o[d0][r]*rli[r]);}
    asm volatile("s_waitcnt lgkmcnt(0)":::"memory");
    #pragma unroll
    for(int i=0;i<4;++i){const int row=i*8+(lane>>3),ch=lane&7; const u32x4 v=*(const u32x4*)(stg+row*64+ch*8); ATTN_STORE16(Ow+(long)row*OP+ch*8,v);} }
  asm volatile("s_waitcnt lgkmcnt(0)\n\ts_barrier":::"memory");
  #undef DMA_K
  #undef DMA_V
  #undef CMASK
  #undef START
  #undef RESC
  #undef ROT
}
constexpr int ATTN_LDS_BYTES=LDS_BYTES;
#undef SBAR
#undef WAIT_BAR
}
#define GAS __attribute__((address_space(1)))
#define LAS __attribute__((address_space(3)))
typedef unsigned short bf16;
typedef unsigned v4u __attribute__((ext_vector_type(4)));
typedef unsigned v2u __attribute__((ext_vector_type(2)));
typedef float f32x4 __attribute__((ext_vector_type(4)));
typedef short bf16x8 __attribute__((ext_vector_type(8)));
constexpr int NWAVES = 8, NTHREADS = 512;
constexpr int RING_BYTES = 131072, LDS_BYTES = 147456;
#define LDS_WAIT() asm volatile("s_waitcnt lgkmcnt(0)" ::: "memory")
#define VM_WAIT() asm volatile("s_waitcnt vmcnt(0)" ::: "memory")
__device__ __forceinline__ unsigned f2bf(float f) { unsigned u = __builtin_bit_cast(unsigned, f); return (u + 0x7fffu + ((u >> 16) & 1u)) >> 16; }
__device__ __forceinline__ unsigned pk2(float lo, float hi) { return f2bf(lo) | (f2bf(hi) << 16); }
__device__ __forceinline__ float bf2f(unsigned short b) { return __builtin_bit_cast(float, ((unsigned)b) << 16); }
__device__ __forceinline__ float sigmoidf_(float x) { return 1.0f / (1.0f + __expf(-x)); }
__device__ __forceinline__ float siluf_(float x) { return x * sigmoidf_(x); }
__device__ __forceinline__ float wave_sum(float v) {
#pragma unroll
    for (int o = 1; o < 64; o <<= 1) v += __shfl_xor(v, o);
    return v;
}

constexpr size_t MiB = 1u << 20;
constexpr size_t WS_CTL = 0, WS_MOD = 1 * MiB;
constexpr size_t WS_WIN = 2 * MiB, WIN_BYTES = (size_t)PP * D * 2;
constexpr size_t WS_WOUT = WS_WIN + 2 * WIN_BYTES, WOUT_BYTES = (size_t)D * D * 2;
constexpr size_t WS_WUP = WS_WOUT + 2 * WOUT_BYTES, WUP_BYTES = (size_t)DFF * D * 2;
constexpr size_t WS_WDN = WS_WUP + 2 * WUP_BYTES, WDN_BYTES = (size_t)D * DFF * 2;
constexpr size_t WS_WPW = WS_WDN + 2 * WDN_BYTES, WPW_BYTES = (size_t)256 * 256 * 2;
static_assert(WS_WPW + 2 * WPW_BYTES <= 50 * MiB, "weights");
constexpr size_t WS_XC = 50 * MiB;
constexpr size_t WS_ACT = 54 * MiB;
constexpr size_t WS_P = 88 * MiB;
constexpr size_t WS_H = 88 * MiB;
constexpr size_t WS_QA = 182 * MiB;
constexpr size_t WS_KA = 191 * MiB, WS_VA = 196 * MiB;
constexpr size_t WS_KV = 201 * MiB;
constexpr size_t WS_DEC = 235 * MiB;
constexpr size_t WS_END = 256 * MiB;
static_assert(WS_P + (size_t)M * PP * 2 <= WS_QA && WS_H + (size_t)M * DFF * 2 <= WS_END && WS_ACT + (size_t)M * D * 2 <= WS_P, "ws map");

struct Args { const float* in[27]; float* out; unsigned char* ws; int ph_lo, ph_hi, layer, pad; };

template <class Map> __device__ __forceinline__ void transpose_item(const float* W, int K, int N, bf16* WT, LAS float* scr, int kb, int nb, int lane, Map srcc) {
    const int k0 = 64 * kb, n0 = 32 * nb; const int sc = srcc(n0 + (lane & 31));
#pragma unroll 8
    for (int i = 0; i < 32; ++i) { const int kk = 2 * i + (lane >> 5); scr[kk * 33 + (lane & 31)] = sc >= 0 ? W[(size_t)(k0 + kk) * N + sc] : 0.f; }
    LDS_WAIT(); asm volatile("" ::: "memory");
    const int c = lane & 7;
#pragma unroll
    for (int j = 0; j < 4; ++j) { const int n = (lane >> 3) + 8 * j; const LAS float* s = scr + (8 * c) * 33 + n;
        v4u o; o.x = pk2(s[0 * 33], s[1 * 33]); o.y = pk2(s[2 * 33], s[3 * 33]); o.z = pk2(s[4 * 33], s[5 * 33]); o.w = pk2(s[6 * 33], s[7 * 33]);
        *(GAS v4u*)(WT + (size_t)(n0 + n) * K + k0 + 8 * c) = o; }
    LDS_WAIT(); asm volatile("" ::: "memory");
}
struct MapId { __device__ __forceinline__ int operator()(int n) const { return n; } };
struct MapWin { __device__ __forceinline__ int operator()(int n) const { return n < 1280 ? n : (n < 2560 ? n + 16 : (n < 2576 ? n - 1280 : -1)); } };

__device__ __forceinline__ void ph_prologue(const Args& a, LAS unsigned char* lds, int tid, int lane, int wave, int bid, int G) {
    unsigned char* ws = a.ws;
    LAS float* scr = (LAS float*)(lds + wave * 16384);
    const int gw = bid * NWAVES + wave, NGW = G * NWAVES;
    constexpr int I_IN = (D / 64) * (PP / 32), I_OUT = (D / 64) * (D / 32), I_UP = (D / 64) * (DFF / 32), I_DN = (DFF / 64) * (D / 32), I_PW = (256 / 64) * (256 / 32);
    constexpr int I_L = I_IN + I_OUT + I_UP + I_DN + I_PW;
    for (int it = gw; it < DEPTH * I_L; it += NGW) {
        const int l = it / I_L; int r = it % I_L;
        if (r < I_IN) { transpose_item(a.in[8] + (size_t)l * D * PIN, D, PIN, (bf16*)(ws + WS_WIN + l * WIN_BYTES), scr, r / (PP / 32), r % (PP / 32), lane, MapWin()); continue; } r -= I_IN;
        if (r < I_OUT) { transpose_item(a.in[23] + (size_t)l * D * D, D, D, (bf16*)(ws + WS_WOUT + l * WOUT_BYTES), scr, r / (D / 32), r % (D / 32), lane, MapId()); continue; } r -= I_OUT;
        if (r < I_UP) { transpose_item(a.in[24] + (size_t)l * D * DFF, D, DFF, (bf16*)(ws + WS_WUP + l * WUP_BYTES), scr, r / (DFF / 32), r % (DFF / 32), lane, MapId()); continue; } r -= I_UP;
        if (r < I_DN) { transpose_item(a.in[25] + (size_t)l * DFF * D, DFF, D, (bf16*)(ws + WS_WDN + l * WDN_BYTES), scr, r / (D / 32), r % (D / 32), lane, MapId()); continue; } r -= I_DN;
        transpose_item(a.in[13] + (size_t)l * 256 * 256, 256, 256, (bf16*)(ws + WS_WPW + l * WPW_BYTES), scr, r / 8, r % 8, lane, MapId());
    }
    __syncthreads();
    LAS float* sil = (LAS float*)lds;
    LAS float* part = (LAS float*)(lds + NS * D * 4);
    float* MOD = (float*)(ws + WS_MOD);
    const float* c = a.in[1]; const float* cc = a.in[3]; const float* w_mod = a.in[4]; const float* b_mod = a.in[5];
    bool staged = false;
    for (int task = bid; task < DEPTH * (NMOD / 64); task += G) {
        if (!staged) { for (int i = tid; i < NS * D; i += NTHREADS) { const int s = i / D, k = i % D; const float v = s < NB ? c[s * D + k] : cc[k]; sil[i] = siluf_(v); } staged = true; __syncthreads(); }
        const int l = task / (NMOD / 64), c0 = (task % (NMOD / 64)) * 64;
        float acc[NS];
#pragma unroll
        for (int s = 0; s < NS; ++s) acc[s] = 0.f;
        const float* wp = w_mod + (size_t)l * D * NMOD + (size_t)(wave * 128) * NMOD + c0 + lane;
#pragma unroll 4
        for (int k = 0; k < 128; ++k) { const float wv = wp[(size_t)k * NMOD];
#pragma unroll
            for (int s = 0; s < NS; ++s) acc[s] += sil[s * D + wave * 128 + k] * wv; }
#pragma unroll
        for (int s = 0; s < NS; ++s) part[(wave * NS + s) * 64 + lane] = acc[s];
        __syncthreads();
        if (tid < NS * 64) { const int s = tid / 64, ln = tid % 64; float v = 0.f;
#pragma unroll
            for (int w = 0; w < 8; ++w) v += part[(w * NS + s) * 64 + ln];
            MOD[((size_t)l * NS + s) * NMOD + c0 + ln] = v + b_mod[(size_t)l * NMOD + c0 + ln]; }
        __syncthreads();
    }
}
__device__ __forceinline__ void ph_normmod(const float* xl, const float* xc, const float* g, const float* mod, int i_shift, int i_scale, bf16* XN, int nrows, int lane, int gw, int NGW) {
    for (int r = gw; r < nrows; r += NGW) {
        const float* xr = r < ML ? xl + (size_t)r * D : xc + (size_t)(r - ML) * D;
        const float* m = mod + (size_t)(r < ML ? r / SEQ : NB) * NMOD;
        f32x4 v[4]; float s = 0.f;
#pragma unroll
        for (int j = 0; j < 4; ++j) { v[j] = *(const f32x4*)(xr + 4 * lane + 256 * j); s += (v[j].x * v[j].x + v[j].y * v[j].y) + (v[j].z * v[j].z + v[j].w * v[j].w); }
        const float rs = 1.0f / sqrtf(wave_sum(s) * (1.0f / D) + EPS);
#pragma unroll
        for (int j = 0; j < 4; ++j) { const int c0 = 4 * lane + 256 * j;
            const f32x4 gg = *(const f32x4*)(g + c0), sc = *(const f32x4*)(m + i_scale * D + c0), sh = *(const f32x4*)(m + i_shift * D + c0);
            const f32x4 o = v[j] * rs * gg * (sc + 1.0f) + sh;
            v2u w; w.x = pk2(o.x, o.y); w.y = pk2(o.z, o.w); *(v2u*)(XN + (size_t)r * D + c0) = w; }
    }
}
__device__ __forceinline__ void ph_final(float* x, const float* g, int lane, int gw, int NGW) {
    for (int r = gw; r < ML; r += NGW) {
        float* xr = x + (size_t)r * D;
        f32x4 v[4]; float s = 0.f;
#pragma unroll
        for (int j = 0; j < 4; ++j) { v[j] = *(const f32x4*)(xr + 4 * lane + 256 * j); s += (v[j].x * v[j].x + v[j].y * v[j].y) + (v[j].z * v[j].z + v[j].w * v[j].w); }
        const float rs = 1.0f / sqrtf(wave_sum(s) * (1.0f / D) + EPS);
#pragma unroll
        for (int j = 0; j < 4; ++j) { const int c0 = 4 * lane + 256 * j; *(f32x4*)(xr + c0) = v[j] * rs * *(const f32x4*)(g + c0); }
    }
}
#define RLX_AGENT __ATOMIC_RELAXED, __HIP_MEMORY_SCOPE_AGENT
#define XB_TMO      128
#define XB_XCNT(j)  (256  + 64 * (j))
#define XB_XSUB(j)  (1280 + 64 * (j))
#define XB_XGEN(j)  (2304 + 64 * (j))
#define XB_TOP      3328
#define XB_TOPGEN   3392
#define XCD_BAR_WORDS 3456
#define XB_SPIN_CAP (1u << 18)

__device__ __forceinline__ unsigned xb_ld(unsigned* p)              { return __hip_atomic_load(p, __ATOMIC_RELAXED, __HIP_MEMORY_SCOPE_AGENT); }
__device__ __forceinline__ unsigned xb_add(unsigned* p, unsigned v) { return __hip_atomic_fetch_add(p, v, __ATOMIC_RELAXED, __HIP_MEMORY_SCOPE_AGENT); }
__device__ __forceinline__ unsigned xb_xcc_id() { return (unsigned)__builtin_amdgcn_s_getreg((3 << 11) | 20) & 0xFu; }
#define XB_SPIN(cond, bar) do { unsigned _sp = 0; while (cond) { __builtin_amdgcn_s_sleep(1); \
    if ((++_sp & 255u) == 0u) { if (xb_ld(&(bar)[XB_TMO])) break; if (_sp > XB_SPIN_CAP) { atomicAdd(&(bar)[XB_TMO], 1u); break; } } } } while (0)

struct XcdBarrier {
    unsigned* bar; unsigned x;
    volatile LAS unsigned* st;
};

__device__ __forceinline__ XcdBarrier xcd_barrier_post(unsigned* bar, volatile LAS unsigned* st) {
    XcdBarrier b; b.bar = bar; b.x = xb_xcc_id(); b.st = st;
    if (threadIdx.x == 0) (void)xb_add(&bar[XB_XCNT(b.x)], 1u);
    return b;
}
__device__ __forceinline__ void xcd_barrier_complete(unsigned* bar, unsigned x, unsigned& nloc, unsigned& nx) {
    const unsigned G = gridDim.x * gridDim.y * gridDim.z;
    unsigned sum, cnt, mine, sp = 0u;
    for (;;) {
        sum = 0u; cnt = 0u; mine = 0u;
#pragma unroll
        for (unsigned j = 0; j < 16; ++j) { const unsigned c = xb_ld(&bar[XB_XCNT(j)]); sum += c; cnt += (c > 0u) ? 1u : 0u; mine = (j == x) ? c : mine; }
        if (sum == G) break;
        __builtin_amdgcn_s_sleep(1);
        if ((++sp & 255u) == 0u) { if (xb_ld(&bar[XB_TMO])) break; if (sp > XB_SPIN_CAP) { atomicAdd(&bar[XB_TMO], 1u); break; } }
    }
    nloc = mine > 0u ? mine : 1u; nx = cnt > 0u ? cnt : 1u;
}

__device__ __forceinline__ void xcd_barrier(const XcdBarrier& b) {
    asm volatile("s_waitcnt vmcnt(0)" ::: "memory");
    __syncthreads();
    if (threadIdx.x == 0) {
        unsigned* bar = b.bar;
        __builtin_amdgcn_s_waitcnt(0);
        unsigned nloc = b.st[0], nx = b.st[1];
        if (nloc == 0u) { xcd_barrier_complete(bar, b.x, nloc, nx); b.st[0] = nloc; b.st[1] = nx; }
        const unsigned old = xb_add(&bar[XB_XSUB(b.x)], 1u);
        const unsigned gen = old / nloc;
        if (old + 1u == (gen + 1u) * nloc) {
            __builtin_amdgcn_fence(__ATOMIC_RELEASE, "agent");
            asm volatile("s_waitcnt vmcnt(0)" ::: "memory");
            const unsigned og = xb_add(&bar[XB_TOP], 1u);
            const unsigned tg = og / nx;
            if (og + 1u == (tg + 1u) * nx) xb_add(&bar[XB_TOPGEN], 1u);
            else XB_SPIN(xb_ld(&bar[XB_TOPGEN]) == tg, bar);
            __builtin_amdgcn_fence(__ATOMIC_ACQUIRE, "agent");
            xb_add(&bar[XB_XGEN(b.x)], 1u);
            asm volatile("s_waitcnt vmcnt(0)" ::: "memory");
        } else {
            XB_SPIN(xb_ld(&bar[XB_XGEN(b.x)]) == gen, bar);
            __builtin_amdgcn_fence(__ATOMIC_ACQUIRE, "agent");
            asm volatile("s_waitcnt vmcnt(0)" ::: "memory");
        }
    }
    __syncthreads();
}
__device__ __forceinline__ void ph_attprep(const bf16* P, const float* qg, const float* kg, bf16* QA, bf16* KA, bf16* VA, int lane, int gw, int NGW) {
    const float gq = qg[lane], gk = kg[lane];
    const int kk = lane & 31; const float inv = exp2f(-(float)(kk & 15) * (13.287712379549449f / 16.0f));
    for (int r = gw; r < M; r += NGW) {
        const bool lat = r < ML; const int b = lat ? r / SEQ : (r - ML) / CTX, t = lat ? r % SEQ : (r - ML) % CTX;
        const bf16* pr = P + (size_t)r * PP;
        float cs = 1.f, sn = 0.f;
        if (lat) { const float ang = (float)(kk < 16 ? t / GRIDW : t % GRIDW) * inv; sincosf(ang, &sn, &cs); }
        const float sgn = lane < 32 ? -1.f : 1.f;
        const size_t krow = (size_t)b * KEYS + (lat ? CTX + t : t);
#pragma unroll
        for (int h = 0; h < 6; ++h) {
            const float x = bf2f(pr[(h < 4 ? OFF_AQ + h * 64 : OFF_AK + (h - 4) * 64) + lane]);
            const float rs = 1.0f / sqrtf(wave_sum(x * x) * (1.0f / 64) + EPS);
            const float v = x * rs * (h < 4 ? gq : gk);
            const float o = v * cs + sgn * __shfl_xor(v, 32) * sn;
            if (h < 4) QA[(size_t)r * 256 + h * 64 + lane] = (bf16)f2bf(o * (0.125f * 1.4426950408889634f));
            else KA[krow * 128 + (h - 4) * 64 + lane] = (bf16)f2bf(o);
        }
        VA[krow * 128 + lane] = pr[OFF_AV + lane]; VA[krow * 128 + 64 + lane] = pr[OFF_AV + 64 + lane];
    }
}
__device__ __forceinline__ void ph_attention(const bf16* QA, const bf16* KA, const bf16* VA, bf16* Y, bool need_ctx, char* lds, int bid, int G, int tid) {
    const int vcu = (G % 8 == 0) ? (bid % 8) * (G / 8) + bid / 8 : bid;
    const int NU = 256 + (need_ctx ? 16 : 0);
    for (int u = vcu; u < NU; u += G) {
        if (u < 256) { const int b = u >> 6, h = (u >> 4) & 3, qb = u & 15; const size_t row = (size_t)b * SEQ + qb * 256;
            attn_body::attn_unit<8>((const attn_body::bf16*)(QA + row * 256 + h * 64), (const attn_body::bf16*)(KA + (size_t)b * KEYS * 128 + (h >> 1) * 64), (const attn_body::bf16*)(VA + (size_t)b * KEYS * 128 + (h >> 1) * 64),
                                    (attn_body::bf16*)(Y + row * D + 512 + h * 64), KEYS / 64, lds, tid); }
        else { const int b = (u - 256) >> 2, h = (u - 256) & 3; const size_t row = (size_t)ML + b * CTX;
            attn_body::attn_unit<8>((const attn_body::bf16*)(QA + row * 256 + h * 64), (const attn_body::bf16*)(KA + (size_t)b * KEYS * 128 + (h >> 1) * 64), (const attn_body::bf16*)(VA + (size_t)b * KEYS * 128 + (h >> 1) * 64),
                                    (attn_body::bf16*)(Y + row * D + 512 + h * 64), CTX / 64, lds, tid); }
    }
}
__device__ __forceinline__ void ph_conv(const bf16* P, const float* w_dw, const float* b_dw, const float* ln_g, const float* ln_b, const bf16* PwT, const float* b_pw, bf16* Y, int nrows,
                                        LAS unsigned char* lds, int tid, int lane, int wave, int bid, int G) {
    typedef float f32x4_t __attribute__((ext_vector_type(4)));
    LAS float* U = (LAS float*)lds; LAS unsigned char* Zb = lds + 96256; constexpr int ZS = 528;
    const int nunits = nrows / 64;
    if (bid >= nunits) return;
    const int ch = tid & 255, half = tid >> 8;
    float wreg[31];
#pragma unroll
    for (int j = 0; j < 31; ++j) wreg[j] = w_dw[j * 256 + ch];
    const float bdw = b_dw[ch];
    const f32x4_t lg = *(const f32x4_t*)(ln_g + 4 * lane), lb = *(const f32x4_t*)(ln_b + 4 * lane);
    bf16x8 wf[2][8];
#pragma unroll
    for (int nt = 0; nt < 2; ++nt)
#pragma unroll
        for (int ks = 0; ks < 8; ++ks) wf[nt][ks] = *(const bf16x8*)(PwT + (size_t)(32 * wave + 16 * nt + (lane & 15)) * 256 + 32 * ks + 8 * (lane >> 4));
    const f32x4_t bp0 = *(const f32x4_t*)(b_pw + 32 * wave + 4 * (lane >> 4)), bp1 = *(const f32x4_t*)(b_pw + 32 * wave + 16 + 4 * (lane >> 4));
    for (int u = bid; u < nunits; u += G) {
        const int r0 = u * 64; int base, t0, T;
        if (r0 < ML) { base = (r0 / SEQ) * SEQ; t0 = r0 % SEQ; T = SEQ; } else { const int rc = r0 - ML; base = ML + (rc / CTX) * CTX; t0 = rc % CTX; T = CTX; }
        for (int i = tid >> 5; i < 94; i += 16) {
            const int tt = t0 - 15 + i, c8 = (tid & 31) * 8;
            f32x4_t o0 = {0.f, 0.f, 0.f, 0.f}, o1 = {0.f, 0.f, 0.f, 0.f};
            if (tt >= 0 && tt < T) {
                const bf16* pr = P + (size_t)(base + tt) * PP;
                const bf16x8 av = *(const bf16x8*)(pr + OFF_CA + c8), gv = *(const bf16x8*)(pr + OFF_CG + c8);
#pragma unroll
                for (int e = 0; e < 4; ++e) { o0[e] = bf2f((unsigned short)av[e]) * sigmoidf_(bf2f((unsigned short)gv[e])); o1[e] = bf2f((unsigned short)av[4 + e]) * sigmoidf_(bf2f((unsigned short)gv[4 + e])); }
            }
            *(LAS f32x4_t*)(U + i * 256 + c8) = o0; *(LAS f32x4_t*)(U + i * 256 + c8 + 4) = o1;
        }
        __syncthreads();
        float y[32];
        {
            float uu[62];
#pragma unroll
            for (int i = 0; i < 62; ++i) uu[i] = U[(32 * half + i) * 256 + ch];
#pragma unroll
            for (int t = 0; t < 32; ++t) { float acc = bdw;
#pragma unroll
                for (int j = 0; j < 31; ++j) acc += uu[t + j] * wreg[j];
                y[t] = acc; }
        }
        __syncthreads();
#pragma unroll
        for (int t = 0; t < 32; ++t) U[(32 * half + t) * 256 + ch] = y[t];
        __syncthreads();
#pragma unroll 2
        for (int q = 0; q < 8; ++q) { const int tok = 8 * wave + q;
            const f32x4_t v = *(LAS f32x4_t*)(U + tok * 256 + 4 * lane);
            const float mu = wave_sum((v.x + v.y) + (v.z + v.w)) * (1.0f / 256);
            const f32x4_t dv = v - mu;
            const float var = wave_sum((dv.x * dv.x + dv.y * dv.y) + (dv.z * dv.z + dv.w * dv.w)) * (1.0f / 256);
            const float rs = 1.0f / sqrtf(var + EPS);
            f32x4_t o = dv * rs * lg + lb;
#pragma unroll
            for (int e = 0; e < 4; ++e) o[e] = siluf_(o[e]);
            v2u w; w.x = pk2(o.x, o.y); w.y = pk2(o.z, o.w);
            *(LAS v2u*)(Zb + tok * ZS + 8 * lane) = w; }
        __syncthreads();
        f32x4_t acc[2][4];
#pragma unroll
        for (int nt = 0; nt < 2; ++nt)
#pragma unroll
            for (int tt = 0; tt < 4; ++tt) acc[nt][tt] = (f32x4_t){0.f, 0.f, 0.f, 0.f};
#pragma unroll
        for (int ks = 0; ks < 8; ++ks) {
            bf16x8 zf[4];
#pragma unroll
            for (int tt = 0; tt < 4; ++tt) zf[tt] = *(LAS bf16x8*)(Zb + (16 * tt + (lane & 15)) * ZS + 64 * ks + 16 * (lane >> 4));
#pragma unroll
            for (int nt = 0; nt < 2; ++nt)
#pragma unroll
                for (int tt = 0; tt < 4; ++tt) acc[nt][tt] = __builtin_amdgcn_mfma_f32_16x16x32_bf16(wf[nt][ks], zf[tt], acc[nt][tt], 0, 0, 0);
        }
#pragma unroll
        for (int tt = 0; tt < 4; ++tt) { bf16* yr = Y + (size_t)(r0 + 16 * tt + (lane & 15)) * D + 32 * wave + 4 * (lane >> 4);
            const f32x4_t a0 = acc[0][tt] + bp0, a1 = acc[1][tt] + bp1;
            v2u w0, w1; w0.x = pk2(a0.x, a0.y); w0.y = pk2(a0.z, a0.w); w1.x = pk2(a1.x, a1.y); w1.y = pk2(a1.z, a1.w);
            *(v2u*)yr = w0; *(v2u*)(yr + 16) = w1; }
        __syncthreads();
    }
}
constexpr int NSLOT = (CTX + SEQ) / 64, NCHAIN = 2 * 2 * NB * 4;
constexpr size_t WS_ROPE = 256 * 1024;
constexpr int SL_QD = 0, SL_KI = 10240, SL_SC = 20480, SL_VT = 38912, SL_ST = 48128, SL_TOT = 58368, SL_ZS = 60416, SL_OX = 64512, SL_END = 80896;
template <int MODE> __device__ __forceinline__ void scan_units(const Args& a, int l, bool need_ctx, LAS unsigned char* lds, int tid, int lane, int wave, int bid, int G) {
    typedef float f32x4_t __attribute__((ext_vector_type(4)));
    typedef float f32x2_t __attribute__((ext_vector_type(2)));
    unsigned char* ws = a.ws;
    const bf16* P = (const bf16*)(ws + WS_P); bf16* Y = (bf16*)(ws + WS_ACT);
    float* KV = (float*)(ws + WS_KV); float* DEC = (float*)(ws + WS_DEC);
    const f32x2_t* ROPE = (const f32x2_t*)(ws + WS_ROPE);
    const int slot_lo = (MODE == 3 && !need_ctx) ? 4 : 0, nsl = NSLOT - slot_lo, nunits = 2 * NB * 4 * nsl;
    const int col = lane, dir = col >> 5, d = col & 31, seg = wave, g = lane >> 4, li = lane & 15;
    for (int u = bid; u < nunits; u += G) {
        const int mixer = u / (NB * 4 * nsl), rem = u % (NB * 4 * nsl), b = rem / (4 * nsl), h = (rem / nsl) & 3, slot = slot_lo + rem % nsl;
        const bool lat = slot >= 4; const int t0 = lat ? (slot - 4) * 64 : slot * 64; const int r0 = lat ? b * SEQ + t0 : ML + b * CTX + t0;
        const int oq = mixer ? OFF_RQ : OFF_GQ, ok = mixer ? OFF_RK : OFF_GK, ov = mixer ? OFF_RV : OFF_GV, og = mixer ? OFF_RG : OFF_GR;
        float la[8];
        if (mixer == 0) {
            LAS float* zs = (LAS float*)(lds + SL_ZS) + wave * 128;
            zs[lane] = bf2f(P[(size_t)(r0 + 8 * seg + (lane >> 4)) * PP + OFF_Z + (lane & 15)]);
            zs[64 + lane] = bf2f(P[(size_t)(r0 + 8 * seg + 4 + (lane >> 4)) * PP + OFF_Z + (lane & 15)]);
            const float* wa = (dir ? a.in[17] : a.in[15]) + (size_t)l * 16 * 128 + h * 32 + d; const float ba = (dir ? a.in[18] : a.in[16])[l * 128 + h * 32 + d];
            float wv[16];
#pragma unroll
            for (int j = 0; j < 16; ++j) wv[j] = wa[j * 128];
            LDS_WAIT();
#pragma unroll
            for (int i = 0; i < 8; ++i) { float pre = ba;
#pragma unroll
                for (int j = 0; j < 16; ++j) pre += zs[i * 16 + j] * wv[j];
                la[i] = (fminf(pre, 0.f) - log1pf(expf(-fabsf(pre)))) * (1.0f / 16.0f); }
        } else {
            const float lg = log1pf(-exp2f(-5.0f - (float)h));
#pragma unroll
            for (int i = 0; i < 8; ++i) la[i] = lg;
        }
        float cum[8];
        if (dir == 0) { float r = 0.f;
#pragma unroll
            for (int i = 0; i < 8; ++i) { r += la[i]; cum[i] = r; } ((LAS float*)(lds + SL_TOT))[seg * 64 + col] = r; }
        else { float r = 0.f;
#pragma unroll
            for (int i = 7; i >= 0; --i) { r += la[i]; cum[i] = r; } ((LAS float*)(lds + SL_TOT))[seg * 64 + col] = r; }
        float qv[8], kv[8];
#pragma unroll
        for (int i = 0; i < 8; ++i) { const bf16* pr = P + (size_t)(r0 + 8 * seg + i) * PP;
            float q = bf2f(pr[oq + h * 32 + d]), k = bf2f(pr[ok + h * 32 + d]);
            if (mixer == 0) q *= 0.17677669529663687f;
            else { k *= 0.17677669529663687f;
                if (lat) { const float qp = bf2f(pr[oq + h * 32 + (d ^ 16)]), kp = bf2f(pr[ok + h * 32 + (d ^ 16)]) * 0.17677669529663687f;
                    const f32x2_t cs = ROPE[(size_t)(t0 + 8 * seg + i) * 16 + (d & 15)]; const float sg = d < 16 ? -1.f : 1.f;
                    q = q * cs.x + sg * qp * cs.y; k = k * cs.x + sg * kp * cs.y; } }
            qv[i] = q; kv[i] = k; }
        { v4u w; unsigned short vv[8];
#pragma unroll
            for (int i = 0; i < 8; ++i) vv[i] = P[(size_t)(r0 + 8 * wave + i) * PP + ov + h * 64 + lane];
            w.x = vv[0] | ((unsigned)vv[1] << 16); w.y = vv[2] | ((unsigned)vv[3] << 16); w.z = vv[4] | ((unsigned)vv[5] << 16); w.w = vv[6] | ((unsigned)vv[7] << 16);
            *(LAS v4u*)(lds + SL_VT + lane * 144 + wave * 16) = w; }
        const int chain_f = ((mixer * 2 + 0) * NB + b) * 4 + h, chain_b = ((mixer * 2 + 1) * NB + b) * 4 + h;
        if (MODE == 3) {
#pragma unroll
            for (int dd = 0; dd < 2; ++dd) { const float* S = KV + ((size_t)(dd ? chain_b : chain_f) * NSLOT + slot) * 2048;
                const f32x4_t s4 = *(const f32x4_t*)(S + tid * 4); v2u w; w.x = pk2(s4.x, s4.y); w.y = pk2(s4.z, s4.w);
                *(LAS v2u*)(lds + SL_ST + dd * 5120 + (tid >> 3) * 80 + (tid & 7) * 8) = w; }
        }
        __syncthreads();
        {
            const LAS float* tot = (const LAS float*)(lds + SL_TOT); float off = 0.f, total = 0.f;
#pragma unroll
            for (int s2 = 0; s2 < 8; ++s2) { const float tv = tot[s2 * 64 + col]; total += tv; if (dir == 0 ? (s2 < seg) : (s2 > seg)) off += tv; }
            if (MODE == 3) {
#pragma unroll
                for (int i = 0; i < 8; ++i) { const float c = cum[i] + off; const int s = 8 * seg + i;
                    *(LAS unsigned short*)(lds + SL_QD + dir * 5120 + s * 80 + d * 2) = (unsigned short)f2bf(qv[i] * expf(c));
                    *(LAS unsigned short*)(lds + SL_KI + dir * 5120 + s * 80 + d * 2) = (unsigned short)f2bf(kv[i] * expf(-c)); }
            } else {
                v4u w; unsigned short ke[8];
#pragma unroll
                for (int i = 0; i < 8; ++i) ke[i] = (unsigned short)f2bf(kv[i] * expf(total - (cum[i] + off)));
                w.x = ke[0] | ((unsigned)ke[1] << 16); w.y = ke[2] | ((unsigned)ke[3] << 16); w.z = ke[4] | ((unsigned)ke[5] << 16); w.w = ke[6] | ((unsigned)ke[7] << 16);
                *(LAS v4u*)(lds + SL_KI + dir * 4608 + d * 144 + seg * 16) = w;
                if (seg == 0) DEC[((size_t)(dir ? chain_b : chain_f) * NSLOT + slot) * 32 + d] = expf(total);
            }
        }
        __syncthreads();
        const int wdir = wave >> 2, wt = wave & 3;
        if (MODE == 1) {
            f32x4_t acc[2] = {(f32x4_t){0.f, 0.f, 0.f, 0.f}, (f32x4_t){0.f, 0.f, 0.f, 0.f}};
#pragma unroll
            for (int ks = 0; ks < 2; ++ks) { const bf16x8 af = *(LAS bf16x8*)(lds + SL_VT + (16 * wt + li) * 144 + 64 * ks + 16 * g);
#pragma unroll
                for (int dt = 0; dt < 2; ++dt) { const bf16x8 bfr = *(LAS bf16x8*)(lds + SL_KI + wdir * 4608 + (16 * dt + li) * 144 + 64 * ks + 16 * g);
                    acc[dt] = __builtin_amdgcn_mfma_f32_16x16x32_bf16(af, bfr, acc[dt], 0, 0, 0); } }
            float* dst = KV + ((size_t)(wdir ? chain_b : chain_f) * NSLOT + slot) * 2048;
#pragma unroll
            for (int dt = 0; dt < 2; ++dt)
#pragma unroll
                for (int r = 0; r < 4; ++r) dst[(16 * wt + 4 * g + r) * 32 + 16 * dt + li] = acc[dt][r];
        } else {
            const int ct = wt;
            const bf16x8 qf = *(LAS bf16x8*)(lds + SL_QD + wdir * 5120 + (16 * ct + li) * 80 + 16 * g);
#pragma unroll
            for (int st = 0; st < 4; ++st) {
                f32x4_t sc = {0.f, 0.f, 0.f, 0.f};
                const bool live = wdir == 0 ? (st <= ct) : (st >= ct);
                if (live) { const bf16x8 kf = *(LAS bf16x8*)(lds + SL_KI + wdir * 5120 + (16 * st + li) * 80 + 16 * g);
                    sc = __builtin_amdgcn_mfma_f32_16x16x32_bf16(kf, qf, sc, 0, 0, 0);
                    if (st == ct) {
#pragma unroll
                        for (int r = 0; r < 4; ++r) { const int s = 4 * g + r, c = li; if (wdir == 0 ? (s > c) : (s < c)) sc[r] = 0.f; } } }
                v2u w; w.x = pk2(sc[0], sc[1]); w.y = pk2(sc[2], sc[3]);
                *(LAS v2u*)(lds + SL_SC + wdir * 9216 + (16 * ct + li) * 144 + (16 * st + 4 * g) * 2) = w; }
            LDS_WAIT();
            f32x4_t acc[4];
#pragma unroll
            for (int et = 0; et < 4; ++et) acc[et] = (f32x4_t){0.f, 0.f, 0.f, 0.f};
            const bf16x8 s0 = *(LAS bf16x8*)(lds + SL_SC + wdir * 9216 + (16 * ct + li) * 144 + 16 * g), s1 = *(LAS bf16x8*)(lds + SL_SC + wdir * 9216 + (16 * ct + li) * 144 + 64 + 16 * g);
#pragma unroll
            for (int et = 0; et < 4; ++et) {
                const bf16x8 v0 = *(LAS bf16x8*)(lds + SL_VT + (16 * et + li) * 144 + 16 * g), v1 = *(LAS bf16x8*)(lds + SL_VT + (16 * et + li) * 144 + 64 + 16 * g);
                const bf16x8 stf = *(LAS bf16x8*)(lds + SL_ST + wdir * 5120 + (16 * et + li) * 80 + 16 * g);
                acc[et] = __builtin_amdgcn_mfma_f32_16x16x32_bf16(v0, s0, acc[et], 0, 0, 0);
                acc[et] = __builtin_amdgcn_mfma_f32_16x16x32_bf16(v1, s1, acc[et], 0, 0, 0);
                acc[et] = __builtin_amdgcn_mfma_f32_16x16x32_bf16(stf, qf, acc[et], 0, 0, 0); }
            LAS float* ox = (LAS float*)(lds + SL_OX) + ct * 1024;
            if (wdir == 1) {
#pragma unroll
                for (int et = 0; et < 4; ++et)
#pragma unroll
                    for (int r = 0; r < 4; ++r) ox[(et * 4 + r) * 64 + lane] = acc[et][r]; }
            __syncthreads();
            if (wdir == 0) {
                float ss = 0.f;
#pragma unroll
                for (int et = 0; et < 4; ++et)
#pragma unroll
                    for (int r = 0; r < 4; ++r) { acc[et][r] += ox[(et * 4 + r) * 64 + lane]; ss += acc[et][r] * acc[et][r]; }
                ss += __shfl_xor(ss, 16); ss += __shfl_xor(ss, 32);
                const float rs = 1.0f / sqrtf(ss * (1.0f / 64) + EPS);
                const int row = r0 + 16 * ct + li; const float* ng = (mixer ? a.in[22] : a.in[19]) + l * 256 + h * 64;
#pragma unroll
                for (int et = 0; et < 4; ++et) { const int e0 = 16 * et + 4 * g;
                    const v2u gt = *(const v2u*)(P + (size_t)row * PP + og + h * 64 + e0); const f32x4_t gn = *(const f32x4_t*)(ng + e0);
                    const float g0 = bf2f((unsigned short)(gt.x & 0xffff)), g1 = bf2f((unsigned short)(gt.x >> 16)), g2 = bf2f((unsigned short)(gt.y & 0xffff)), g3 = bf2f((unsigned short)(gt.y >> 16));
                    v2u w; w.x = pk2(acc[et][0] * rs * gn.x * siluf_(g0), acc[et][1] * rs * gn.y * siluf_(g1)); w.y = pk2(acc[et][2] * rs * gn.z * siluf_(g2), acc[et][3] * rs * gn.w * siluf_(g3));
                    *(v2u*)(Y + (size_t)row * D + (mixer ? 768 : 256) + h * 64 + e0) = w; }
            }
        }
        __syncthreads();
    }
}
__device__ __forceinline__ void ph_scan_state(unsigned char* ws, int tid, int bid, int G) {
    float* KV = (float*)(ws + WS_KV); const float* DEC = (const float*)(ws + WS_DEC);
    for (int gid = bid * NTHREADS + tid; gid < NCHAIN * 2048; gid += G * NTHREADS) {
        const int chain = gid >> 11, idx = gid & 2047, d = idx & 31, dir = (chain / (NB * 4)) & 1;
        float* kv = KV + (size_t)chain * NSLOT * 2048 + idx; const float* dc = DEC + (size_t)chain * NSLOT * 32 + d;
        float S = 0.f;
#pragma unroll 4
        for (int i = 0; i < NSLOT; ++i) {
            const int slot = dir == 0 ? i : (i < 4 ? 3 - i : NSLOT + 3 - i);
            const float kvv = kv[(size_t)slot * 2048], dv = dc[slot * 32];
            kv[(size_t)slot * 2048] = S; S = dv * S + kvv;
        }
    }
}
__device__ __forceinline__ void ph_rope_table(unsigned char* ws, int tid, int bid, int G) {
    typedef float f32x2_t __attribute__((ext_vector_type(2)));
    f32x2_t* ROPE = (f32x2_t*)(ws + WS_ROPE);
    for (int i = bid * NTHREADS + tid; i < SEQ * 16; i += G * NTHREADS) { const int t = i >> 4, k = i & 15;
        const float inv = exp2f(-(float)(k & 7) * (13.287712379549449f / 8.0f)); const float ang = (float)(k < 8 ? t / GRIDW : t % GRIDW) * inv;
        float s, c; sincosf(ang, &s, &c); ROPE[i] = (f32x2_t){c, s}; }
}
__global__ void __launch_bounds__(NTHREADS, 2) mk(Args a) {
    extern __shared__ __attribute__((aligned(16))) unsigned char lds_raw[];
    LAS unsigned char* lds = (LAS unsigned char*)lds_raw;
    cg::grid_group grid = cg::this_grid();
    volatile LAS unsigned* MISC = (volatile LAS unsigned*)(lds + RING_BYTES + 64);
    if (threadIdx.x < 16) MISC[threadIdx.x] = 0u;
    __syncthreads();
    XcdBarrier xbar = xcd_barrier_post((unsigned*)(a.ws + WS_CTL), MISC + 8);
    int tid = threadIdx.x, lane = tid & 63, wave = __builtin_amdgcn_readfirstlane(tid >> 6);
    const int bid = blockIdx.x, G = gridDim.x, NGW = G * NWAVES; int gw = bid * NWAVES + wave;
#define FRESH() do { tid = threadIdx.x; asm volatile("" : "+v"(tid)); lane = tid & 63; wave = __builtin_amdgcn_readfirstlane(tid >> 6); gw = bid * NWAVES + wave; } while (0)
    unsigned char* ws = a.ws;
    float* XC = (float*)(ws + WS_XC);
    bf16* ACT = (bf16*)(ws + WS_ACT); bf16* P = (bf16*)(ws + WS_P); bf16* H = (bf16*)(ws + WS_H);
#define GSYNC() do { xcd_barrier(xbar); FRESH(); } while (0)
    ph_rope_table(ws, tid, bid, G); ph_prologue(a, lds, tid, lane, wave, bid, G);
    grid.sync(); FRESH();
    for (int l = 0; l < DEPTH; ++l) {
        const bool need_ctx = l < DEPTH - 1; const int nro = need_ctx ? M : ML;
        const float* mod = (const float*)(ws + WS_MOD) + (size_t)l * NS * NMOD;
        const float* xl = l == 0 ? a.in[0] : a.out; const float* xc = l == 0 ? a.in[2] : (const float*)(ws + WS_XC);
        ph_normmod(xl, xc, a.in[6] + l * D, mod, 0, 1, ACT, M, lane, gw, NGW);
        GSYNC();
        { pg8::Gemm g{ACT, (const bf16*)(ws + WS_WIN + l * WIN_BYTES), M, PP, D}; pg8::StaticOrder S; S.init(M, PP, G, bid);
          pg8::EpiStore<0> E{P, PP}; pg8::gemm_phase<pg8::EpiStore<0>, pg8::StaticOrder, true, true>(lds, g, S, E, tid); }
        GSYNC();
        ph_conv(P, a.in[9] + l * 31 * 256, a.in[10] + l * 256, a.in[11] + l * 256, a.in[12] + l * 256, (const bf16*)(ws + WS_WPW + l * WPW_BYTES), a.in[14] + l * 256, ACT, nro, lds, tid, lane, wave, bid, G);
        __syncthreads(); FRESH();
        ph_attprep(P, a.in[20] + l * 64, a.in[21] + l * 64, (bf16*)(ws + WS_QA), (bf16*)(ws + WS_KA), (bf16*)(ws + WS_VA), lane, gw, NGW);
        FRESH();
        scan_units<1>(a, l, need_ctx, lds, tid, lane, wave, bid, G);
        GSYNC();
        ph_scan_state(ws, tid, bid, G);
        FRESH();
        ph_attention((const bf16*)(ws + WS_QA), (const bf16*)(ws + WS_KA), (const bf16*)(ws + WS_VA), ACT, need_ctx, (char*)lds_raw, bid, G, tid);
        GSYNC();
        scan_units<3>(a, l, need_ctx, lds, tid, lane, wave, bid, G);
        GSYNC();
        { pg8::Gemm g{ACT, (const bf16*)(ws + WS_WOUT + l * WOUT_BYTES), nro, D, D}; pg8::StaticOrder S; S.init(nro, D, G, bid);
          pg8::EpiResid E{xl, xc, a.out, XC, mod + 2 * D}; pg8::gemm_phase<pg8::EpiResid, pg8::StaticOrder, true, true>(lds, g, S, E, tid); }
        GSYNC();
        ph_normmod(a.out, XC, a.in[7] + l * D, mod, 3, 4, ACT, nro, lane, gw, NGW);
        GSYNC();
        { pg8::Gemm g{ACT, (const bf16*)(ws + WS_WUP + l * WUP_BYTES), nro, DFF, D}; pg8::StaticOrder S; S.init(nro, DFF, G, bid);
          pg8::EpiStore<2> E{H, DFF}; pg8::gemm_phase<pg8::EpiStore<2>, pg8::StaticOrder, true, true>(lds, g, S, E, tid); }
        GSYNC();
        { pg8::Gemm g{H, (const bf16*)(ws + WS_WDN + l * WDN_BYTES), nro, D, DFF}; pg8::StaticOrder S; S.init(nro, D, G, bid);
          pg8::EpiResid E{a.out, XC, a.out, XC, mod + 5 * D}; pg8::gemm_phase<pg8::EpiResid, pg8::StaticOrder, true, true>(lds, g, S, E, tid); }
        GSYNC();
    }
    ph_final(a.out, a.in[26], lane, gw, NGW);
}
extern "C" void kernel_launch(void* const* d_in, const int* in_sizes, int n_in, void* d_out, int out_size, void* d_ws, size_t ws_size, hipStream_t stream) {
    static int grid = 0;
    if (grid == 0) {
        if (n_in != 27 || in_sizes[0] != ML * D || out_size != ML * D || ws_size < WS_END) { fprintf(stderr, "kernel_launch: unexpected shapes / workspace (n_in %d, ws %zu)\n", n_in, ws_size); grid = -1; return; }
        int dev = 0, cus = 0, per_cu = 0;
        if (hipGetDevice(&dev) != hipSuccess || hipDeviceGetAttribute(&cus, hipDeviceAttributeMultiprocessorCount, dev) != hipSuccess) { grid = -1; return; }
        if (hipFuncSetAttribute((const void*)mk, hipFuncAttributeMaxDynamicSharedMemorySize, LDS_BYTES) != hipSuccess) { fprintf(stderr, "kernel_launch: hipFuncSetAttribute failed\n"); grid = -1; return; }
        if (hipOccupancyMaxActiveBlocksPerMultiprocessor(&per_cu, (const void*)mk, NTHREADS, LDS_BYTES) != hipSuccess || per_cu < 1) { fprintf(stderr, "kernel_launch: occupancy query says %d blocks per CU\n", per_cu); (void)hipGetLastError(); per_cu = 1; }
        grid = cus * (per_cu > 1 ? 1 : per_cu);
    }
    if (grid < 0) return;
    Args a{};
    for (int i = 0; i < 27; ++i) a.in[i] = (const float*)d_in[i];
    a.out = (float*)d_out; a.ws = (unsigned char*)d_ws;
    if (hipMemsetAsync((char*)d_ws + WS_CTL, 0, 16384, stream) != hipSuccess) { fprintf(stderr, "kernel_launch: memset failed\n"); return; }
    void* args[] = {&a};
    hipError_t e = hipLaunchCooperativeKernel((const void*)mk, dim3(grid), dim3(NTHREADS), args, LDS_BYTES, stream);
    if (e != hipSuccess) fprintf(stderr, "kernel_launch: cooperative launch failed: %s (grid %d)\n", hipGetErrorString(e), grid);
}
```

```cpp
#include <hip/hip_runtime.h>
#include <hip/hip_cooperative_groups.h>
#include <cstdio>
#include <cstdint>
namespace cg = cooperative_groups;
#ifndef REP_PRO
#define REP_PRO 1
#endif
#ifndef REP_NORM
#define REP_NORM 1
#endif
#ifndef REP_INPROJ
#define REP_INPROJ 1
#endif
#ifndef REP_B1
#define REP_B1 1
#endif
#ifndef REP_ATT
#define REP_ATT 1
#endif
#ifndef REP_B3
#define REP_B3 1
#endif
#ifndef REP_WOUT
#define REP_WOUT 1
#endif
#ifndef REP_UP
#define REP_UP 1
#endif
#ifndef REP_DOWN
#define REP_DOWN 1
#endif
#define REPEAT(n) _Pragma("nounroll") for (int rep_ = 0, nrep_ = opaque_int(n); rep_ < nrep_; ++rep_)
__device__ __forceinline__ int opaque_int(int v) { asm volatile("" : "+s"(v)); return v; }

constexpr int D = 1024, NB = 4, SEQ = 4096, CTX = 256, DFF = 4096, DEPTH = 2, GRIDW = 64;
constexpr int ML = NB * SEQ, MC = NB * CTX, M = ML + MC, NS = NB + 1, NMOD = 6 * D;
constexpr int PIN = 2576;
constexpr int PP = 2816;
constexpr int OFF_CA = 0, OFF_CG = 256, OFF_GQ = 512, OFF_GK = 640, OFF_GV = 768, OFF_GR = 1024, OFF_AQ = 1280, OFF_AK = 1536, OFF_AV = 1664,
              OFF_RQ = 1792, OFF_RK = 1920, OFF_RV = 2048, OFF_RG = 2304, OFF_Z = 2560;
constexpr float EPS = 1e-6f;
constexpr int KEYS = CTX + SEQ;
namespace pg8 {
#define PG8_LAS __attribute__((address_space(3)))
typedef unsigned short bf16_t;
typedef short bf16x8 __attribute__((ext_vector_type(8)));
typedef float f32x4 __attribute__((ext_vector_type(4)));
typedef unsigned u32x4 __attribute__((ext_vector_type(4)));
constexpr int BM = 256, BK = 64, HALF = 128, HTB = HALF * BK * 2  , STAGE_BYTES = 8 * HTB, NXCD = 8, WGM = 8;

__host__ __device__ __forceinline__ int lds_byte(int r, int c) { const int st = (r >> 4) * 2 + (c >> 5), rr = r & 15, cc = c & 31, ob = rr * 64 + cc * 2; return st * 1024 + (ob ^ (((ob >> 9) & 1) << 5)); }
__host__ __device__ __forceinline__ void stage_rc(int b, int& R, int& C) { const int st = b / 1024, sb = b % 1024, swz = sb ^ (((sb >> 9) & 1) << 5); R = (st >> 1) * 16 + swz / 64; C = (st & 1) * 32 + (swz % 64) / 2; }
__host__ __device__ __forceinline__ int perm32(int rho) { const int n = rho >> 4, i = rho & 15; return 8 * (i >> 2) + 4 * n + (i & 3); }

struct Unit { int pm, pn; };
struct Gemm { const bf16_t* A; const bf16_t* Bt; int M, N, K; };

struct StaticOrder {
    int nM, nN, nwg, G, c;
    __host__ __device__ void init(int M, int N, int G_, int c_) { nM = M / BM; nN = N / BM; nwg = nM * nN; G = G_; c = c_; }
    __host__ __device__ bool next(int i, Unit& u) const {
        const long L = (long)i * G + c; if (L >= nwg) return false;
        int wgid = (int)L; { const int q = nwg / NXCD, r = nwg % NXCD, xcd = wgid % NXCD, off = wgid / NXCD; wgid = (xcd < r ? xcd * (q + 1) : r * (q + 1) + (xcd - r) * q) + off; }
        const int nig = WGM * nN, gid = wgid / nig, fm = gid * WGM, gsz = (nM - fm) < WGM ? (nM - fm) : WGM;
        u.pm = fm + ((wgid % nig) % gsz); u.pn = (wgid % nig) / gsz; return true;
    }
    __device__ __forceinline__ void a_ready(const Unit&) const {}
    __device__ __forceinline__ void done(const Unit&) const {}
};

__device__ __forceinline__ unsigned cvt_pk_bf16(float lo, float hi) { unsigned r; asm volatile("v_cvt_pk_bf16_f32 %0, %1, %2" : "=v"(r) : "v"(lo), "v"(hi)); return r; }
typedef float f32x2 __attribute__((ext_vector_type(2)));
__device__ __forceinline__ f32x2 gelu_pk(f32x2 v) {
    const f32x2 av = __builtin_elementwise_abs(v), d = av * 0.2316418882f + 1.0f;
    f32x2 t; t.x = __builtin_amdgcn_rcpf(d.x); t.y = __builtin_amdgcn_rcpf(d.y);
    f32x2 q = t * 0.5307027145f + (-0.7265760135f); q = q * t + 0.7107068705f; q = q * t + (-0.142248368f); q = q * t + 0.127414796f; q = q * t;
    const f32x2 s = (v * v) * (-0.72134752044f);
    f32x2 e; e.x = __builtin_amdgcn_exp2f(s.x); e.y = __builtin_amdgcn_exp2f(s.y);
    const f32x2 m = v * (q * e), r = v - m;
    f32x2 o; o.x = v.x < 0.f ? m.x : r.x; o.y = v.y < 0.f ? m.y : r.y; return o;
}

template <int ACT  > struct EpiBf16 {
    static constexpr bool PERM = true, AFTER_DRAIN = false; static_assert(ACT == 0 || ACT == 1, "EpiBf16: ACT is 0 (none) or 1 (gelu_pk)");
    bf16_t* O; int ldc; const float* bias; int split_cols; size_t split_stride; float scale0;
    __device__ __forceinline__ void operator()(const f32x4 (&acc)[2][2][4][2], const Unit& u, int wr, int wc, int fr, int fq) const {
        const int row0 = u.pm * BM + wr * 64 + fr; int colt = u.pn * BM; bf16_t* base = O;
        float sc = 1.f; if (split_cols) { const int t = colt / split_cols; base += (size_t)t * split_stride; colt -= t * split_cols; if (t == 0) sc = scale0; }
        const int col0 = colt + wc * 32 + 8 * fq, bcol0 = u.pn * BM + wc * 32 + 8 * fq;
        f32x4 bv[2][2];
#pragma unroll
        for (int bj = 0; bj < 2; ++bj)
#pragma unroll
            for (int n = 0; n < 2; ++n) bv[bj][n] = bias ? *(const f32x4*)(bias + bcol0 + bj * HALF + 4 * n) : (f32x4){0.f, 0.f, 0.f, 0.f};
#pragma unroll
        for (int ai = 0; ai < 2; ++ai)
#pragma unroll
            for (int m = 0; m < 4; ++m) { bf16_t* rowp = base + (size_t)(row0 + ai * HALF + m * 16) * ldc + col0;
#pragma unroll
                for (int bj = 0; bj < 2; ++bj) { f32x4 v0 = acc[ai][bj][m][0] + bv[bj][0], v1 = acc[ai][bj][m][1] + bv[bj][1];
                    if (ACT == 1) { f32x2 a = gelu_pk((f32x2){v0[0], v0[1]}), b = gelu_pk((f32x2){v0[2], v0[3]}), c = gelu_pk((f32x2){v1[0], v1[1]}), d = gelu_pk((f32x2){v1[2], v1[3]});
                        v0 = (f32x4){a.x, a.y, b.x, b.y}; v1 = (f32x4){c.x, c.y, d.x, d.y}; }
                    v0 = v0 * sc; v1 = v1 * sc; u32x4 w; w.x = cvt_pk_bf16(v0[0], v0[1]); w.y = cvt_pk_bf16(v0[2], v0[3]); w.z = cvt_pk_bf16(v1[0], v1[1]); w.w = cvt_pk_bf16(v1[2], v1[3]);
                    *(u32x4*)(rowp + bj * HALF) = w; } }
    }
};

template <int ACT> struct EpiStore {
    static constexpr bool PERM = true, AFTER_DRAIN = false;
    bf16_t* O; int ldc;
    __device__ __forceinline__ void operator()(const f32x4 (&acc)[2][2][4][2], const Unit& u, int wr, int wc, int fr, int fq) const {
        const int row0 = u.pm * BM + wr * 64 + fr, col0 = u.pn * BM + wc * 32 + 8 * fq;
#pragma unroll
        for (int ai = 0; ai < 2; ++ai)
#pragma unroll
            for (int m = 0; m < 4; ++m) { bf16_t* rowp = O + (size_t)(row0 + ai * HALF + m * 16) * ldc + col0;
#pragma unroll
                for (int bj = 0; bj < 2; ++bj) { f32x4 v0 = acc[ai][bj][m][0], v1 = acc[ai][bj][m][1];
                    if (ACT == 2) {
#pragma unroll
                        for (int e = 0; e < 4; ++e) { const float a = v0[e] > 0.f ? v0[e] : 0.f, b = v1[e] > 0.f ? v1[e] : 0.f; v0[e] = a * a; v1[e] = b * b; } }
                    u32x4 w; w.x = cvt_pk_bf16(v0[0], v0[1]); w.y = cvt_pk_bf16(v0[2], v0[3]); w.z = cvt_pk_bf16(v1[0], v1[1]); w.w = cvt_pk_bf16(v1[2], v1[3]);
                    *(u32x4*)(rowp + bj * HALF) = w; } }
    }
};
struct EpiResid {
    static constexpr bool PERM = false, AFTER_DRAIN = false;
    const float* xin_l; const float* xin_c; float* xout_l; float* xout_c; const float* gate;
    int dry;
    __device__ __forceinline__ void operator()(const f32x4 (&acc)[2][2][4][2], const Unit& u, int wr, int wc, int fr, int fq) const {
        const int r0 = u.pm * BM; const bool lat = r0 < ML; const int slot = lat ? r0 / SEQ : NB;
        const float* xin = lat ? xin_l + (size_t)r0 * D : xin_c + (size_t)(r0 - ML) * D;
        float* xout = lat ? xout_l + (size_t)r0 * D : xout_c + (size_t)(r0 - ML) * D;
        const int col0 = wc * 32 + 4 * fq;
        const float* gp = gate + (size_t)slot * NMOD + u.pn * BM;
        xin += u.pn * BM; xout += u.pn * BM;
#pragma unroll
        for (int ai = 0; ai < 2; ++ai)
#pragma unroll
            for (int m = 0; m < 4; ++m) { const int off = (ai * HALF + wr * 64 + m * 16 + fr) * D + col0;
#pragma unroll
                for (int bj = 0; bj < 2; ++bj)
#pragma unroll
                    for (int n = 0; n < 2; ++n) { const f32x4 xi = *(const f32x4*)(xin + off + bj * HALF + n * 16); const f32x4 gv = *(const f32x4*)(gp + col0 + bj * HALF + n * 16);
                        if (!dry) *(f32x4*)(xout + off + bj * HALF + n * 16) = xi + gv * acc[ai][bj][m][n]; }
                asm volatile("" ::: "memory"); }
    }
};

template <class Epi, class Sched, bool ALIGN_EPI = false, bool SP2 = false>
__device__ __forceinline__ void gemm_phase(PG8_LAS unsigned char* lds, const Gemm g, const Sched& S, const Epi& E, const int tid) {
    const int wid = __builtin_amdgcn_readfirstlane(tid >> 6), lane = tid & 63, wr = wid >> 2, wc = wid & 3, fr = lane & 15, fq = lane >> 4;
    const int K = g.K, nt = K / BK;
    unsigned voffA[2], voffB[2];
#pragma unroll
    for (int i = 0; i < 2; ++i) { int R, C; stage_rc(tid * 16 + i * 8192, R, C); const int Rb = Epi::PERM ? ((R & ~31) + perm32(R & 31)) : R;
        voffA[i] = (unsigned)(R * K + C) * 2u; voffB[i] = (unsigned)(Rb * K + C) * 2u; }
    const size_t kstep = (size_t)(BK * 2);
    const size_t hstep = (size_t)HALF * K * 2;
    const size_t tstep = 2 * hstep;
    const unsigned ldsw = (unsigned)wid * 1024u;
    const int aoff = lds_byte(wr * 64 + fr, fq * 8), boff = lds_byte(wc * 32 + fr, fq * 8);
#define PG8_SA(b, h) (((b) * 2 + (h)) * HTB)
#define PG8_SB(b, h) ((4 + (b) * 2 + (h)) * HTB)
#define PG8_STAGE(bufoff, gbase, voff) do { _Pragma("unroll") for (int _i = 0; _i < 2; ++_i) \
        __builtin_amdgcn_global_load_lds((const unsigned*)((const char*)(gbase) + (voff)[_i]), (PG8_LAS unsigned*)(lds + (bufoff) + ldsw + _i * 8192), 16, 0, 0); } while (0)
#define PG8_LDA(dst, b, h) do { _Pragma("unroll") for (int m = 0; m < 4; ++m) _Pragma("unroll") for (int k = 0; k < 2; ++k) dst[m][k] = *(const PG8_LAS bf16x8*)(lds + PG8_SA(b, h) + aoff + m * 2048 + k * 1024); } while (0)
#define PG8_LDB(dst, b, h) do { _Pragma("unroll") for (int n = 0; n < 2; ++n) _Pragma("unroll") for (int k = 0; k < 2; ++k) dst[n][k] = *(const PG8_LAS bf16x8*)(lds + PG8_SB(b, h) + boff + n * 2048 + k * 1024); } while (0)
#define PG8_MMA(ai, bj, At, Bt) do { __builtin_amdgcn_s_setprio(1); _Pragma("unroll") for (int m = 0; m < 4; ++m) _Pragma("unroll") for (int n = 0; n < 2; ++n) _Pragma("unroll") for (int k = 0; k < 2; ++k) \
        acc[ai][bj][m][n] = __builtin_amdgcn_mfma_f32_16x16x32_bf16(Bt[n][k], At[m][k], acc[ai][bj][m][n], 0, 0, 0); __builtin_amdgcn_s_setprio(0); } while (0)
#define PG8_WAIT_V(n) asm volatile("s_waitcnt vmcnt(" #n ")" ::: "memory")
#define PG8_WAIT_L(n) asm volatile("s_waitcnt lgkmcnt(" #n ")" ::: "memory")
#define PG8_BAR __builtin_amdgcn_s_barrier()
#define PG8_SCHED __builtin_amdgcn_sched_barrier(0)
    Unit cur, nxt; int ui = 0;
    if (!S.next(0, cur)) return;
    f32x4 acc[2][2][4][2];
#pragma unroll
    for (int a = 0; a < 2; ++a)
#pragma unroll
        for (int b = 0; b < 2; ++b)
#pragma unroll
            for (int m = 0; m < 4; ++m)
#pragma unroll
                for (int n = 0; n < 2; ++n) acc[a][b][m][n] = (f32x4){0.f, 0.f, 0.f, 0.f};
    bf16x8 At[4][2], B0[2][2], B1[2][2];
    const char* cA = (const char*)g.A + (size_t)cur.pm * tstep; const char* cB = (const char*)g.Bt + (size_t)cur.pn * tstep;
    S.a_ready(cur);
    if constexpr (SP2) {
        PG8_STAGE(PG8_SB(0, 0), cB, voffB); PG8_STAGE(PG8_SB(0, 1), cB + hstep, voffB); PG8_STAGE(PG8_SA(0, 0), cA, voffA); PG8_STAGE(PG8_SA(0, 1), cA + hstep, voffA);
        if (wr == 1) PG8_BAR;
        PG8_WAIT_V(2); PG8_BAR;
        PG8_STAGE(PG8_SB(1, 0), cB + kstep, voffB); PG8_STAGE(PG8_SA(1, 0), cA + kstep, voffA); PG8_STAGE(PG8_SB(1, 1), cB + hstep + kstep, voffB);
        PG8_WAIT_V(6); PG8_BAR;
    } else {
        PG8_STAGE(PG8_SB(0, 0), cB, voffB); PG8_STAGE(PG8_SA(0, 0), cA, voffA); PG8_STAGE(PG8_SB(0, 1), cB + hstep, voffB); PG8_STAGE(PG8_SA(0, 1), cA + hstep, voffA);
        if (wr == 1) PG8_BAR;
        PG8_WAIT_V(4); PG8_BAR;
        PG8_STAGE(PG8_SB(1, 0), cB + kstep, voffB); PG8_STAGE(PG8_SA(1, 0), cA + kstep, voffA); PG8_STAGE(PG8_SB(1, 1), cB + hstep + kstep, voffB);
        PG8_WAIT_V(6); PG8_BAR;
    }
    for (;;) {
        const bool has_next = S.next(ui + 1, nxt);
        const char* nA = has_next ? (const char*)g.A + (size_t)nxt.pm * tstep : cA; const char* nB = has_next ? (const char*)g.Bt + (size_t)nxt.pn * tstep : cB;
        for (int t = 0; t < nt; t += 2) {
            const bool last = (t == nt - 2);
            const char* a1 = cA + (size_t)(t + 1) * kstep;
            const char* a2 = last ? nA : cA + (size_t)(t + 2) * kstep; const char* b2 = last ? nB : cB + (size_t)(t + 2) * kstep;
            const char* a3 = a2 + kstep; const char* b3 = b2 + kstep;
            if (last && has_next) S.a_ready(nxt);
            if constexpr (SP2) {
            PG8_LDB(B0, 0, 0); PG8_LDB(B1, 0, 1); PG8_SCHED; PG8_LDA(At, 0, 0); PG8_STAGE(PG8_SA(1, 1), a1 + hstep, voffA);
            PG8_WAIT_V(8); PG8_WAIT_L(0); PG8_BAR; PG8_MMA(0, 0, At, B0); PG8_MMA(0, 1, At, B1); PG8_BAR; PG8_SCHED;
            PG8_LDA(At, 0, 1); PG8_STAGE(PG8_SB(0, 0), b2, voffB); PG8_STAGE(PG8_SB(0, 1), b2 + hstep, voffB); PG8_STAGE(PG8_SA(0, 0), a2, voffA);
            PG8_WAIT_V(8); PG8_WAIT_L(0); PG8_BAR; PG8_MMA(1, 0, At, B0); PG8_MMA(1, 1, At, B1); PG8_BAR; PG8_SCHED;
            PG8_LDB(B0, 1, 0); PG8_LDB(B1, 1, 1); PG8_SCHED; PG8_LDA(At, 1, 0); PG8_STAGE(PG8_SA(0, 1), a2 + hstep, voffA);
            PG8_WAIT_V(8); PG8_WAIT_L(0); PG8_BAR; PG8_MMA(0, 0, At, B0); PG8_MMA(0, 1, At, B1); PG8_BAR; PG8_SCHED;
            PG8_LDA(At, 1, 1); PG8_STAGE(PG8_SB(1, 0), b3, voffB); PG8_STAGE(PG8_SB(1, 1), b3 + hstep, voffB); PG8_STAGE(PG8_SA(1, 0), a3, voffA);
            PG8_WAIT_V(8); PG8_WAIT_L(0); PG8_BAR; PG8_MMA(1, 0, At, B0); PG8_MMA(1, 1, At, B1); PG8_BAR; PG8_SCHED;
            } else {
            PG8_LDB(B0, 0, 0); PG8_SCHED; PG8_LDA(At, 0, 0); PG8_STAGE(PG8_SA(1, 1), a1 + hstep, voffA);
            PG8_WAIT_L(8); PG8_BAR; PG8_WAIT_L(0); PG8_MMA(0, 0, At, B0); PG8_BAR; PG8_SCHED;
            PG8_LDB(B1, 0, 1); PG8_STAGE(PG8_SB(0, 0), b2, voffB);
            PG8_BAR; PG8_WAIT_L(0); PG8_MMA(0, 1, At, B1); PG8_BAR;
            PG8_LDA(At, 0, 1); PG8_STAGE(PG8_SA(0, 0), a2, voffA);
            PG8_BAR; PG8_WAIT_L(0); PG8_MMA(1, 0, At, B0); PG8_BAR; PG8_SCHED;
            PG8_STAGE(PG8_SB(0, 1), b2 + hstep, voffB);
            PG8_WAIT_V(6); PG8_BAR; PG8_MMA(1, 1, At, B1); PG8_BAR;
            PG8_LDB(B0, 1, 0); PG8_SCHED; PG8_LDA(At, 1, 0); PG8_STAGE(PG8_SA(0, 1), a2 + hstep, voffA);
            PG8_WAIT_L(8); PG8_BAR; PG8_WAIT_L(0); PG8_MMA(0, 0, At, B0); PG8_BAR; PG8_SCHED;
            PG8_LDB(B1, 1, 1); PG8_STAGE(PG8_SB(1, 0), b3, voffB);
            PG8_BAR; PG8_WAIT_L(0); PG8_MMA(0, 1, At, B1); PG8_BAR;
            PG8_LDA(At, 1, 1); PG8_STAGE(PG8_SA(1, 0), a3, voffA);
            PG8_BAR; PG8_WAIT_L(0); PG8_MMA(1, 0, At, B0); PG8_BAR; PG8_SCHED;
            PG8_STAGE(PG8_SB(1, 1), b3 + hstep, voffB);
            PG8_WAIT_V(6); PG8_BAR; PG8_MMA(1, 1, At, B1); PG8_BAR;
            }
        }
        if constexpr (ALIGN_EPI) { if (wr == 0) PG8_BAR; }
        if constexpr (!Epi::AFTER_DRAIN) { E(acc, cur, wr, wc, fr, fq); S.done(cur); }
        if (!has_next) break;
#pragma unroll
        for (int a = 0; a < 2; ++a)
#pragma unroll
            for (int b = 0; b < 2; ++b)
#pragma unroll
                for (int m = 0; m < 4; ++m)
#pragma unroll
                    for (int n = 0; n < 2; ++n) acc[a][b][m][n] = (f32x4){0.f, 0.f, 0.f, 0.f};
        cur = nxt; cA = nA; cB = nB; ++ui;
        if constexpr (ALIGN_EPI) { if (wr == 1) PG8_BAR; }
    }
    PG8_WAIT_V(0);
    if constexpr (!ALIGN_EPI) { if (wr == 0) PG8_BAR; }
    PG8_BAR;
    if constexpr (Epi::AFTER_DRAIN) { E.fused(acc, cur, wr, wc, fr, fq, lds, wid, lane); S.done(cur); }
#undef PG8_SA
#undef PG8_SB
#undef PG8_STAGE
#undef PG8_LDA
#undef PG8_LDB
#undef PG8_MMA
#undef PG8_WAIT_V
#undef PG8_WAIT_L
#undef PG8_BAR
#undef PG8_SCHED
}
}
#include <hip/hip_bf16.h>
#include <cmath>
namespace attn_body {
using bf16=__hip_bfloat16;
using bf16x8=__attribute__((ext_vector_type(8)))short;
using s16x4=__attribute__((ext_vector_type(4)))short;
using f32x16=__attribute__((ext_vector_type(16)))float;
using u32x4=__attribute__((ext_vector_type(4)))unsigned;
constexpr int D=64;
constexpr int QP=256,KP=128,OP=1024;
constexpr int NW=8,QBLK=32,QB=QBLK*NW,KVBLK=64;
constexpr int ATTN_UNIT_ROWS=QB;
__device__ __forceinline__ int crow(int r,int hi){return (r&3)+8*(r>>2)+4*hi;}
#define SBAR() __builtin_amdgcn_sched_barrier(0)
__device__ __forceinline__ void cmask(f32x16&p0,f32x16&p1,int jb,int qrel,int hi){
  const float NEG=-INFINITY; int kb=64*jb+4*hi;
  #pragma unroll
  for(int r=0;r<16;++r){int kv=kb+(r&3)+8*(r>>2); if(kv>qrel)p0[r]=NEG; if(kv+32>qrel)p1[r]=NEG;}
}

constexpr int NSLOT=3, SLOTB=8192;
constexpr int LDS_K=0, LDS_V=NSLOT*SLOTB, LDS_WS=2*NSLOT*SLOTB, LDS_OST=LDS_WS+NW*64*4, LDS_BYTES=LDS_OST+NW*4096;
constexpr float C2=0.125f*1.4426950408889634f;
__device__ __forceinline__ void glds16(const void*gsrc,unsigned lds_dst){unsigned keep;
  asm volatile("s_mov_b32 %0, m0\n\ts_mov_b32 m0, %2\n\ts_nop 0\n\tglobal_load_lds_dwordx4 %1, off\n\ts_mov_b32 m0, %0":"=&s"(keep):"v"(gsrc),"s"(lds_dst):"memory");}
__device__ __forceinline__ float max3f(float a,float b,float c){float r;asm("v_max3_f32 %0, %1, %2, %3":"=v"(r):"v"(a),"v"(b),"v"(c));return r;}
__device__ __forceinline__ float max2f(float a,float b){float r;asm("v_max_f32_e32 %0, %1, %2":"=v"(r):"v"(a),"v"(b));return r;}
__device__ __forceinline__ float fadd_s(float a,float b){float r;asm("v_add_f32_e32 %0, %1, %2":"=v"(r):"v"(a),"v"(b));return r;}
__device__ __forceinline__ float fsub_s(float a,float b){float r;asm("v_sub_f32_e32 %0, %1, %2":"=v"(r):"v"(a),"v"(b));return r;}
typedef float f32x2_t __attribute__((ext_vector_type(2))); typedef __bf16 bf16x2_t __attribute__((ext_vector_type(2)));
__device__ __forceinline__ unsigned cvtpk_s(float lo,float hi){f32x2_t v={lo,hi};bf16x2_t b=__builtin_convertvector(v,bf16x2_t);return __builtin_bit_cast(unsigned,b);}
#define WAIT_BAR(N) asm volatile("s_waitcnt vmcnt(" #N ") lgkmcnt(0)\n\ts_barrier":::"memory")

__device__ __forceinline__ void qkt(f32x16&p0,f32x16&p1,const char*Kslot,const bf16x8*qr,const f32x16&negm,int r32,int hi){
  const char*kb=Kslot+hi*1024+r32*16;
  #pragma unroll
  for(int d0=0;d0<4;++d0){
    const bf16x8 b0=*reinterpret_cast<const bf16x8*>(kb+d0*2048);
    const bf16x8 b1=*reinterpret_cast<const bf16x8*>(kb+d0*2048+512);
    if(d0==0){p0=__builtin_amdgcn_mfma_f32_32x32x16_bf16(b0,qr[0],negm,0,0,0);p1=__builtin_amdgcn_mfma_f32_32x32x16_bf16(b1,qr[0],negm,0,0,0);}
    else{p0=__builtin_amdgcn_mfma_f32_32x32x16_bf16(b0,qr[d0],p0,0,0,0);p1=__builtin_amdgcn_mfma_f32_32x32x16_bf16(b1,qr[d0],p1,0,0,0);}}
}
typedef __attribute__((address_space(3))) const char* lds_cptr;
typedef short v4i16_t __attribute__((ext_vector_type(4)));
__device__ __forceinline__ void kload8(bf16x8*kf,lds_cptr kp){
  kf[0]=*(const __attribute__((address_space(3))) bf16x8*)(kp);      kf[1]=*(const __attribute__((address_space(3))) bf16x8*)(kp+512);
  kf[2]=*(const __attribute__((address_space(3))) bf16x8*)(kp+2048); kf[3]=*(const __attribute__((address_space(3))) bf16x8*)(kp+2560);
  kf[4]=*(const __attribute__((address_space(3))) bf16x8*)(kp+4096); kf[5]=*(const __attribute__((address_space(3))) bf16x8*)(kp+4608);
  kf[6]=*(const __attribute__((address_space(3))) bf16x8*)(kp+6144); kf[7]=*(const __attribute__((address_space(3))) bf16x8*)(kp+6656);
}
__device__ __forceinline__ void kload2(bf16x8*kf,lds_cptr kp,int j){ kf[2*j]=*(const __attribute__((address_space(3))) bf16x8*)(kp+j*2048); kf[2*j+1]=*(const __attribute__((address_space(3))) bf16x8*)(kp+j*2048+512); }
__device__ __forceinline__ s16x4 vtr(lds_cptr p){ return __builtin_bit_cast(s16x4,__builtin_amdgcn_ds_read_tr16_b64_v4i16((__attribute__((address_space(3))) v4i16_t*)p)); }
__device__ __forceinline__ float rowmax(const f32x16&p0,const f32x16&p1){
  float a=max3f(p0[0],p0[1],p1[0]),b=max3f(p0[2],p0[3],p1[1]);a=max3f(a,p1[2],p1[3]);
  #pragma unroll
  for(int r=4;r<16;r+=4){a=max3f(a,p0[r],p0[r+1]);b=max3f(b,p0[r+2],p0[r+3]);a=max3f(a,p1[r],p1[r+1]);b=max3f(b,p1[r+2],p1[r+3]);}
  const float m=max2f(a,b);
  auto rr=__builtin_amdgcn_permlane32_swap(__float_as_uint(m),__float_as_uint(m),false,false);
  return max2f(__uint_as_float(rr[0]),__uint_as_float(rr[1]));
}
__device__ __forceinline__ void pv(f32x16*o,int vb,bf16x8 pa0,bf16x8 pa1,bf16x8 pa2,bf16x8 pa3){
  #pragma unroll
  for(int d0=0;d0<2;++d0){s16x4 lo[4],hi[4];
    #pragma unroll
    for(int ks=0;ks<4;++ks){
      asm volatile("ds_read_b64_tr_b16 %0,%1 offset:%c2":"=&v"(lo[ks]):"v"(vb),"i"(d0*4096+ks*1024):"memory");
      asm volatile("ds_read_b64_tr_b16 %0,%1 offset:%c2":"=&v"(hi[ks]):"v"(vb),"i"(d0*4096+ks*1024+512):"memory");}
    asm volatile("s_waitcnt lgkmcnt(0)":::"memory");SBAR();
    #define PK(k) (bf16x8){lo[k][0],lo[k][1],lo[k][2],lo[k][3],hi[k][0],hi[k][1],hi[k][2],hi[k][3]}
    o[d0]=__builtin_amdgcn_mfma_f32_32x32x16_bf16(pa0,PK(0),o[d0],0,0,0);
    o[d0]=__builtin_amdgcn_mfma_f32_32x32x16_bf16(pa1,PK(1),o[d0],0,0,0);
    o[d0]=__builtin_amdgcn_mfma_f32_32x32x16_bf16(pa2,PK(2),o[d0],0,0,0);
    o[d0]=__builtin_amdgcn_mfma_f32_32x32x16_bf16(pa3,PK(3),o[d0],0,0,0);
    #undef PK
  }
}

#ifndef ATTN_STORE16
#define ATTN_STORE16(p,v) (*(u32x4*)(p)=(v))
#endif
template<int THRL> __device__ __forceinline__ void attn_unit(const bf16*Qu,const bf16*__restrict__ Kh,const bf16*__restrict__ Vh,bf16*Ou,const int NT,char*shm,const int tid){
  const int lane=tid&63,r32=lane&31,hi=lane>>5; const int wid=__builtin_amdgcn_readfirstlane(tid>>6);
  const bf16*Qw=Qu+(long)(wid*QBLK)*QP;
  const unsigned lds0=(unsigned)(uintptr_t)shm;
  float*wsf=(float*)(shm+LDS_WS)+wid*64;
  const bf16*ksrc=Kh+(long)lane*KP+wid*8;
  const bf16*vsrc=Vh+(long)(16*(wid&3)+(lane>>2))*KP+(wid>>2)*32+(lane&3)*8;
  const unsigned kdst=lds0+LDS_K+wid*1024, vdst=lds0+LDS_V+wid*1024;
  #define DMA_K(t,slot) glds16(ksrc+(long)(t)*KVBLK*KP,(unsigned)__builtin_amdgcn_readfirstlane(kdst+(slot)))
  #define DMA_V(t,slot) glds16(vsrc+(long)(t)*KVBLK*KP,(unsigned)__builtin_amdgcn_readfirstlane(vdst+(slot)))
  const int vb0=(int)(lds0+LDS_V)+((lane>>4)&1)*32+(lane&3)*8+(4*hi+((lane&15)>>2))*64;
  const char*Kbase=shm+LDS_K; bf16x8 kf[8];
  const lds_cptr shm3=(lds_cptr)shm; const lds_cptr kp0=shm3+LDS_K+hi*1024+r32*16; const lds_cptr vp0=shm3+LDS_V+((lane>>4)&1)*32+(lane&3)*8+(4*hi+((lane&15)>>2))*64;
  DMA_K(0,0);DMA_V(0,0);DMA_K(1,SLOTB);
  bf16x8 qr[4];
  #pragma unroll
  for(int d0=0;d0<4;++d0)qr[d0]=*reinterpret_cast<const bf16x8*>(&Qw[(long)r32*QP+d0*16+hi*8]);
  float mhat=0.f,l_reg=0.f;f32x16 o[2];o[0]=f32x16{};o[1]=f32x16{};f32x16 negm=f32x16{};asm volatile("":"+v"(negm));
  #define CMASK(P0,P1,t) do{}while(0)
  bool resc=false;
  #define START(P0,P1) do{ const float rm=rowmax(P0,P1); resc=false; \
    { const float dl=rm; mhat=fadd_s(mhat,dl); \
      _Pragma("unroll") for(int r=0;r<16;++r){P0[r]=fsub_s(P0[r],dl);P1[r]=fsub_s(P1[r],dl);} \
      _Pragma("unroll") for(int r=0;r<16;++r)negm[r]=-mhat; asm volatile("":"+v"(negm)); } \
    _Pragma("unroll") for(int r=0;r<16;++r)P0[r]=__builtin_amdgcn_exp2f(P0[r]); }while(0)
  #define RESC() do{ if(resc){ asm volatile("s_waitcnt lgkmcnt(0)":::"memory"); \
      _Pragma("unroll") for(int d_=0;d_<2;++d_) _Pragma("unroll") for(int r=0;r<16;++r)o[d_][r]*=wsf[crow(r,hi)]; } }while(0)
  f32x16 pA0,pA1,pB0,pB1;
  int sl_prev=0,sl_cur=0,sl_next=SLOTB;
  #define ROT() do{sl_prev=sl_cur;sl_cur=sl_next;sl_next=(sl_next==(NSLOT-1)*SLOTB)?0:sl_next+SLOTB;}while(0)
  DMA_K(2,2*SLOTB);
  WAIT_BAR(3);
  qkt(pA0,pA1,Kbase,qr,negm,r32,hi);asm volatile("s_nop 15\n\ts_nop 7":"+v"(pA0),"+v"(pA1));CMASK(pA0,pA1,0);
  START(pA0,pA1);
  _Pragma("unroll") for(int r=0;r<16;++r)pA1[r]=__builtin_amdgcn_exp2f(pA1[r]);
  WAIT_BAR(0);
  DMA_K(3,0);DMA_V(1,SLOTB);
  ROT();
  kload8(kf,kp0+sl_cur);
  WAIT_BAR(2);
  s16x4 vlo[8],vhi[8]; u32x4 pw0,pw1,pw2,pw3;
  #define PKW(P,B) cvtpk_s(P[B],P[B+1])
  #define PAF(k) __builtin_bit_cast(bf16x8,pw##k)
  #define VFR(i) (bf16x8){vlo[i][0],vlo[i][1],vlo[i][2],vlo[i][3],vhi[i][0],vhi[i][1],vhi[i][2],vhi[i][3]}
  #define PIN(x) asm volatile("":"+v"(x))
  #define MX3(a,b,c) __builtin_fmaxf(__builtin_fmaxf((a),(b)),(c))
  #define GAPA(MF,A0,A1,A2,A3,W0,W1,PW) do{ MF; sacc+=A0; sacc+=A1; sacc+=A2; sacc+=A3; PIN(sacc); W0; W1; PIN(PW); SBAR(); }while(0)
  #define EX(v) __builtin_amdgcn_exp2f(v)
  #define GAPB(MF,X,B) do{ MF; X[B]=EX(X[B]); X[B+1]=EX(X[B+1]); X[B+2]=EX(X[B+2]); X[B+3]=EX(X[B+3]); PIN(X); SBAR(); }while(0)
  #define VRD(i) do{ vlo[i]=vtr(vp_+(((i)>>2)*4096+((i)&3)*1024)); vhi[i]=vtr(vp_+(((i)>>2)*4096+((i)&3)*1024+512)); }while(0)
  #define KRD(G,j) do{ if(G){ kload2(kf,kp0+sl_next,j); SBAR(); } }while(0)
  #define STEP(C0,C1,P0,P1,t,GK,GV,GL) do{ SBAR(); \
    const lds_cptr vp_=vp0+sl_prev; \
    VRD(0); SBAR(); float sacc=(P0[0]+P0[1]); \
    GAPA(C0=__builtin_amdgcn_mfma_f32_32x32x16_bf16(kf[0],qr[0],negm,0,0,0), P0[2],P0[3],P0[4],P0[5],     pw0[0]=PKW(P0,0), pw0[1]=PKW(P0,2), pw0); \
    VRD(4); SBAR(); GAPA(C1=__builtin_amdgcn_mfma_f32_32x32x16_bf16(kf[1],qr[0],negm,0,0,0), P0[6],P0[7],P0[8],P0[9],     pw0[2]=PKW(P0,4), pw0[3]=PKW(P0,6), pw0); \
    VRD(1); SBAR(); GAPA(C0=__builtin_amdgcn_mfma_f32_32x32x16_bf16(kf[2],qr[1],C0,0,0,0),   P0[10],P0[11],P0[12],P0[13], pw1[0]=PKW(P0,8), pw1[1]=PKW(P0,10), pw1); \
    VRD(5); SBAR(); GAPA(C1=__builtin_amdgcn_mfma_f32_32x32x16_bf16(kf[3],qr[1],C1,0,0,0),   P0[14],P0[15],P1[0],P1[1],   pw1[2]=PKW(P0,12),pw1[3]=PKW(P0,14), pw1); \
    VRD(2); SBAR(); GAPA(C0=__builtin_amdgcn_mfma_f32_32x32x16_bf16(kf[4],qr[2],C0,0,0,0),   P1[2],P1[3],P1[4],P1[5],     pw2[0]=PKW(P1,0), pw2[1]=PKW(P1,2), pw2); \
    VRD(6); SBAR(); GAPA(C1=__builtin_amdgcn_mfma_f32_32x32x16_bf16(kf[5],qr[2],C1,0,0,0),   P1[6],P1[7],P1[8],P1[9],     pw2[2]=PKW(P1,4), pw2[3]=PKW(P1,6), pw2); \
    VRD(3); SBAR(); GAPA(C0=__builtin_amdgcn_mfma_f32_32x32x16_bf16(kf[6],qr[3],C0,0,0,0),   P1[10],P1[11],P1[12],P1[13], pw3[0]=PKW(P1,8), pw3[1]=PKW(P1,10), pw3); \
    VRD(7); SBAR(); GAPA(C1=__builtin_amdgcn_mfma_f32_32x32x16_bf16(kf[7],qr[3],C1,0,0,0),   P1[14],P1[15],0.f,0.f,       pw3[2]=PKW(P1,12),pw3[3]=PKW(P1,14), pw3); \
    l_reg+=sacc; \
    if(GK){DMA_K((t)+3,sl_cur);} if(GV){DMA_V((t)+1,sl_next);} \
    CMASK(C0,C1,t); \
    { float a=MX3(C0[0],C0[1],C1[0]),b=MX3(C0[2],C0[3],C1[1]); a=MX3(a,C1[2],C1[3]); \
      _Pragma("unroll") for(int r=4;r<16;r+=4){a=MX3(a,C0[r],C0[r+1]);b=MX3(b,C0[r+2],C0[r+3]);a=MX3(a,C1[r],C1[r+1]);b=MX3(b,C1[r+2],C1[r+3]);} \
      float rm=__builtin_fmaxf(a,b); { auto rr=__builtin_amdgcn_permlane32_swap(__float_as_uint(rm),__float_as_uint(rm),false,false); rm=__builtin_fmaxf(__uint_as_float(rr[0]),__uint_as_float(rr[1])); } \
      resc=false; \
      if(__builtin_expect(__any(rm>(float)THRL),0)){ const float dl=__builtin_fmaxf(rm,0.f); mhat+=dl; \
        _Pragma("unroll") for(int r=0;r<16;++r){C0[r]-=dl;C1[r]-=dl;} \
        _Pragma("unroll") for(int r=0;r<16;++r)negm[r]=-mhat; asm volatile("":"+v"(negm)); \
        const float f=__builtin_amdgcn_exp2f(-dl); l_reg*=f; if(hi==0)wsf[r32]=f; resc=true; } } \
    SBAR(); \
    GAPB(o[0]=__builtin_amdgcn_mfma_f32_32x32x16_bf16(PAF(0),VFR(0),o[0],0,0,0), C0,0); \
    GAPB(o[1]=__builtin_amdgcn_mfma_f32_32x32x16_bf16(PAF(0),VFR(4),o[1],0,0,0), C0,4); \
    KRD(GL,0); GAPB(o[0]=__builtin_amdgcn_mfma_f32_32x32x16_bf16(PAF(1),VFR(1),o[0],0,0,0), C0,8); \
    KRD(GL,1); GAPB(o[1]=__builtin_amdgcn_mfma_f32_32x32x16_bf16(PAF(1),VFR(5),o[1],0,0,0), C0,12); \
    KRD(GL,2); GAPB(o[0]=__builtin_amdgcn_mfma_f32_32x32x16_bf16(PAF(2),VFR(2),o[0],0,0,0), C1,0); \
    KRD(GL,3); GAPB(o[1]=__builtin_amdgcn_mfma_f32_32x32x16_bf16(PAF(2),VFR(6),o[1],0,0,0), C1,4); \
    GAPB(o[0]=__builtin_amdgcn_mfma_f32_32x32x16_bf16(PAF(3),VFR(3),o[0],0,0,0), C1,8); \
    GAPB(o[1]=__builtin_amdgcn_mfma_f32_32x32x16_bf16(PAF(3),VFR(7),o[1],0,0,0), C1,12); \
    }while(0)
  int t=1;
  for(;t+5<NT;t+=2){
    STEP(pB0,pB1,pA0,pA1,t,true,true,true);     WAIT_BAR(2); RESC(); ROT();
    STEP(pA0,pA1,pB0,pB1,t+1,true,true,true);   WAIT_BAR(2); RESC(); ROT();
  }
  #define ENDW(tt) do{ if((tt)+3<NT){WAIT_BAR(2);} else if((tt)+2<NT){WAIT_BAR(1);} else {WAIT_BAR(0);} }while(0)
  for(;t+1<NT;t+=2){
    STEP(pB0,pB1,pA0,pA1,t,(t+3<NT),(t+1<NT),(t+1<NT));       ENDW(t);   RESC(); ROT();
    STEP(pA0,pA1,pB0,pB1,t+1,(t+4<NT),(t+2<NT),(t+2<NT));     ENDW(t+1); RESC(); ROT();
  }
  STEP(pB0,pB1,pA0,pA1,NT-1,false,false,false); RESC();
  { float sacc=pB0[0]+pB0[1]; _Pragma("unroll") for(int r=2;r<16;++r)sacc+=pB0[r]; _Pragma("unroll") for(int r=0;r<16;++r)sacc+=pB1[r]; l_reg+=sacc;
    pw0=(u32x4){PKW(pB0,0),PKW(pB0,2),PKW(pB0,4),PKW(pB0,6)};pw1=(u32x4){PKW(pB0,8),PKW(pB0,10),PKW(pB0,12),PKW(pB0,14)};pw2=(u32x4){PKW(pB1,0),PKW(pB1,2),PKW(pB1,4),PKW(pB1,6)};pw3=(u32x4){PKW(pB1,8),PKW(pB1,10),PKW(pB1,12),PKW(pB1,14)};
    SBAR(); pv(o,vb0+sl_cur,PAF(0),PAF(1),PAF(2),PAF(3)); }
  #undef PKW
  #undef PAF
  #undef VFR
  #undef PIN
  #undef MX3
  #undef GAPA
  #undef GAPB
  #undef EX
  #undef VRD
  #undef KRD
  #undef STEP
  #undef ENDW
  {auto rr=__builtin_amdgcn_permlane32_swap(__float_as_uint(l_reg),__float_as_uint(l_reg),false,false);l_reg=__uint_as_float(rr[0])+__uint_as_float(rr[1]);}
  if(hi==0)wsf[32+r32]=l_reg;asm volatile("s_waitcnt lgkmcnt(0)":::"memory");
  float rli[16];
  #pragma unroll
  for(int r=0;r<16;++r)rli[r]=__builtin_amdgcn_rcpf(wsf[32+crow(r,hi)]);
  bf16*Ow=Ou+(long)(wid*QBLK)*OP;
  { bf16*stg=(bf16*)(shm+LDS_OST)+wid*2048;
    #pragma unroll
    for(int r=0;r<16;++r){const int orow=crow(r,hi);
      #pragma unroll
      for(int d0=0;d0<2;++d0)stg[orow*64+d0*32+r32]=__float2bfloat16(o[d0][r]*rli[r]);}
    asm volatile("s_waitcnt lgkmcnt(0)":::"memory");
    #pragma unroll
    for(int i=0;i<4;++i){const int row=i*8+(lane>>3),ch=lane&7; const u32x4 v=*(const u32x4*)(stg+row*64+ch*8); ATTN_STORE16(Ow+(long)row*OP+ch*8,v);} }
  asm volatile("s_waitcnt lgkmcnt(0)\n\ts_barrier":::"memory");
  #undef DMA_K
  #undef DMA_V
  #undef CMASK
  #undef START
  #undef RESC
  #undef ROT
}
constexpr int ATTN_LDS_BYTES=LDS_BYTES;
#undef SBAR
#undef WAIT_BAR
}
#define GAS __attribute__((address_space(1)))
#define LAS __attribute__((address_space(3)))
typedef unsigned short bf16;
typedef unsigned v4u __attribute__((ext_vector_type(4)));
typedef unsigned v2u __attribute__((ext_vector_type(2)));
typedef float f32x4 __attribute__((ext_vector_type(4)));
typedef short bf16x8 __attribute__((ext_vector_type(8)));
constexpr int NWAVES = 8, NTHREADS = 512;
constexpr int RING_BYTES = 131072, LDS_BYTES = 147456;
#define LDS_WAIT() asm volatile("s_waitcnt lgkmcnt(0)" ::: "memory")
#define VM_WAIT() asm volatile("s_waitcnt vmcnt(0)" ::: "memory")
__device__ __forceinline__ unsigned f2bf(float f) { unsigned u = __builtin_bit_cast(unsigned, f); return (u + 0x7fffu + ((u >> 16) & 1u)) >> 16; }
__device__ __forceinline__ unsigned pk2(float lo, float hi) { return f2bf(lo) | (f2bf(hi) << 16); }
__device__ __forceinline__ float bf2f(unsigned short b) { return __builtin_bit_cast(float, ((unsigned)b) << 16); }
__device__ __forceinline__ float sigmoidf_(float x) { return 1.0f / (1.0f + __expf(-x)); }
__device__ __forceinline__ float siluf_(float x) { return x * sigmoidf_(x); }
__device__ __forceinline__ float wave_sum(float v) {
#pragma unroll
    for (int o = 1; o < 64; o <<= 1) v += __shfl_xor(v, o);
    return v;
}

constexpr size_t MiB = 1u << 20;
constexpr size_t WS_CTL = 0, WS_MOD = 1 * MiB;
constexpr size_t WS_WIN = 2 * MiB, WIN_BYTES = (size_t)PP * D * 2;
constexpr size_t WS_WOUT = WS_WIN + 2 * WIN_BYTES, WOUT_BYTES = (size_t)D * D * 2;
constexpr size_t WS_WUP = WS_WOUT + 2 * WOUT_BYTES, WUP_BYTES = (size_t)DFF * D * 2;
constexpr size_t WS_WDN = WS_WUP + 2 * WUP_BYTES, WDN_BYTES = (size_t)D * DFF * 2;
constexpr size_t WS_WPW = WS_WDN + 2 * WDN_BYTES, WPW_BYTES = (size_t)256 * 256 * 2;
static_assert(WS_WPW + 2 * WPW_BYTES <= 50 * MiB, "weights");
constexpr size_t WS_XC = 50 * MiB;
constexpr size_t WS_ACT = 54 * MiB;
constexpr size_t WS_P = 88 * MiB;
constexpr size_t WS_H = 88 * MiB;
constexpr size_t WS_QA = 182 * MiB;
constexpr size_t WS_KA = 191 * MiB, WS_VA = 196 * MiB;
constexpr size_t WS_KV = 201 * MiB;
constexpr size_t WS_DEC = 235 * MiB;
constexpr size_t WS_END = 256 * MiB;
static_assert(WS_P + (size_t)M * PP * 2 <= WS_QA && WS_H + (size_t)M * DFF * 2 <= WS_END && WS_ACT + (size_t)M * D * 2 <= WS_P, "ws map");

struct Args { const float* in[27]; float* out; unsigned char* ws; int ph_lo, ph_hi, layer, pad; };

template <class Map> __device__ __forceinline__ void transpose_item(const float* W, int K, int N, bf16* WT, LAS float* scr, int kb, int nb, int lane, Map srcc) {
    const int k0 = 64 * kb, n0 = 32 * nb; const int sc = srcc(n0 + (lane & 31));
#pragma unroll 8
    for (int i = 0; i < 32; ++i) { const int kk = 2 * i + (lane >> 5); scr[kk * 33 + (lane & 31)] = sc >= 0 ? W[(size_t)(k0 + kk) * N + sc] : 0.f; }
    LDS_WAIT(); asm volatile("" ::: "memory");
    const int c = lane & 7;
#pragma unroll
    for (int j = 0; j < 4; ++j) { const int n = (lane >> 3) + 8 * j; const LAS float* s = scr + (8 * c) * 33 + n;
        v4u o; o.x = pk2(s[0 * 33], s[1 * 33]); o.y = pk2(s[2 * 33], s[3 * 33]); o.z = pk2(s[4 * 33], s[5 * 33]); o.w = pk2(s[6 * 33], s[7 * 33]);
        *(GAS v4u*)(WT + (size_t)(n0 + n) * K + k0 + 8 * c) = o; }
    LDS_WAIT(); asm volatile("" ::: "memory");
}
struct MapId { __device__ __forceinline__ int operator()(int n) const { return n; } };
struct MapWin { __device__ __forceinline__ int operator()(int n) const { return n < 1280 ? n : (n < 2560 ? n + 16 : (n < 2576 ? n - 1280 : -1)); } };

__device__ __forceinline__ void ph_prologue(const Args& a, LAS unsigned char* lds, int tid, int lane, int wave, int bid, int G) {
    unsigned char* ws = a.ws;
    LAS float* scr = (LAS float*)(lds + wave * 16384);
    const int gw = bid * NWAVES + wave, NGW = G * NWAVES;
    constexpr int I_IN = (D / 64) * (PP / 32), I_OUT = (D / 64) * (D / 32), I_UP = (D / 64) * (DFF / 32), I_DN = (DFF / 64) * (D / 32), I_PW = (256 / 64) * (256 / 32);
    constexpr int I_L = I_IN + I_OUT + I_UP + I_DN + I_PW;
    for (int it = gw; it < DEPTH * I_L; it += NGW) {
        const int l = it / I_L; int r = it % I_L;
        if (r < I_IN) { transpose_item(a.in[8] + (size_t)l * D * PIN, D, PIN, (bf16*)(ws + WS_WIN + l * WIN_BYTES), scr, r / (PP / 32), r % (PP / 32), lane, MapWin()); continue; } r -= I_IN;
        if (r < I_OUT) { transpose_item(a.in[23] + (size_t)l * D * D, D, D, (bf16*)(ws + WS_WOUT + l * WOUT_BYTES), scr, r / (D / 32), r % (D / 32), lane, MapId()); continue; } r -= I_OUT;
        if (r < I_UP) { transpose_item(a.in[24] + (size_t)l * D * DFF, D, DFF, (bf16*)(ws + WS_WUP + l * WUP_BYTES), scr, r / (DFF / 32), r % (DFF / 32), lane, MapId()); continue; } r -= I_UP;
        if (r < I_DN) { transpose_item(a.in[25] + (size_t)l * DFF * D, DFF, D, (bf16*)(ws + WS_WDN + l * WDN_BYTES), scr, r / (D / 32), r % (D / 32), lane, MapId()); continue; } r -= I_DN;
        transpose_item(a.in[13] + (size_t)l * 256 * 256, 256, 256, (bf16*)(ws + WS_WPW + l * WPW_BYTES), scr, r / 8, r % 8, lane, MapId());
    }
    __syncthreads();
    LAS float* sil = (LAS float*)lds;
    LAS float* part = (LAS float*)(lds + NS * D * 4);
    float* MOD = (float*)(ws + WS_MOD);
    const float* c = a.in[1]; const float* cc = a.in[3]; const float* w_mod = a.in[4]; const float* b_mod = a.in[5];
    bool staged = false;
    for (int task = bid; task < DEPTH * (NMOD / 64); task += G) {
        if (!staged) { for (int i = tid; i < NS * D; i += NTHREADS) { const int s = i / D, k = i % D; const float v = s < NB ? c[s * D + k] : cc[k]; sil[i] = siluf_(v); } staged = true; __syncthreads(); }
        const int l = task / (NMOD / 64), c0 = (task % (NMOD / 64)) * 64;
        float acc[NS];
#pragma unroll
        for (int s = 0; s < NS; ++s) acc[s] = 0.f;
        const float* wp = w_mod + (size_t)l * D * NMOD + (size_t)(wave * 128) * NMOD + c0 + lane;
#pragma unroll 4
        for (int k = 0; k < 128; ++k) { const float wv = wp[(size_t)k * NMOD];
#pragma unroll
            for (int s = 0; s < NS; ++s) acc[s] += sil[s * D + wave * 128 + k] * wv; }
#pragma unroll
        for (int s = 0; s < NS; ++s) part[(wave * NS + s) * 64 + lane] = acc[s];
        __syncthreads();
        if (tid < NS * 64) { const int s = tid / 64, ln = tid % 64; float v = 0.f;
#pragma unroll
            for (int w = 0; w < 8; ++w) v += part[(w * NS + s) * 64 + ln];
            MOD[((size_t)l * NS + s) * NMOD + c0 + ln] = v + b_mod[(size_t)l * NMOD + c0 + ln]; }
        __syncthreads();
    }
}
__device__ __forceinline__ void ph_normmod(const float* xl, const float* xc, const float* g, const float* mod, int i_shift, int i_scale, bf16* XN, int nrows, int lane, int gw, int NGW) {
    for (int r = gw; r < nrows; r += NGW) {
        const float* xr = r < ML ? xl + (size_t)r * D : xc + (size_t)(r - ML) * D;
        const float* m = mod + (size_t)(r < ML ? r / SEQ : NB) * NMOD;
        f32x4 v[4]; float s = 0.f;
#pragma unroll
        for (int j = 0; j < 4; ++j) { v[j] = *(const f32x4*)(xr + 4 * lane + 256 * j); s += (v[j].x * v[j].x + v[j].y * v[j].y) + (v[j].z * v[j].z + v[j].w * v[j].w); }
        const float rs = 1.0f / sqrtf(wave_sum(s) * (1.0f / D) + EPS);
#pragma unroll
        for (int j = 0; j < 4; ++j) { const int c0 = 4 * lane + 256 * j;
            const f32x4 gg = *(const f32x4*)(g + c0), sc = *(const f32x4*)(m + i_scale * D + c0), sh = *(const f32x4*)(m + i_shift * D + c0);
            const f32x4 o = v[j] * rs * gg * (sc + 1.0f) + sh;
            v2u w; w.x = pk2(o.x, o.y); w.y = pk2(o.z, o.w); *(v2u*)(XN + (size_t)r * D + c0) = w; }
    }
}
__device__ __forceinline__ void ph_final(float* x, const float* g, int lane, int gw, int NGW) {
    for (int r = gw; r < ML; r += NGW) {
        float* xr = x + (size_t)r * D;
        f32x4 v[4]; float s = 0.f;
#pragma unroll
        for (int j = 0; j < 4; ++j) { v[j] = *(const f32x4*)(xr + 4 * lane + 256 * j); s += (v[j].x * v[j].x + v[j].y * v[j].y) + (v[j].z * v[j].z + v[j].w * v[j].w); }
        const float rs = 1.0f / sqrtf(wave_sum(s) * (1.0f / D) + EPS);
#pragma unroll
        for (int j = 0; j < 4; ++j) { const int c0 = 4 * lane + 256 * j; *(f32x4*)(xr + c0) = v[j] * rs * *(const f32x4*)(g + c0); }
    }
}
#define RLX_AGENT __ATOMIC_RELAXED, __HIP_MEMORY_SCOPE_AGENT
#define XB_TMO      128
#define XB_XCNT(j)  (256  + 64 * (j))
#define XB_XSUB(j)  (1280 + 64 * (j))
#define XB_XGEN(j)  (2304 + 64 * (j))
#define XB_TOP      3328
#define XB_TOPGEN   3392
#define XCD_BAR_WORDS 3456
#define XB_SPIN_CAP (1u << 18)

__device__ __forceinline__ unsigned xb_ld(unsigned* p)              { return __hip_atomic_load(p, __ATOMIC_RELAXED, __HIP_MEMORY_SCOPE_AGENT); }
__device__ __forceinline__ unsigned xb_add(unsigned* p, unsigned v) { return __hip_atomic_fetch_add(p, v, __ATOMIC_RELAXED, __HIP_MEMORY_SCOPE_AGENT); }
__device__ __forceinline__ unsigned xb_xcc_id() { return (unsigned)__builtin_amdgcn_s_getreg((3 << 11) | 20) & 0xFu; }
#define XB_SPIN(cond, bar) do { unsigned _sp = 0; while (cond) { __builtin_amdgcn_s_sleep(1); \
    if ((++_sp & 255u) == 0u) { if (xb_ld(&(bar)[XB_TMO])) break; if (_sp > XB_SPIN_CAP) { atomicAdd(&(bar)[XB_TMO], 1u); break; } } } } while (0)

struct XcdBarrier {
    unsigned* bar; unsigned x;
    volatile LAS unsigned* st;
};

__device__ __forceinline__ XcdBarrier xcd_barrier_post(unsigned* bar, volatile LAS unsigned* st) {
    XcdBarrier b; b.bar = bar; b.x = xb_xcc_id(); b.st = st;
    if (threadIdx.x == 0) (void)xb_add(&bar[XB_XCNT(b.x)], 1u);
    return b;
}
__device__ __forceinline__ void xcd_barrier_complete(unsigned* bar, unsigned x, unsigned& nloc, unsigned& nx) {
    const unsigned G = gridDim.x * gridDim.y * gridDim.z;
    unsigned sum, cnt, mine, sp = 0u;
    for (;;) {
        sum = 0u; cnt = 0u; mine = 0u;
#pragma unroll
        for (unsigned j = 0; j < 16; ++j) { const unsigned c = xb_ld(&bar[XB_XCNT(j)]); sum += c; cnt += (c > 0u) ? 1u : 0u; mine = (j == x) ? c : mine; }
        if (sum == G) break;
        __builtin_amdgcn_s_sleep(1);
        if ((++sp & 255u) == 0u) { if (xb_ld(&bar[XB_TMO])) break; if (sp > XB_SPIN_CAP) { atomicAdd(&bar[XB_TMO], 1u); break; } }
    }
    nloc = mine > 0u ? mine : 1u; nx = cnt > 0u ? cnt : 1u;
}

__device__ __forceinline__ void xcd_barrier(const XcdBarrier& b) {
    asm volatile("s_waitcnt vmcnt(0)" ::: "memory");
    __syncthreads();
    if (threadIdx.x == 0) {
        unsigned* bar = b.bar;
        __builtin_amdgcn_s_waitcnt(0);
        unsigned nloc = b.st[0], nx = b.st[1];
        if (nloc == 0u) { xcd_barrier_complete(bar, b.x, nloc, nx); b.st[0] = nloc; b.st[1] = nx; }
        const unsigned old = xb_add(&bar[XB_XSUB(b.x)], 1u);
        const unsigned gen = old / nloc;
        if (old + 1u == (gen + 1u) * nloc) {
            __builtin_amdgcn_fence(__ATOMIC_RELEASE, "agent");
            asm volatile("s_waitcnt vmcnt(0)" ::: "memory");
            const unsigned og = xb_add(&bar[XB_TOP], 1u);
            const unsigned tg = og / nx;
            if (og + 1u == (tg + 1u) * nx) xb_add(&bar[XB_TOPGEN], 1u);
            else XB_SPIN(xb_ld(&bar[XB_TOPGEN]) == tg, bar);
            __builtin_amdgcn_fence(__ATOMIC_ACQUIRE, "agent");
            xb_add(&bar[XB_XGEN(b.x)], 1u);
            asm volatile("s_waitcnt vmcnt(0)" ::: "memory");
        } else {
            XB_SPIN(xb_ld(&bar[XB_XGEN(b.x)]) == gen, bar);
            __builtin_amdgcn_fence(__ATOMIC_ACQUIRE, "agent");
            asm volatile("s_waitcnt vmcnt(0)" ::: "memory");
        }
    }
    __syncthreads();
}
__device__ __forceinline__ void ph_attprep(const bf16* P, const float* qg, const float* kg, bf16* QA, bf16* KA, bf16* VA, int lane, int gw, int NGW) {
    const float gq = qg[lane], gk = kg[lane];
    const int kk = lane & 31; const float inv = exp2f(-(float)(kk & 15) * (13.287712379549449f / 16.0f));
    for (int r = gw; r < M; r += NGW) {
        const bool lat = r < ML; const int b = lat ? r / SEQ : (r - ML) / CTX, t = lat ? r % SEQ : (r - ML) % CTX;
        const bf16* pr = P + (size_t)r * PP;
        float cs = 1.f, sn = 0.f;
        if (lat) { const float ang = (float)(kk < 16 ? t / GRIDW : t % GRIDW) * inv; sincosf(ang, &sn, &cs); }
        const float sgn = lane < 32 ? -1.f : 1.f;
        const size_t krow = (size_t)b * KEYS + (lat ? CTX + t : t);
#pragma unroll
        for (int h = 0; h < 6; ++h) {
            const float x = bf2f(pr[(h < 4 ? OFF_AQ + h * 64 : OFF_AK + (h - 4) * 64) + lane]);
            const float rs = 1.0f / sqrtf(wave_sum(x * x) * (1.0f / 64) + EPS);
            const float v = x * rs * (h < 4 ? gq : gk);
            const float o = v * cs + sgn * __shfl_xor(v, 32) * sn;
            if (h < 4) QA[(size_t)r * 256 + h * 64 + lane] = (bf16)f2bf(o * (0.125f * 1.4426950408889634f));
            else KA[krow * 128 + (h - 4) * 64 + lane] = (bf16)f2bf(o);
        }
        VA[krow * 128 + lane] = pr[OFF_AV + lane]; VA[krow * 128 + 64 + lane] = pr[OFF_AV + 64 + lane];
    }
}
__device__ __forceinline__ void ph_attention(const bf16* QA, const bf16* KA, const bf16* VA, bf16* Y, bool need_ctx, char* lds, int bid, int G, int tid) {
    const int vcu = (G % 8 == 0) ? (bid % 8) * (G / 8) + bid / 8 : bid;
    const int NU = 256 + (need_ctx ? 16 : 0);
    for (int u = vcu; u < NU; u += G) {
        if (u < 256) { const int b = u >> 6, h = (u >> 4) & 3, qb = u & 15; const size_t row = (size_t)b * SEQ + qb * 256;
            attn_body::attn_unit<8>((const attn_body::bf16*)(QA + row * 256 + h * 64), (const attn_body::bf16*)(KA + (size_t)b * KEYS * 128 + (h >> 1) * 64), (const attn_body::bf16*)(VA + (size_t)b * KEYS * 128 + (h >> 1) * 64),
                                    (attn_body::bf16*)(Y + row * D + 512 + h * 64), KEYS / 64, lds, tid); }
        else { const int b = (u - 256) >> 2, h = (u - 256) & 3; const size_t row = (size_t)ML + b * CTX;
            attn_body::attn_unit<8>((const attn_body::bf16*)(QA + row * 256 + h * 64), (const attn_body::bf16*)(KA + (size_t)b * KEYS * 128 + (h >> 1) * 64), (const attn_body::bf16*)(VA + (size_t)b * KEYS * 128 + (h >> 1) * 64),
                                    (attn_body::bf16*)(Y + row * D + 512 + h * 64), CTX / 64, lds, tid); }
    }
}
__device__ __forceinline__ void ph_conv(const bf16* P, const float* w_dw, const float* b_dw, const float* ln_g, const float* ln_b, const bf16* PwT, const float* b_pw, bf16* Y, int nrows,
                                        LAS unsigned char* lds, int tid, int lane, int wave, int bid, int G) {
    typedef float f32x4_t __attribute__((ext_vector_type(4)));
    LAS float* U = (LAS float*)lds; LAS unsigned char* Zb = lds + 96256; constexpr int ZS = 528;
    const int nunits = nrows / 64;
    if (bid >= nunits) return;
    const int ch = tid & 255, half = tid >> 8;
    float wreg[31];
#pragma unroll
    for (int j = 0; j < 31; ++j) wreg[j] = w_dw[j * 256 + ch];
    const float bdw = b_dw[ch];
    const f32x4_t lg = *(const f32x4_t*)(ln_g + 4 * lane), lb = *(const f32x4_t*)(ln_b + 4 * lane);
    bf16x8 wf[2][8];
#pragma unroll
    for (int nt = 0; nt < 2; ++nt)
#pragma unroll
        for (int ks = 0; ks < 8; ++ks) wf[nt][ks] = *(const bf16x8*)(PwT + (size_t)(32 * wave + 16 * nt + (lane & 15)) * 256 + 32 * ks + 8 * (lane >> 4));
    const f32x4_t bp0 = *(const f32x4_t*)(b_pw + 32 * wave + 4 * (lane >> 4)), bp1 = *(const f32x4_t*)(b_pw + 32 * wave + 16 + 4 * (lane >> 4));
    for (int u = bid; u < nunits; u += G) {
        const int r0 = u * 64; int base, t0, T;
        if (r0 < ML) { base = (r0 / SEQ) * SEQ; t0 = r0 % SEQ; T = SEQ; } else { const int rc = r0 - ML; base = ML + (rc / CTX) * CTX; t0 = rc % CTX; T = CTX; }
        for (int i = tid >> 5; i < 94; i += 16) {
            const int tt = t0 - 15 + i, c8 = (tid & 31) * 8;
            f32x4_t o0 = {0.f, 0.f, 0.f, 0.f}, o1 = {0.f, 0.f, 0.f, 0.f};
            if (tt >= 0 && tt < T) {
                const bf16* pr = P + (size_t)(base + tt) * PP;
                const bf16x8 av = *(const bf16x8*)(pr + OFF_CA + c8), gv = *(const bf16x8*)(pr + OFF_CG + c8);
#pragma unroll
                for (int e = 0; e < 4; ++e) { o0[e] = bf2f((unsigned short)av[e]) * sigmoidf_(bf2f((unsigned short)gv[e])); o1[e] = bf2f((unsigned short)av[4 + e]) * sigmoidf_(bf2f((unsigned short)gv[4 + e])); }
            }
            *(LAS f32x4_t*)(U + i * 256 + c8) = o0; *(LAS f32x4_t*)(U + i * 256 + c8 + 4) = o1;
        }
        __syncthreads();
        float y[32];
        {
            float uu[62];
#pragma unroll
            for (int i = 0; i < 62; ++i) uu[i] = U[(32 * half + i) * 256 + ch];
#pragma unroll
            for (int t = 0; t < 32; ++t) { float acc = bdw;
#pragma unroll
                for (int j = 0; j < 31; ++j) acc += uu[t + j] * wreg[j];
                y[t] = acc; }
        }
        __syncthreads();
#pragma unroll
        for (int t = 0; t < 32; ++t) U[(32 * half + t) * 256 + ch] = y[t];
        __syncthreads();
#pragma unroll 2
        for (int q = 0; q < 8; ++q) { const int tok = 8 * wave + q;
            const f32x4_t v = *(LAS f32x4_t*)(U + tok * 256 + 4 * lane);
            const float mu = wave_sum((v.x + v.y) + (v.z + v.w)) * (1.0f / 256);
            const f32x4_t dv = v - mu;
            const float var = wave_sum((dv.x * dv.x + dv.y * dv.y) + (dv.z * dv.z + dv.w * dv.w)) * (1.0f / 256);
            const float rs = 1.0f / sqrtf(var + EPS);
            f32x4_t o = dv * rs * lg + lb;
#pragma unroll
            for (int e = 0; e < 4; ++e) o[e] = siluf_(o[e]);
            v2u w; w.x = pk2(o.x, o.y); w.y = pk2(o.z, o.w);
            *(LAS v2u*)(Zb + tok * ZS + 8 * lane) = w; }
        __syncthreads();
        f32x4_t acc[2][4];
#pragma unroll
        for (int nt = 0; nt < 2; ++nt)
#pragma unroll
            for (int tt = 0; tt < 4; ++tt) acc[nt][tt] = (f32x4_t){0.f, 0.f, 0.f, 0.f};
#pragma unroll
        for (int ks = 0; ks < 8; ++ks) {
            bf16x8 zf[4];
#pragma unroll
            for (int tt = 0; tt < 4; ++tt) zf[tt] = *(LAS bf16x8*)(Zb + (16 * tt + (lane & 15)) * ZS + 64 * ks + 16 * (lane >> 4));
#pragma unroll
            for (int nt = 0; nt < 2; ++nt)
#pragma unroll
                for (int tt = 0; tt < 4; ++tt) acc[nt][tt] = __builtin_amdgcn_mfma_f32_16x16x32_bf16(wf[nt][ks], zf[tt], acc[nt][tt], 0, 0, 0);
        }
#pragma unroll
        for (int tt = 0; tt < 4; ++tt) { bf16* yr = Y + (size_t)(r0 + 16 * tt + (lane & 15)) * D + 32 * wave + 4 * (lane >> 4);
            const f32x4_t a0 = acc[0][tt] + bp0, a1 = acc[1][tt] + bp1;
            v2u w0, w1; w0.x = pk2(a0.x, a0.y); w0.y = pk2(a0.z, a0.w); w1.x = pk2(a1.x, a1.y); w1.y = pk2(a1.z, a1.w);
            *(v2u*)yr = w0; *(v2u*)(yr + 16) = w1; }
        __syncthreads();
    }
}
constexpr int NSLOT = (CTX + SEQ) / 64, NCHAIN = 2 * 2 * NB * 4;
constexpr size_t WS_ROPE = 256 * 1024;
constexpr int SL_QD = 0, SL_KI = 10240, SL_SC = 20480, SL_VT = 38912, SL_ST = 48128, SL_TOT = 58368, SL_ZS = 60416, SL_OX = 64512, SL_END = 80896;
template <int MODE> __device__ __forceinline__ void scan_units(const Args& a, int l, bool need_ctx, LAS unsigned char* lds, int tid, int lane, int wave, int bid, int G) {
    typedef float f32x4_t __attribute__((ext_vector_type(4)));
    typedef float f32x2_t __attribute__((ext_vector_type(2)));
    unsigned char* ws = a.ws;
    const bf16* P = (const bf16*)(ws + WS_P); bf16* Y = (bf16*)(ws + WS_ACT);
    float* KV = (float*)(ws + WS_KV); float* DEC = (float*)(ws + WS_DEC);
    const f32x2_t* ROPE = (const f32x2_t*)(ws + WS_ROPE);
    const int slot_lo = (MODE == 3 && !need_ctx) ? 4 : 0, nsl = NSLOT - slot_lo, nunits = 2 * NB * 4 * nsl;
    const int col = lane, dir = col >> 5, d = col & 31, seg = wave, g = lane >> 4, li = lane & 15;
    for (int u = bid; u < nunits; u += G) {
        const int mixer = u / (NB * 4 * nsl), rem = u % (NB * 4 * nsl), b = rem / (4 * nsl), h = (rem / nsl) & 3, slot = slot_lo + rem % nsl;
        const bool lat = slot >= 4; const int t0 = lat ? (slot - 4) * 64 : slot * 64; const int r0 = lat ? b * SEQ + t0 : ML + b * CTX + t0;
        const int oq = mixer ? OFF_RQ : OFF_GQ, ok = mixer ? OFF_RK : OFF_GK, ov = mixer ? OFF_RV : OFF_GV, og = mixer ? OFF_RG : OFF_GR;
        float la[8];
        if (mixer == 0) {
            LAS float* zs = (LAS float*)(lds + SL_ZS) + wave * 128;
            zs[lane] = bf2f(P[(size_t)(r0 + 8 * seg + (lane >> 4)) * PP + OFF_Z + (lane & 15)]);
            zs[64 + lane] = bf2f(P[(size_t)(r0 + 8 * seg + 4 + (lane >> 4)) * PP + OFF_Z + (lane & 15)]);
            const float* wa = (dir ? a.in[17] : a.in[15]) + (size_t)l * 16 * 128 + h * 32 + d; const float ba = (dir ? a.in[18] : a.in[16])[l * 128 + h * 32 + d];
            float wv[16];
#pragma unroll
            for (int j = 0; j < 16; ++j) wv[j] = wa[j * 128];
            LDS_WAIT();
#pragma unroll
            for (int i = 0; i < 8; ++i) { float pre = ba;
#pragma unroll
                for (int j = 0; j < 16; ++j) pre += zs[i * 16 + j] * wv[j];
                la[i] = (fminf(pre, 0.f) - log1pf(expf(-fabsf(pre)))) * (1.0f / 16.0f); }
        } else {
            const float lg = log1pf(-exp2f(-5.0f - (float)h));
#pragma unroll
            for (int i = 0; i < 8; ++i) la[i] = lg;
        }
        float cum[8];
        if (dir == 0) { float r = 0.f;
#pragma unroll
            for (int i = 0; i < 8; ++i) { r += la[i]; cum[i] = r; } ((LAS float*)(lds + SL_TOT))[seg * 64 + col] = r; }
        else { float r = 0.f;
#pragma unroll
            for (int i = 7; i >= 0; --i) { r += la[i]; cum[i] = r; } ((LAS float*)(lds + SL_TOT))[seg * 64 + col] = r; }
        float qv[8], kv[8];
#pragma unroll
        for (int i = 0; i < 8; ++i) { const bf16* pr = P + (size_t)(r0 + 8 * seg + i) * PP;
            float q = bf2f(pr[oq + h * 32 + d]), k = bf2f(pr[ok + h * 32 + d]);
            if (mixer == 0) q *= 0.17677669529663687f;
            else { k *= 0.17677669529663687f;
                if (lat) { const float qp = bf2f(pr[oq + h * 32 + (d ^ 16)]), kp = bf2f(pr[ok + h * 32 + (d ^ 16)]) * 0.17677669529663687f;
                    const f32x2_t cs = ROPE[(size_t)(t0 + 8 * seg + i) * 16 + (d & 15)]; const float sg = d < 16 ? -1.f : 1.f;
                    q = q * cs.x + sg * qp * cs.y; k = k * cs.x + sg * kp * cs.y; } }
            qv[i] = q; kv[i] = k; }
        { v4u w; unsigned short vv[8];
#pragma unroll
            for (int i = 0; i < 8; ++i) vv[i] = P[(size_t)(r0 + 8 * wave + i) * PP + ov + h * 64 + lane];
            w.x = vv[0] | ((unsigned)vv[1] << 16); w.y = vv[2] | ((unsigned)vv[3] << 16); w.z = vv[4] | ((unsigned)vv[5] << 16); w.w = vv[6] | ((unsigned)vv[7] << 16);
            *(LAS v4u*)(lds + SL_VT + lane * 144 + wave * 16) = w; }
        const int chain_f = ((mixer * 2 + 0) * NB + b) * 4 + h, chain_b = ((mixer * 2 + 1) * NB + b) * 4 + h;
        if (MODE == 3) {
#pragma unroll
            for (int dd = 0; dd < 2; ++dd) { const float* S = KV + ((size_t)(dd ? chain_b : chain_f) * NSLOT + slot) * 2048;
                const f32x4_t s4 = *(const f32x4_t*)(S + tid * 4); v2u w; w.x = pk2(s4.x, s4.y); w.y = pk2(s4.z, s4.w);
                *(LAS v2u*)(lds + SL_ST + dd * 5120 + (tid >> 3) * 80 + (tid & 7) * 8) = w; }
        }
        __syncthreads();
        {
            const LAS float* tot = (const LAS float*)(lds + SL_TOT); float off = 0.f, total = 0.f;
#pragma unroll
            for (int s2 = 0; s2 < 8; ++s2) { const float tv = tot[s2 * 64 + col]; total += tv; if (dir == 0 ? (s2 < seg) : (s2 > seg)) off += tv; }
            if (MODE == 3) {
#pragma unroll
                for (int i = 0; i < 8; ++i) { const float c = cum[i] + off; const int s = 8 * seg + i;
                    *(LAS unsigned short*)(lds + SL_QD + dir * 5120 + s * 80 + d * 2) = (unsigned short)f2bf(qv[i] * expf(c));
                    *(LAS unsigned short*)(lds + SL_KI + dir * 5120 + s * 80 + d * 2) = (unsigned short)f2bf(kv[i] * expf(-c)); }
            } else {
                v4u w; unsigned short ke[8];
#pragma unroll
                for (int i = 0; i < 8; ++i) ke[i] = (unsigned short)f2bf(kv[i] * expf(total - (cum[i] + off)));
                w.x = ke[0] | ((unsigned)ke[1] << 16); w.y = ke[2] | ((unsigned)ke[3] << 16); w.z = ke[4] | ((unsigned)ke[5] << 16); w.w = ke[6] | ((unsigned)ke[7] << 16);
                *(LAS v4u*)(lds + SL_KI + dir * 4608 + d * 144 + seg * 16) = w;
                if (seg == 0) DEC[((size_t)(dir ? chain_b : chain_f) * NSLOT + slot) * 32 + d] = expf(total);
            }
        }
        __syncthreads();
        const int wdir = wave >> 2, wt = wave & 3;
        if (MODE == 1) {
            f32x4_t acc[2] = {(f32x4_t){0.f, 0.f, 0.f, 0.f}, (f32x4_t){0.f, 0.f, 0.f, 0.f}};
#pragma unroll
            for (int ks = 0; ks < 2; ++ks) { const bf16x8 af = *(LAS bf16x8*)(lds + SL_VT + (16 * wt + li) * 144 + 64 * ks + 16 * g);
#pragma unroll
                for (int dt = 0; dt < 2; ++dt) { const bf16x8 bfr = *(LAS bf16x8*)(lds + SL_KI + wdir * 4608 + (16 * dt + li) * 144 + 64 * ks + 16 * g);
                    acc[dt] = __builtin_amdgcn_mfma_f32_16x16x32_bf16(af, bfr, acc[dt], 0, 0, 0); } }
            float* dst = KV + ((size_t)(wdir ? chain_b : chain_f) * NSLOT + slot) * 2048;
#pragma unroll
            for (int dt = 0; dt < 2; ++dt)
#pragma unroll
                for (int r = 0; r < 4; ++r) dst[(16 * wt + 4 * g + r) * 32 + 16 * dt + li] = acc[dt][r];
        } else {
            const int ct = wt;
            const bf16x8 qf = *(LAS bf16x8*)(lds + SL_QD + wdir * 5120 + (16 * ct + li) * 80 + 16 * g);
#pragma unroll
            for (int st = 0; st < 4; ++st) {
                f32x4_t sc = {0.f, 0.f, 0.f, 0.f};
                const bool live = wdir == 0 ? (st <= ct) : (st >= ct);
                if (live) { const bf16x8 kf = *(LAS bf16x8*)(lds + SL_KI + wdir * 5120 + (16 * st + li) * 80 + 16 * g);
                    sc = __builtin_amdgcn_mfma_f32_16x16x32_bf16(kf, qf, sc, 0, 0, 0);
                    if (st == ct) {
#pragma unroll
                        for (int r = 0; r < 4; ++r) { const int s = 4 * g + r, c = li; if (wdir == 0 ? (s > c) : (s < c)) sc[r] = 0.f; } } }
                v2u w; w.x = pk2(sc[0], sc[1]); w.y = pk2(sc[2], sc[3]);
                *(LAS v2u*)(lds + SL_SC + wdir * 9216 + (16 * ct + li) * 144 + (16 * st + 4 * g) * 2) = w; }
            LDS_WAIT();
            f32x4_t acc[4];
#pragma unroll
            for (int et = 0; et < 4; ++et) acc[et] = (f32x4_t){0.f, 0.f, 0.f, 0.f};
            const bf16x8 s0 = *(LAS bf16x8*)(lds + SL_SC + wdir * 9216 + (16 * ct + li) * 144 + 16 * g), s1 = *(LAS bf16x8*)(lds + SL_SC + wdir * 9216 + (16 * ct + li) * 144 + 64 + 16 * g);
#pragma unroll
            for (int et = 0; et < 4; ++et) {
                const bf16x8 v0 = *(LAS bf16x8*)(lds + SL_VT + (16 * et + li) * 144 + 16 * g), v1 = *(LAS bf16x8*)(lds + SL_VT + (16 * et + li) * 144 + 64 + 16 * g);
                const bf16x8 stf = *(LAS bf16x8*)(lds + SL_ST + wdir * 5120 + (16 * et + li) * 80 + 16 * g);
                acc[et] = __builtin_amdgcn_mfma_f32_16x16x32_bf16(v0, s0, acc[et], 0, 0, 0);
                acc[et] = __builtin_amdgcn_mfma_f32_16x16x32_bf16(v1, s1, acc[et], 0, 0, 0);
                acc[et] = __builtin_amdgcn_mfma_f32_16x16x32_bf16(stf, qf, acc[et], 0, 0, 0); }
            LAS float* ox = (LAS float*)(lds + SL_OX) + ct * 1024;
            if (wdir == 1) {
#pragma unroll
                for (int et = 0; et < 4; ++et)
#pragma unroll
                    for (int r = 0; r < 4; ++r) ox[(et * 4 + r) * 64 + lane] = acc[et][r]; }
            __syncthreads();
            if (wdir == 0) {
                float ss = 0.f;
#pragma unroll
                for (int et = 0; et < 4; ++et)
#pragma unroll
                    for (int r = 0; r < 4; ++r) { acc[et][r] += ox[(et * 4 + r) * 64 + lane]; ss += acc[et][r] * acc[et][r]; }
                ss += __shfl_xor(ss, 16); ss += __shfl_xor(ss, 32);
                const float rs = 1.0f / sqrtf(ss * (1.0f / 64) + EPS);
                const int row = r0 + 16 * ct + li; const float* ng = (mixer ? a.in[22] : a.in[19]) + l * 256 + h * 64;
#pragma unroll
                for (int et = 0; et < 4; ++et) { const int e0 = 16 * et + 4 * g;
                    const v2u gt = *(const v2u*)(P + (size_t)row * PP + og + h * 64 + e0); const f32x4_t gn = *(const f32x4_t*)(ng + e0);
                    const float g0 = bf2f((unsigned short)(gt.x & 0xffff)), g1 = bf2f((unsigned short)(gt.x >> 16)), g2 = bf2f((unsigned short)(gt.y & 0xffff)), g3 = bf2f((unsigned short)(gt.y >> 16));
                    v2u w; w.x = pk2(acc[et][0] * rs * gn.x * siluf_(g0), acc[et][1] * rs * gn.y * siluf_(g1)); w.y = pk2(acc[et][2] * rs * gn.z * siluf_(g2), acc[et][3] * rs * gn.w * siluf_(g3));
                    *(v2u*)(Y + (size_t)row * D + (mixer ? 768 : 256) + h * 64 + e0) = w; }
            }
        }
        __syncthreads();
    }
}
__device__ __forceinline__ void ph_scan_state(unsigned char* ws, int tid, int bid, int G) {
    float* KV = (float*)(ws + WS_KV); const float* DEC = (const float*)(ws + WS_DEC);
    for (int gid = bid * NTHREADS + tid; gid < NCHAIN * 2048; gid += G * NTHREADS) {
        const int chain = gid >> 11, idx = gid & 2047, d = idx & 31, dir = (chain / (NB * 4)) & 1;
        float* kv = KV + (size_t)chain * NSLOT * 2048 + idx; const float* dc = DEC + (size_t)chain * NSLOT * 32 + d;
        float S = 0.f;
#pragma unroll 4
        for (int i = 0; i < NSLOT; ++i) {
            const int slot = dir == 0 ? i : (i < 4 ? 3 - i : NSLOT + 3 - i);
            const float kvv = kv[(size_t)slot * 2048], dv = dc[slot * 32];
            kv[(size_t)slot * 2048] = S; S = dv * S + kvv;
        }
    }
}
__device__ __forceinline__ void ph_rope_table(unsigned char* ws, int tid, int bid, int G) {
    typedef float f32x2_t __attribute__((ext_vector_type(2)));
    f32x2_t* ROPE = (f32x2_t*)(ws + WS_ROPE);
    for (int i = bid * NTHREADS + tid; i < SEQ * 16; i += G * NTHREADS) { const int t = i >> 4, k = i & 15;
        const float inv = exp2f(-(float)(k & 7) * (13.287712379549449f / 8.0f)); const float ang = (float)(k < 8 ? t / GRIDW : t % GRIDW) * inv;
        float s, c; sincosf(ang, &s, &c); ROPE[i] = (f32x2_t){c, s}; }
}
__global__ void __launch_bounds__(NTHREADS, 2) mk(Args a) {
    extern __shared__ __attribute__((aligned(16))) unsigned char lds_raw[];
    LAS unsigned char* lds = (LAS unsigned char*)lds_raw;
    cg::grid_group grid = cg::this_grid();
    volatile LAS unsigned* MISC = (volatile LAS unsigned*)(lds + RING_BYTES + 64);
    if (threadIdx.x < 16) MISC[threadIdx.x] = 0u;
    __syncthreads();
    XcdBarrier xbar = xcd_barrier_post((unsigned*)(a.ws + WS_CTL), MISC + 8);
    int tid = threadIdx.x, lane = tid & 63, wave = __builtin_amdgcn_readfirstlane(tid >> 6);
    const int bid = blockIdx.x, G = gridDim.x, NGW = G * NWAVES; int gw = bid * NWAVES + wave;
#define FRESH() do { tid = threadIdx.x; asm volatile("" : "+v"(tid)); lane = tid & 63; wave = __builtin_amdgcn_readfirstlane(tid >> 6); gw = bid * NWAVES + wave; } while (0)
    unsigned char* ws = a.ws;
    float* XC = (float*)(ws + WS_XC);
    bf16* ACT = (bf16*)(ws + WS_ACT); bf16* P = (bf16*)(ws + WS_P); bf16* H = (bf16*)(ws + WS_H);
#define GSYNC() do { xcd_barrier(xbar); FRESH(); } while (0)
    REPEAT(REP_PRO) { ph_rope_table(ws, tid, bid, G); ph_prologue(a, lds, tid, lane, wave, bid, G); __syncthreads(); FRESH(); }
    grid.sync(); FRESH();
    for (int l = 0; l < DEPTH; ++l) {
        const bool need_ctx = l < DEPTH - 1; const int nro = need_ctx ? M : ML;
        const float* mod = (const float*)(ws + WS_MOD) + (size_t)l * NS * NMOD;
        const float* xl = l == 0 ? a.in[0] : a.out; const float* xc = l == 0 ? a.in[2] : (const float*)(ws + WS_XC);
        REPEAT(REP_NORM) { ph_normmod(xl, xc, a.in[6] + l * D, mod, 0, 1, ACT, M, lane, gw, NGW); FRESH(); }
        GSYNC();
        REPEAT(REP_INPROJ) { pg8::Gemm g{ACT, (const bf16*)(ws + WS_WIN + l * WIN_BYTES), M, PP, D}; pg8::StaticOrder S; S.init(M, PP, G, bid);
          pg8::EpiStore<0> E{P, PP}; pg8::gemm_phase<pg8::EpiStore<0>, pg8::StaticOrder, true, true>(lds, g, S, E, tid); FRESH(); }
        GSYNC();
        REPEAT(REP_B1) {
        ph_conv(P, a.in[9] + l * 31 * 256, a.in[10] + l * 256, a.in[11] + l * 256, a.in[12] + l * 256, (const bf16*)(ws + WS_WPW + l * WPW_BYTES), a.in[14] + l * 256, ACT, nro, lds, tid, lane, wave, bid, G);
        __syncthreads(); FRESH();
        ph_attprep(P, a.in[20] + l * 64, a.in[21] + l * 64, (bf16*)(ws + WS_QA), (bf16*)(ws + WS_KA), (bf16*)(ws + WS_VA), lane, gw, NGW);
        FRESH();
        scan_units<1>(a, l, need_ctx, lds, tid, lane, wave, bid, G);
        FRESH(); }
        GSYNC();
        ph_scan_state(ws, tid, bid, G);
        FRESH();
        REPEAT(REP_ATT) { ph_attention((const bf16*)(ws + WS_QA), (const bf16*)(ws + WS_KA), (const bf16*)(ws + WS_VA), ACT, need_ctx, (char*)lds_raw, bid, G, tid); FRESH(); }
        GSYNC();
        REPEAT(REP_B3) { scan_units<3>(a, l, need_ctx, lds, tid, lane, wave, bid, G); FRESH(); }
        GSYNC();
        REPEAT(REP_WOUT) { pg8::Gemm g{ACT, (const bf16*)(ws + WS_WOUT + l * WOUT_BYTES), nro, D, D}; pg8::StaticOrder S; S.init(nro, D, G, bid);
          pg8::EpiResid E{xl, xc, a.out, XC, mod + 2 * D, rep_}; pg8::gemm_phase<pg8::EpiResid, pg8::StaticOrder, true, true>(lds, g, S, E, tid); FRESH(); }
        GSYNC();
        REPEAT(REP_NORM) { ph_normmod(a.out, XC, a.in[7] + l * D, mod, 3, 4, ACT, nro, lane, gw, NGW); FRESH(); }
        GSYNC();
        REPEAT(REP_UP) { pg8::Gemm g{ACT, (const bf16*)(ws + WS_WUP + l * WUP_BYTES), nro, DFF, D}; pg8::StaticOrder S; S.init(nro, DFF, G, bid);
          pg8::EpiStore<2> E{H, DFF}; pg8::gemm_phase<pg8::EpiStore<2>, pg8::StaticOrder, true, true>(lds, g, S, E, tid); FRESH(); }
        GSYNC();
        REPEAT(REP_DOWN) { pg8::Gemm g{H, (const bf16*)(ws + WS_WDN + l * WDN_BYTES), nro, D, DFF}; pg8::StaticOrder S; S.init(nro, D, G, bid);
          pg8::EpiResid E{a.out, XC, a.out, XC, mod + 5 * D, rep_}; pg8::gemm_phase<pg8::EpiResid, pg8::StaticOrder, true, true>(lds, g, S, E, tid); FRESH(); }
        GSYNC();
    }
    ph_final(a.out, a.in[26], lane, gw, NGW);
}
extern "C" void kernel_launch(void* const* d_in, const int* in_sizes, int n_in, void* d_out, int out_size, void* d_ws, size_t ws_size, hipStream_t stream) {
    static int grid = 0;
    if (grid == 0) {
        if (n_in != 27 || in_sizes[0] != ML * D || out_size != ML * D || ws_size < WS_END) { fprintf(stderr, "kernel_launch: unexpected shapes / workspace (n_in %d, ws %zu)\n", n_in, ws_size); grid = -1; return; }
        int dev = 0, cus = 0, per_cu = 0;
        if (hipGetDevice(&dev) != hipSuccess || hipDeviceGetAttribute(&cus, hipDeviceAttributeMultiprocessorCount, dev) != hipSuccess) { grid = -1; return; }
        if (hipFuncSetAttribute((const void*)mk, hipFuncAttributeMaxDynamicSharedMemorySize, LDS_BYTES) != hipSuccess) { fprintf(stderr, "kernel_launch: hipFuncSetAttribute failed\n"); grid = -1; return; }
        if (hipOccupancyMaxActiveBlocksPerMultiprocessor(&per_cu, (const void*)mk, NTHREADS, LDS_BYTES) != hipSuccess || per_cu < 1) { fprintf(stderr, "kernel_launch: occupancy query says %d blocks per CU\n", per_cu); (void)hipGetLastError(); per_cu = 1; }
        grid = cus * (per_cu > 1 ? 1 : per_cu);
    }
    if (grid < 0) return;
    Args a{};
    for (int i = 0; i < 27; ++i) a.in[i] = (const float*)d_in[i];
    a.out = (float*)d_out; a.ws = (unsigned char*)d_ws;
    if (hipMemsetAsync((char*)d_ws + WS_CTL, 0, 16384, stream) != hipSuccess) { fprintf(stderr, "kernel_launch: memset failed\n"); return; }
    void* args[] = {&a};
    hipError_t e = hipLaunchCooperativeKernel((const void*)mk, dim3(grid), dim3(NTHREADS), args, LDS_BYTES, stream);
    if (e != hipSuccess) fprintf(stderr, "kernel_launch: cooperative launch failed: %s (grid %d)\n", hipGetErrorString(e), grid);
}
```

```cpp
#include <hip/hip_runtime.h>
#include <hip/hip_cooperative_groups.h>
#include <cstdio>
#include <cstdint>
namespace cg = cooperative_groups;
#ifndef REP_PRO
#define REP_PRO 1
#endif
#ifndef REP_NORM
#define REP_NORM 1
#endif
#ifndef REP_INPROJ
#define REP_INPROJ 1
#endif
#ifndef REP_B1
#define REP_B1 1
#endif
#ifndef REP_CONV
#define REP_CONV 1
#endif
#ifndef REP_ATTPREP
#define REP_ATTPREP 1
#endif
#ifndef REP_SCAN1
#define REP_SCAN1 1
#endif
#ifndef REP_ATT
#define REP_ATT 1
#endif
#ifndef REP_B3
#define REP_B3 1
#endif
#ifndef REP_WOUT
#define REP_WOUT 1
#endif
#ifndef REP_UP
#define REP_UP 1
#endif
#ifndef REP_DOWN
#define REP_DOWN 1
#endif
#define REPEAT(n) _Pragma("nounroll") for (int rep_ = 0, nrep_ = opaque_int(n); rep_ < nrep_; ++rep_)
__device__ __forceinline__ int opaque_int(int v) { asm volatile("" : "+s"(v)); return v; }

constexpr int D = 1024, NB = 4, SEQ = 4096, CTX = 256, DFF = 4096, DEPTH = 2, GRIDW = 64;
constexpr int ML = NB * SEQ, MC = NB * CTX, M = ML + MC, NS = NB + 1, NMOD = 6 * D;
constexpr int PIN = 2576;
constexpr int PP = 2816;
constexpr int OFF_CA = 0, OFF_CG = 256, OFF_GQ = 512, OFF_GK = 640, OFF_GV = 768, OFF_GR = 1024, OFF_AQ = 1280, OFF_AK = 1536, OFF_AV = 1664,
              OFF_RQ = 1792, OFF_RK = 1920, OFF_RV = 2048, OFF_RG = 2304, OFF_Z = 2560;
constexpr float EPS = 1e-6f;
constexpr int KEYS = CTX + SEQ;
namespace pg8 {
#define PG8_LAS __attribute__((address_space(3)))
typedef unsigned short bf16_t;
typedef short bf16x8 __attribute__((ext_vector_type(8)));
typedef float f32x4 __attribute__((ext_vector_type(4)));
typedef unsigned u32x4 __attribute__((ext_vector_type(4)));
constexpr int BM = 256, BK = 64, HALF = 128, HTB = HALF * BK * 2  , STAGE_BYTES = 8 * HTB, NXCD = 8, WGM = 8;

__host__ __device__ __forceinline__ int lds_byte(int r, int c) { const int st = (r >> 4) * 2 + (c >> 5), rr = r & 15, cc = c & 31, ob = rr * 64 + cc * 2; return st * 1024 + (ob ^ (((ob >> 9) & 1) << 5)); }
__host__ __device__ __forceinline__ void stage_rc(int b, int& R, int& C) { const int st = b / 1024, sb = b % 1024, swz = sb ^ (((sb >> 9) & 1) << 5); R = (st >> 1) * 16 + swz / 64; C = (st & 1) * 32 + (swz % 64) / 2; }
__host__ __device__ __forceinline__ int perm32(int rho) { const int n = rho >> 4, i = rho & 15; return 8 * (i >> 2) + 4 * n + (i & 3); }

struct Unit { int pm, pn; };
struct Gemm { const bf16_t* A; const bf16_t* Bt; int M, N, K; };

struct StaticOrder {
    int nM, nN, nwg, G, c;
    __host__ __device__ void init(int M, int N, int G_, int c_) { nM = M / BM; nN = N / BM; nwg = nM * nN; G = G_; c = c_; }
    __host__ __device__ bool next(int i, Unit& u) const {
        const long L = (long)i * G + c; if (L >= nwg) return false;
        int wgid = (int)L; { const int q = nwg / NXCD, r = nwg % NXCD, xcd = wgid % NXCD, off = wgid / NXCD; wgid = (xcd < r ? xcd * (q + 1) : r * (q + 1) + (xcd - r) * q) + off; }
        const int nig = WGM * nN, gid = wgid / nig, fm = gid * WGM, gsz = (nM - fm) < WGM ? (nM - fm) : WGM;
        u.pm = fm + ((wgid % nig) % gsz); u.pn = (wgid % nig) / gsz; return true;
    }
    __device__ __forceinline__ void a_ready(const Unit&) const {}
    __device__ __forceinline__ void done(const Unit&) const {}
};

__device__ __forceinline__ unsigned cvt_pk_bf16(float lo, float hi) { unsigned r; asm volatile("v_cvt_pk_bf16_f32 %0, %1, %2" : "=v"(r) : "v"(lo), "v"(hi)); return r; }
typedef float f32x2 __attribute__((ext_vector_type(2)));
__device__ __forceinline__ f32x2 gelu_pk(f32x2 v) {
    const f32x2 av = __builtin_elementwise_abs(v), d = av * 0.2316418882f + 1.0f;
    f32x2 t; t.x = __builtin_amdgcn_rcpf(d.x); t.y = __builtin_amdgcn_rcpf(d.y);
    f32x2 q = t * 0.5307027145f + (-0.7265760135f); q = q * t + 0.7107068705f; q = q * t + (-0.142248368f); q = q * t + 0.127414796f; q = q * t;
    const f32x2 s = (v * v) * (-0.72134752044f);
    f32x2 e; e.x = __builtin_amdgcn_exp2f(s.x); e.y = __builtin_amdgcn_exp2f(s.y);
    const f32x2 m = v * (q * e), r = v - m;
    f32x2 o; o.x = v.x < 0.f ? m.x : r.x; o.y = v.y < 0.f ? m.y : r.y; return o;
}

template <int ACT  > struct EpiBf16 {
    static constexpr bool PERM = true, AFTER_DRAIN = false; static_assert(ACT == 0 || ACT == 1, "EpiBf16: ACT is 0 (none) or 1 (gelu_pk)");
    bf16_t* O; int ldc; const float* bias; int split_cols; size_t split_stride; float scale0;
    __device__ __forceinline__ void operator()(const f32x4 (&acc)[2][2][4][2], const Unit& u, int wr, int wc, int fr, int fq) const {
        const int row0 = u.pm * BM + wr * 64 + fr; int colt = u.pn * BM; bf16_t* base = O;
        float sc = 1.f; if (split_cols) { const int t = colt / split_cols; base += (size_t)t * split_stride; colt -= t * split_cols; if (t == 0) sc = scale0; }
        const int col0 = colt + wc * 32 + 8 * fq, bcol0 = u.pn * BM + wc * 32 + 8 * fq;
        f32x4 bv[2][2];
#pragma unroll
        for (int bj = 0; bj < 2; ++bj)
#pragma unroll
            for (int n = 0; n < 2; ++n) bv[bj][n] = bias ? *(const f32x4*)(bias + bcol0 + bj * HALF + 4 * n) : (f32x4){0.f, 0.f, 0.f, 0.f};
#pragma unroll
        for (int ai = 0; ai < 2; ++ai)
#pragma unroll
            for (int m = 0; m < 4; ++m) { bf16_t* rowp = base + (size_t)(row0 + ai * HALF + m * 16) * ldc + col0;
#pragma unroll
                for (int bj = 0; bj < 2; ++bj) { f32x4 v0 = acc[ai][bj][m][0] + bv[bj][0], v1 = acc[ai][bj][m][1] + bv[bj][1];
                    if (ACT == 1) { f32x2 a = gelu_pk((f32x2){v0[0], v0[1]}), b = gelu_pk((f32x2){v0[2], v0[3]}), c = gelu_pk((f32x2){v1[0], v1[1]}), d = gelu_pk((f32x2){v1[2], v1[3]});
                        v0 = (f32x4){a.x, a.y, b.x, b.y}; v1 = (f32x4){c.x, c.y, d.x, d.y}; }
                    v0 = v0 * sc; v1 = v1 * sc; u32x4 w; w.x = cvt_pk_bf16(v0[0], v0[1]); w.y = cvt_pk_bf16(v0[2], v0[3]); w.z = cvt_pk_bf16(v1[0], v1[1]); w.w = cvt_pk_bf16(v1[2], v1[3]);
                    *(u32x4*)(rowp + bj * HALF) = w; } }
    }
};

template <int ACT> struct EpiStore {
    static constexpr bool PERM = true, AFTER_DRAIN = false;
    bf16_t* O; int ldc;
    __device__ __forceinline__ void operator()(const f32x4 (&acc)[2][2][4][2], const Unit& u, int wr, int wc, int fr, int fq) const {
        const int row0 = u.pm * BM + wr * 64 + fr, col0 = u.pn * BM + wc * 32 + 8 * fq;
#pragma unroll
        for (int ai = 0; ai < 2; ++ai)
#pragma unroll
            for (int m = 0; m < 4; ++m) { bf16_t* rowp = O + (size_t)(row0 + ai * HALF + m * 16) * ldc + col0;
#pragma unroll
                for (int bj = 0; bj < 2; ++bj) { f32x4 v0 = acc[ai][bj][m][0], v1 = acc[ai][bj][m][1];
                    if (ACT == 2) {
#pragma unroll
                        for (int e = 0; e < 4; ++e) { const float a = v0[e] > 0.f ? v0[e] : 0.f, b = v1[e] > 0.f ? v1[e] : 0.f; v0[e] = a * a; v1[e] = b * b; } }
                    u32x4 w; w.x = cvt_pk_bf16(v0[0], v0[1]); w.y = cvt_pk_bf16(v0[2], v0[3]); w.z = cvt_pk_bf16(v1[0], v1[1]); w.w = cvt_pk_bf16(v1[2], v1[3]);
                    *(u32x4*)(rowp + bj * HALF) = w; } }
    }
};
struct EpiResid {
    static constexpr bool PERM = false, AFTER_DRAIN = false;
    const float* xin_l; const float* xin_c; float* xout_l; float* xout_c; const float* gate;
    int dry;
    __device__ __forceinline__ void operator()(const f32x4 (&acc)[2][2][4][2], const Unit& u, int wr, int wc, int fr, int fq) const {
        const int r0 = u.pm * BM; const bool lat = r0 < ML; const int slot = lat ? r0 / SEQ : NB;
        const float* xin = lat ? xin_l + (size_t)r0 * D : xin_c + (size_t)(r0 - ML) * D;
        float* xout = lat ? xout_l + (size_t)r0 * D : xout_c + (size_t)(r0 - ML) * D;
        const int col0 = wc * 32 + 4 * fq;
        const float* gp = gate + (size_t)slot * NMOD + u.pn * BM;
        xin += u.pn * BM; xout += u.pn * BM;
#pragma unroll
        for (int ai = 0; ai < 2; ++ai)
#pragma unroll
            for (int m = 0; m < 4; ++m) { const int off = (ai * HALF + wr * 64 + m * 16 + fr) * D + col0;
#pragma unroll
                for (int bj = 0; bj < 2; ++bj)
#pragma unroll
                    for (int n = 0; n < 2; ++n) { const f32x4 xi = *(const f32x4*)(xin + off + bj * HALF + n * 16); const f32x4 gv = *(const f32x4*)(gp + col0 + bj * HALF + n * 16);
                        if (!dry) *(f32x4*)(xout + off + bj * HALF + n * 16) = xi + gv * acc[ai][bj][m][n]; }
                asm volatile("" ::: "memory"); }
    }
};

template <class Epi, class Sched, bool ALIGN_EPI = false, bool SP2 = false>
__device__ __forceinline__ void gemm_phase(PG8_LAS unsigned char* lds, const Gemm g, const Sched& S, const Epi& E, const int tid) {
    const int wid = __builtin_amdgcn_readfirstlane(tid >> 6), lane = tid & 63, wr = wid >> 2, wc = wid & 3, fr = lane & 15, fq = lane >> 4;
    const int K = g.K, nt = K / BK;
    unsigned voffA[2], voffB[2];
#pragma unroll
    for (int i = 0; i < 2; ++i) { int R, C; stage_rc(tid * 16 + i * 8192, R, C); const int Rb = Epi::PERM ? ((R & ~31) + perm32(R & 31)) : R;
        voffA[i] = (unsigned)(R * K + C) * 2u; voffB[i] = (unsigned)(Rb * K + C) * 2u; }
    const size_t kstep = (size_t)(BK * 2);
    const size_t hstep = (size_t)HALF * K * 2;
    const size_t tstep = 2 * hstep;
    const unsigned ldsw = (unsigned)wid * 1024u;
    const int aoff = lds_byte(wr * 64 + fr, fq * 8), boff = lds_byte(wc * 32 + fr, fq * 8);
#define PG8_SA(b, h) (((b) * 2 + (h)) * HTB)
#define PG8_SB(b, h) ((4 + (b) * 2 + (h)) * HTB)
#define PG8_STAGE(bufoff, gbase, voff) do { _Pragma("unroll") for (int _i = 0; _i < 2; ++_i) \
        __builtin_amdgcn_global_load_lds((const unsigned*)((const char*)(gbase) + (voff)[_i]), (PG8_LAS unsigned*)(lds + (bufoff) + ldsw + _i * 8192), 16, 0, 0); } while (0)
#define PG8_LDA(dst, b, h) do { _Pragma("unroll") for (int m = 0; m < 4; ++m) _Pragma("unroll") for (int k = 0; k < 2; ++k) dst[m][k] = *(const PG8_LAS bf16x8*)(lds + PG8_SA(b, h) + aoff + m * 2048 + k * 1024); } while (0)
#define PG8_LDB(dst, b, h) do { _Pragma("unroll") for (int n = 0; n < 2; ++n) _Pragma("unroll") for (int k = 0; k < 2; ++k) dst[n][k] = *(const PG8_LAS bf16x8*)(lds + PG8_SB(b, h) + boff + n * 2048 + k * 1024); } while (0)
#define PG8_MMA(ai, bj, At, Bt) do { __builtin_amdgcn_s_setprio(1); _Pragma("unroll") for (int m = 0; m < 4; ++m) _Pragma("unroll") for (int n = 0; n < 2; ++n) _Pragma("unroll") for (int k = 0; k < 2; ++k) \
        acc[ai][bj][m][n] = __builtin_amdgcn_mfma_f32_16x16x32_bf16(Bt[n][k], At[m][k], acc[ai][bj][m][n], 0, 0, 0); __builtin_amdgcn_s_setprio(0); } while (0)
#define PG8_WAIT_V(n) asm volatile("s_waitcnt vmcnt(" #n ")" ::: "memory")
#define PG8_WAIT_L(n) asm volatile("s_waitcnt lgkmcnt(" #n ")" ::: "memory")
#define PG8_BAR __builtin_amdgcn_s_barrier()
#define PG8_SCHED __builtin_amdgcn_sched_barrier(0)
    Unit cur, nxt; int ui = 0;
    if (!S.next(0, cur)) return;
    f32x4 acc[2][2][4][2];
#pragma unroll
    for (int a = 0; a < 2; ++a)
#pragma unroll
        for (int b = 0; b < 2; ++b)
#pragma unroll
            for (int m = 0; m < 4; ++m)
#pragma unroll
                for (int n = 0; n < 2; ++n) acc[a][b][m][n] = (f32x4){0.f, 0.f, 0.f, 0.f};
    bf16x8 At[4][2], B0[2][2], B1[2][2];
    const char* cA = (const char*)g.A + (size_t)cur.pm * tstep; const char* cB = (const char*)g.Bt + (size_t)cur.pn * tstep;
    S.a_ready(cur);
    if constexpr (SP2) {
        PG8_STAGE(PG8_SB(0, 0), cB, voffB); PG8_STAGE(PG8_SB(0, 1), cB + hstep, voffB); PG8_STAGE(PG8_SA(0, 0), cA, voffA); PG8_STAGE(PG8_SA(0, 1), cA + hstep, voffA);
        if (wr == 1) PG8_BAR;
        PG8_WAIT_V(2); PG8_BAR;
        PG8_STAGE(PG8_SB(1, 0), cB + kstep, voffB); PG8_STAGE(PG8_SA(1, 0), cA + kstep, voffA); PG8_STAGE(PG8_SB(1, 1), cB + hstep + kstep, voffB);
        PG8_WAIT_V(6); PG8_BAR;
    } else {
        PG8_STAGE(PG8_SB(0, 0), cB, voffB); PG8_STAGE(PG8_SA(0, 0), cA, voffA); PG8_STAGE(PG8_SB(0, 1), cB + hstep, voffB); PG8_STAGE(PG8_SA(0, 1), cA + hstep, voffA);
        if (wr == 1) PG8_BAR;
        PG8_WAIT_V(4); PG8_BAR;
        PG8_STAGE(PG8_SB(1, 0), cB + kstep, voffB); PG8_STAGE(PG8_SA(1, 0), cA + kstep, voffA); PG8_STAGE(PG8_SB(1, 1), cB + hstep + kstep, voffB);
        PG8_WAIT_V(6); PG8_BAR;
    }
    for (;;) {
        const bool has_next = S.next(ui + 1, nxt);
        const char* nA = has_next ? (const char*)g.A + (size_t)nxt.pm * tstep : cA; const char* nB = has_next ? (const char*)g.Bt + (size_t)nxt.pn * tstep : cB;
        for (int t = 0; t < nt; t += 2) {
            const bool last = (t == nt - 2);
            const char* a1 = cA + (size_t)(t + 1) * kstep;
            const char* a2 = last ? nA : cA + (size_t)(t + 2) * kstep; const char* b2 = last ? nB : cB + (size_t)(t + 2) * kstep;
            const char* a3 = a2 + kstep; const char* b3 = b2 + kstep;
            if (last && has_next) S.a_ready(nxt);
            if constexpr (SP2) {
            PG8_LDB(B0, 0, 0); PG8_LDB(B1, 0, 1); PG8_SCHED; PG8_LDA(At, 0, 0); PG8_STAGE(PG8_SA(1, 1), a1 + hstep, voffA);
            PG8_WAIT_V(8); PG8_WAIT_L(0); PG8_BAR; PG8_MMA(0, 0, At, B0); PG8_MMA(0, 1, At, B1); PG8_BAR; PG8_SCHED;
            PG8_LDA(At, 0, 1); PG8_STAGE(PG8_SB(0, 0), b2, voffB); PG8_STAGE(PG8_SB(0, 1), b2 + hstep, voffB); PG8_STAGE(PG8_SA(0, 0), a2, voffA);
            PG8_WAIT_V(8); PG8_WAIT_L(0); PG8_BAR; PG8_MMA(1, 0, At, B0); PG8_MMA(1, 1, At, B1); PG8_BAR; PG8_SCHED;
            PG8_LDB(B0, 1, 0); PG8_LDB(B1, 1, 1); PG8_SCHED; PG8_LDA(At, 1, 0); PG8_STAGE(PG8_SA(0, 1), a2 + hstep, voffA);
            PG8_WAIT_V(8); PG8_WAIT_L(0); PG8_BAR; PG8_MMA(0, 0, At, B0); PG8_MMA(0, 1, At, B1); PG8_BAR; PG8_SCHED;
            PG8_LDA(At, 1, 1); PG8_STAGE(PG8_SB(1, 0), b3, voffB); PG8_STAGE(PG8_SB(1, 1), b3 + hstep, voffB); PG8_STAGE(PG8_SA(1, 0), a3, voffA);
            PG8_WAIT_V(8); PG8_WAIT_L(0); PG8_BAR; PG8_MMA(1, 0, At, B0); PG8_MMA(1, 1, At, B1); PG8_BAR; PG8_SCHED;
            } else {
            PG8_LDB(B0, 0, 0); PG8_SCHED; PG8_LDA(At, 0, 0); PG8_STAGE(PG8_SA(1, 1), a1 + hstep, voffA);
            PG8_WAIT_L(8); PG8_BAR; PG8_WAIT_L(0); PG8_MMA(0, 0, At, B0); PG8_BAR; PG8_SCHED;
            PG8_LDB(B1, 0, 1); PG8_STAGE(PG8_SB(0, 0), b2, voffB);
            PG8_BAR; PG8_WAIT_L(0); PG8_MMA(0, 1, At, B1); PG8_BAR;
            PG8_LDA(At, 0, 1); PG8_STAGE(PG8_SA(0, 0), a2, voffA);
            PG8_BAR; PG8_WAIT_L(0); PG8_MMA(1, 0, At, B0); PG8_BAR; PG8_SCHED;
            PG8_STAGE(PG8_SB(0, 1), b2 + hstep, voffB);
            PG8_WAIT_V(6); PG8_BAR; PG8_MMA(1, 1, At, B1); PG8_BAR;
            PG8_LDB(B0, 1, 0); PG8_SCHED; PG8_LDA(At, 1, 0); PG8_STAGE(PG8_SA(0, 1), a2 + hstep, voffA);
            PG8_WAIT_L(8); PG8_BAR; PG8_WAIT_L(0); PG8_MMA(0, 0, At, B0); PG8_BAR; PG8_SCHED;
            PG8_LDB(B1, 1, 1); PG8_STAGE(PG8_SB(1, 0), b3, voffB);
            PG8_BAR; PG8_WAIT_L(0); PG8_MMA(0, 1, At, B1); PG8_BAR;
            PG8_LDA(At, 1, 1); PG8_STAGE(PG8_SA(1, 0), a3, voffA);
            PG8_BAR; PG8_WAIT_L(0); PG8_MMA(1, 0, At, B0); PG8_BAR; PG8_SCHED;
            PG8_STAGE(PG8_SB(1, 1), b3 + hstep, voffB);
            PG8_WAIT_V(6); PG8_BAR; PG8_MMA(1, 1, At, B1); PG8_BAR;
            }
        }
        if constexpr (ALIGN_EPI) { if (wr == 0) PG8_BAR; }
        if constexpr (!Epi::AFTER_DRAIN) { E(acc, cur, wr, wc, fr, fq); S.done(cur); }
        if (!has_next) break;
#pragma unroll
        for (int a = 0; a < 2; ++a)
#pragma unroll
            for (int b = 0; b < 2; ++b)
#pragma unroll
                for (int m = 0; m < 4; ++m)
#pragma unroll
                    for (int n = 0; n < 2; ++n) acc[a][b][m][n] = (f32x4){0.f, 0.f, 0.f, 0.f};
        cur = nxt; cA = nA; cB = nB; ++ui;
        if constexpr (ALIGN_EPI) { if (wr == 1) PG8_BAR; }
    }
    PG8_WAIT_V(0);
    if constexpr (!ALIGN_EPI) { if (wr == 0) PG8_BAR; }
    PG8_BAR;
    if constexpr (Epi::AFTER_DRAIN) { E.fused(acc, cur, wr, wc, fr, fq, lds, wid, lane); S.done(cur); }
#undef PG8_SA
#undef PG8_SB
#undef PG8_STAGE
#undef PG8_LDA
#undef PG8_LDB
#undef PG8_MMA
#undef PG8_WAIT_V
#undef PG8_WAIT_L
#undef PG8_BAR
#undef PG8_SCHED
}
}
#include <hip/hip_bf16.h>
#include <cmath>
namespace attn_body {
using bf16=__hip_bfloat16;
using bf16x8=__attribute__((ext_vector_type(8)))short;
using s16x4=__attribute__((ext_vector_type(4)))short;
using f32x16=__attribute__((ext_vector_type(16)))float;
using u32x4=__attribute__((ext_vector_type(4)))unsigned;
constexpr int D=64;
constexpr int QP=256,KP=128,OP=1024;
constexpr int NW=8,QBLK=32,QB=QBLK*NW,KVBLK=64;
constexpr int ATTN_UNIT_ROWS=QB;
__device__ __forceinline__ int crow(int r,int hi){return (r&3)+8*(r>>2)+4*hi;}
#define SBAR() __builtin_amdgcn_sched_barrier(0)
__device__ __forceinline__ void cmask(f32x16&p0,f32x16&p1,int jb,int qrel,int hi){
  const float NEG=-INFINITY; int kb=64*jb+4*hi;
  #pragma unroll
  for(int r=0;r<16;++r){int kv=kb+(r&3)+8*(r>>2); if(kv>qrel)p0[r]=NEG; if(kv+32>qrel)p1[r]=NEG;}
}

constexpr int NSLOT=3, SLOTB=8192;
constexpr int LDS_K=0, LDS_V=NSLOT*SLOTB, LDS_WS=2*NSLOT*SLOTB, LDS_OST=LDS_WS+NW*64*4, LDS_BYTES=LDS_OST+NW*4096;
constexpr float C2=0.125f*1.4426950408889634f;
__device__ __forceinline__ void glds16(const void*gsrc,unsigned lds_dst){unsigned keep;
  asm volatile("s_mov_b32 %0, m0\n\ts_mov_b32 m0, %2\n\ts_nop 0\n\tglobal_load_lds_dwordx4 %1, off\n\ts_mov_b32 m0, %0":"=&s"(keep):"v"(gsrc),"s"(lds_dst):"memory");}
__device__ __forceinline__ float max3f(float a,float b,float c){float r;asm("v_max3_f32 %0, %1, %2, %3":"=v"(r):"v"(a),"v"(b),"v"(c));return r;}
__device__ __forceinline__ float max2f(float a,float b){float r;asm("v_max_f32_e32 %0, %1, %2":"=v"(r):"v"(a),"v"(b));return r;}
__device__ __forceinline__ float fadd_s(float a,float b){float r;asm("v_add_f32_e32 %0, %1, %2":"=v"(r):"v"(a),"v"(b));return r;}
__device__ __forceinline__ float fsub_s(float a,float b){float r;asm("v_sub_f32_e32 %0, %1, %2":"=v"(r):"v"(a),"v"(b));return r;}
typedef float f32x2_t __attribute__((ext_vector_type(2))); typedef __bf16 bf16x2_t __attribute__((ext_vector_type(2)));
__device__ __forceinline__ unsigned cvtpk_s(float lo,float hi){f32x2_t v={lo,hi};bf16x2_t b=__builtin_convertvector(v,bf16x2_t);return __builtin_bit_cast(unsigned,b);}
#define WAIT_BAR(N) asm volatile("s_waitcnt vmcnt(" #N ") lgkmcnt(0)\n\ts_barrier":::"memory")

__device__ __forceinline__ void qkt(f32x16&p0,f32x16&p1,const char*Kslot,const bf16x8*qr,const f32x16&negm,int r32,int hi){
  const char*kb=Kslot+hi*1024+r32*16;
  #pragma unroll
  for(int d0=0;d0<4;++d0){
    const bf16x8 b0=*reinterpret_cast<const bf16x8*>(kb+d0*2048);
    const bf16x8 b1=*reinterpret_cast<const bf16x8*>(kb+d0*2048+512);
    if(d0==0){p0=__builtin_amdgcn_mfma_f32_32x32x16_bf16(b0,qr[0],negm,0,0,0);p1=__builtin_amdgcn_mfma_f32_32x32x16_bf16(b1,qr[0],negm,0,0,0);}
    else{p0=__builtin_amdgcn_mfma_f32_32x32x16_bf16(b0,qr[d0],p0,0,0,0);p1=__builtin_amdgcn_mfma_f32_32x32x16_bf16(b1,qr[d0],p1,0,0,0);}}
}
typedef __attribute__((address_space(3))) const char* lds_cptr;
typedef short v4i16_t __attribute__((ext_vector_type(4)));
__device__ __forceinline__ void kload8(bf16x8*kf,lds_cptr kp){
  kf[0]=*(const __attribute__((address_space(3))) bf16x8*)(kp);      kf[1]=*(const __attribute__((address_space(3))) bf16x8*)(kp+512);
  kf[2]=*(const __attribute__((address_space(3))) bf16x8*)(kp+2048); kf[3]=*(const __attribute__((address_space(3))) bf16x8*)(kp+2560);
  kf[4]=*(const __attribute__((address_space(3))) bf16x8*)(kp+4096); kf[5]=*(const __attribute__((address_space(3))) bf16x8*)(kp+4608);
  kf[6]=*(const __attribute__((address_space(3))) bf16x8*)(kp+6144); kf[7]=*(const __attribute__((address_space(3))) bf16x8*)(kp+6656);
}
__device__ __forceinline__ void kload2(bf16x8*kf,lds_cptr kp,int j){ kf[2*j]=*(const __attribute__((address_space(3))) bf16x8*)(kp+j*2048); kf[2*j+1]=*(const __attribute__((address_space(3))) bf16x8*)(kp+j*2048+512); }
__device__ __forceinline__ s16x4 vtr(lds_cptr p){ return __builtin_bit_cast(s16x4,__builtin_amdgcn_ds_read_tr16_b64_v4i16((__attribute__((address_space(3))) v4i16_t*)p)); }
__device__ __forceinline__ float rowmax(const f32x16&p0,const f32x16&p1){
  float a=max3f(p0[0],p0[1],p1[0]),b=max3f(p0[2],p0[3],p1[1]);a=max3f(a,p1[2],p1[3]);
  #pragma unroll
  for(int r=4;r<16;r+=4){a=max3f(a,p0[r],p0[r+1]);b=max3f(b,p0[r+2],p0[r+3]);a=max3f(a,p1[r],p1[r+1]);b=max3f(b,p1[r+2],p1[r+3]);}
  const float m=max2f(a,b);
  auto rr=__builtin_amdgcn_permlane32_swap(__float_as_uint(m),__float_as_uint(m),false,false);
  return max2f(__uint_as_float(rr[0]),__uint_as_float(rr[1]));
}
__device__ __forceinline__ void pv(f32x16*o,int vb,bf16x8 pa0,bf16x8 pa1,bf16x8 pa2,bf16x8 pa3){
  #pragma unroll
  for(int d0=0;d0<2;++d0){s16x4 lo[4],hi[4];
    #pragma unroll
    for(int ks=0;ks<4;++ks){
      asm volatile("ds_read_b64_tr_b16 %0,%1 offset:%c2":"=&v"(lo[ks]):"v"(vb),"i"(d0*4096+ks*1024):"memory");
      asm volatile("ds_read_b64_tr_b16 %0,%1 offset:%c2":"=&v"(hi[ks]):"v"(vb),"i"(d0*4096+ks*1024+512):"memory");}
    asm volatile("s_waitcnt lgkmcnt(0)":::"memory");SBAR();
    #define PK(k) (bf16x8){lo[k][0],lo[k][1],lo[k][2],lo[k][3],hi[k][0],hi[k][1],hi[k][2],hi[k][3]}
    o[d0]=__builtin_amdgcn_mfma_f32_32x32x16_bf16(pa0,PK(0),o[d0],0,0,0);
    o[d0]=__builtin_amdgcn_mfma_f32_32x32x16_bf16(pa1,PK(1),o[d0],0,0,0);
    o[d0]=__builtin_amdgcn_mfma_f32_32x32x16_bf16(pa2,PK(2),o[d0],0,0,0);
    o[d0]=__builtin_amdgcn_mfma_f32_32x32x16_bf16(pa3,PK(3),o[d0],0,0,0);
    #undef PK
  }
}

#ifndef ATTN_STORE16
#define ATTN_STORE16(p,v) (*(u32x4*)(p)=(v))
#endif
template<int THRL> __device__ __forceinline__ void attn_unit(const bf16*Qu,const bf16*__restrict__ Kh,const bf16*__restrict__ Vh,bf16*Ou,const int NT,char*shm,const int tid){
  const int lane=tid&63,r32=lane&31,hi=lane>>5; const int wid=__builtin_amdgcn_readfirstlane(tid>>6);
  const bf16*Qw=Qu+(long)(wid*QBLK)*QP;
  const unsigned lds0=(unsigned)(uintptr_t)shm;
  float*wsf=(float*)(shm+LDS_WS)+wid*64;
  const bf16*ksrc=Kh+(long)lane*KP+wid*8;
  const bf16*vsrc=Vh+(long)(16*(wid&3)+(lane>>2))*KP+(wid>>2)*32+(lane&3)*8;
  const unsigned kdst=lds0+LDS_K+wid*1024, vdst=lds0+LDS_V+wid*1024;
  #define DMA_K(t,slot) glds16(ksrc+(long)(t)*KVBLK*KP,(unsigned)__builtin_amdgcn_readfirstlane(kdst+(slot)))
  #define DMA_V(t,slot) glds16(vsrc+(long)(t)*KVBLK*KP,(unsigned)__builtin_amdgcn_readfirstlane(vdst+(slot)))
  const int vb0=(int)(lds0+LDS_V)+((lane>>4)&1)*32+(lane&3)*8+(4*hi+((lane&15)>>2))*64;
  const char*Kbase=shm+LDS_K; bf16x8 kf[8];
  const lds_cptr shm3=(lds_cptr)shm; const lds_cptr kp0=shm3+LDS_K+hi*1024+r32*16; const lds_cptr vp0=shm3+LDS_V+((lane>>4)&1)*32+(lane&3)*8+(4*hi+((lane&15)>>2))*64;
  DMA_K(0,0);DMA_V(0,0);DMA_K(1,SLOTB);
  bf16x8 qr[4];
  #pragma unroll
  for(int d0=0;d0<4;++d0)qr[d0]=*reinterpret_cast<const bf16x8*>(&Qw[(long)r32*QP+d0*16+hi*8]);
  float mhat=0.f,l_reg=0.f;f32x16 o[2];o[0]=f32x16{};o[1]=f32x16{};f32x16 negm=f32x16{};asm volatile("":"+v"(negm));
  #define CMASK(P0,P1,t) do{}while(0)
  bool resc=false;
  #define START(P0,P1) do{ const float rm=rowmax(P0,P1); resc=false; \
    { const float dl=rm; mhat=fadd_s(mhat,dl); \
      _Pragma("unroll") for(int r=0;r<16;++r){P0[r]=fsub_s(P0[r],dl);P1[r]=fsub_s(P1[r],dl);} \
      _Pragma("unroll") for(int r=0;r<16;++r)negm[r]=-mhat; asm volatile("":"+v"(negm)); } \
    _Pragma("unroll") for(int r=0;r<16;++r)P0[r]=__builtin_amdgcn_exp2f(P0[r]); }while(0)
  #define RESC() do{ if(resc){ asm volatile("s_waitcnt lgkmcnt(0)":::"memory"); \
      _Pragma("unroll") for(int d_=0;d_<2;++d_) _Pragma("unroll") for(int r=0;r<16;++r)o[d_][r]*=wsf[crow(r,hi)]; } }while(0)
  f32x16 pA0,pA1,pB0,pB1;
  int sl_prev=0,sl_cur=0,sl_next=SLOTB;
  #define ROT() do{sl_prev=sl_cur;sl_cur=sl_next;sl_next=(sl_next==(NSLOT-1)*SLOTB)?0:sl_next+SLOTB;}while(0)
  DMA_K(2,2*SLOTB);
  WAIT_BAR(3);
  qkt(pA0,pA1,Kbase,qr,negm,r32,hi);asm volatile("s_nop 15\n\ts_nop 7":"+v"(pA0),"+v"(pA1));CMASK(pA0,pA1,0);
  START(pA0,pA1);
  _Pragma("unroll") for(int r=0;r<16;++r)pA1[r]=__builtin_amdgcn_exp2f(pA1[r]);
  WAIT_BAR(0);
  DMA_K(3,0);DMA_V(1,SLOTB);
  ROT();
  kload8(kf,kp0+sl_cur);
  WAIT_BAR(2);
  s16x4 vlo[8],vhi[8]; u32x4 pw0,pw1,pw2,pw3;
  #define PKW(P,B) cvtpk_s(P[B],P[B+1])
  #define PAF(k) __builtin_bit_cast(bf16x8,pw##k)
  #define VFR(i) (bf16x8){vlo[i][0],vlo[i][1],vlo[i][2],vlo[i][3],vhi[i][0],vhi[i][1],vhi[i][2],vhi[i][3]}
  #define PIN(x) asm volatile("":"+v"(x))
  #define MX3(a,b,c) __builtin_fmaxf(__builtin_fmaxf((a),(b)),(c))
  #define GAPA(MF,A0,A1,A2,A3,W0,W1,PW) do{ MF; sacc+=A0; sacc+=A1; sacc+=A2; sacc+=A3; PIN(sacc); W0; W1; PIN(PW); SBAR(); }while(0)
  #define EX(v) __builtin_amdgcn_exp2f(v)
  #define GAPB(MF,X,B) do{ MF; X[B]=EX(X[B]); X[B+1]=EX(X[B+1]); X[B+2]=EX(X[B+2]); X[B+3]=EX(X[B+3]); PIN(X); SBAR(); }while(0)
  #define VRD(i) do{ vlo[i]=vtr(vp_+(((i)>>2)*4096+((i)&3)*1024)); vhi[i]=vtr(vp_+(((i)>>2)*4096+((i)&3)*1024+512)); }while(0)
  #define KRD(G,j) do{ if(G){ kload2(kf,kp0+sl_next,j); SBAR(); } }while(0)
  #define STEP(C0,C1,P0,P1,t,GK,GV,GL) do{ SBAR(); \
    const lds_cptr vp_=vp0+sl_prev; \
    VRD(0); SBAR(); float sacc=(P0[0]+P0[1]); \
    GAPA(C0=__builtin_amdgcn_mfma_f32_32x32x16_bf16(kf[0],qr[0],negm,0,0,0), P0[2],P0[3],P0[4],P0[5],     pw0[0]=PKW(P0,0), pw0[1]=PKW(P0,2), pw0); \
    VRD(4); SBAR(); GAPA(C1=__builtin_amdgcn_mfma_f32_32x32x16_bf16(kf[1],qr[0],negm,0,0,0), P0[6],P0[7],P0[8],P0[9],     pw0[2]=PKW(P0,4), pw0[3]=PKW(P0,6), pw0); \
    VRD(1); SBAR(); GAPA(C0=__builtin_amdgcn_mfma_f32_32x32x16_bf16(kf[2],qr[1],C0,0,0,0),   P0[10],P0[11],P0[12],P0[13], pw1[0]=PKW(P0,8), pw1[1]=PKW(P0,10), pw1); \
    VRD(5); SBAR(); GAPA(C1=__builtin_amdgcn_mfma_f32_32x32x16_bf16(kf[3],qr[1],C1,0,0,0),   P0[14],P0[15],P1[0],P1[1],   pw1[2]=PKW(P0,12),pw1[3]=PKW(P0,14), pw1); \
    VRD(2); SBAR(); GAPA(C0=__builtin_amdgcn_mfma_f32_32x32x16_bf16(kf[4],qr[2],C0,0,0,0),   P1[2],P1[3],P1[4],P1[5],     pw2[0]=PKW(P1,0), pw2[1]=PKW(P1,2), pw2); \
    VRD(6); SBAR(); GAPA(C1=__builtin_amdgcn_mfma_f32_32x32x16_bf16(kf[5],qr[2],C1,0,0,0),   P1[6],P1[7],P1[8],P1[9],     pw2[2]=PKW(P1,4), pw2[3]=PKW(P1,6), pw2); \
    VRD(3); SBAR(); GAPA(C0=__builtin_amdgcn_mfma_f32_32x32x16_bf16(kf[6],qr[3],C0,0,0,0),   P1[10],P1[11],P1[12],P1[13], pw3[0]=PKW(P1,8), pw3[1]=PKW(P1,10), pw3); \
    VRD(7); SBAR(); GAPA(C1=__builtin_amdgcn_mfma_f32_32x32x16_bf16(kf[7],qr[3],C1,0,0,0),   P1[14],P1[15],0.f,0.f,       pw3[2]=PKW(P1,12),pw3[3]=PKW(P1,14), pw3); \
    l_reg+=sacc; \
    if(GK){DMA_K((t)+3,sl_cur);} if(GV){DMA_V((t)+1,sl_next);} \
    CMASK(C0,C1,t); \
    { float a=MX3(C0[0],C0[1],C1[0]),b=MX3(C0[2],C0[3],C1[1]); a=MX3(a,C1[2],C1[3]); \
      _Pragma("unroll") for(int r=4;r<16;r+=4){a=MX3(a,C0[r],C0[r+1]);b=MX3(b,C0[r+2],C0[r+3]);a=MX3(a,C1[r],C1[r+1]);b=MX3(b,C1[r+2],C1[r+3]);} \
      float rm=__builtin_fmaxf(a,b); { auto rr=__builtin_amdgcn_permlane32_swap(__float_as_uint(rm),__float_as_uint(rm),false,false); rm=__builtin_fmaxf(__uint_as_float(rr[0]),__uint_as_float(rr[1])); } \
      resc=false; \
      if(__builtin_expect(__any(rm>(float)THRL),0)){ const float dl=__builtin_fmaxf(rm,0.f); mhat+=dl; \
        _Pragma("unroll") for(int r=0;r<16;++r){C0[r]-=dl;C1[r]-=dl;} \
        _Pragma("unroll") for(int r=0;r<16;++r)negm[r]=-mhat; asm volatile("":"+v"(negm)); \
        const float f=__builtin_amdgcn_exp2f(-dl); l_reg*=f; if(hi==0)wsf[r32]=f; resc=true; } } \
    SBAR(); \
    GAPB(o[0]=__builtin_amdgcn_mfma_f32_32x32x16_bf16(PAF(0),VFR(0),o[0],0,0,0), C0,0); \
    GAPB(o[1]=__builtin_amdgcn_mfma_f32_32x32x16_bf16(PAF(0),VFR(4),o[1],0,0,0), C0,4); \
    KRD(GL,0); GAPB(o[0]=__builtin_amdgcn_mfma_f32_32x32x16_bf16(PAF(1),VFR(1),o[0],0,0,0), C0,8); \
    KRD(GL,1); GAPB(o[1]=__builtin_amdgcn_mfma_f32_32x32x16_bf16(PAF(1),VFR(5),o[1],0,0,0), C0,12); \
    KRD(GL,2); GAPB(o[0]=__builtin_amdgcn_mfma_f32_32x32x16_bf16(PAF(2),VFR(2),o[0],0,0,0), C1,0); \
    KRD(GL,3); GAPB(o[1]=__builtin_amdgcn_mfma_f32_32x32x16_bf16(PAF(2),VFR(6),o[1],0,0,0), C1,4); \
    GAPB(o[0]=__builtin_amdgcn_mfma_f32_32x32x16_bf16(PAF(3),VFR(3),o[0],0,0,0), C1,8); \
    GAPB(o[1]=__builtin_amdgcn_mfma_f32_32x32x16_bf16(PAF(3),VFR(7),o[1],0,0,0), C1,12); \
    }while(0)
  int t=1;
  for(;t+5<NT;t+=2){
    STEP(pB0,pB1,pA0,pA1,t,true,true,true);     WAIT_BAR(2); RESC(); ROT();
    STEP(pA0,pA1,pB0,pB1,t+1,true,true,true);   WAIT_BAR(2); RESC(); ROT();
  }
  #define ENDW(tt) do{ if((tt)+3<NT){WAIT_BAR(2);} else if((tt)+2<NT){WAIT_BAR(1);} else {WAIT_BAR(0);} }while(0)
  for(;t+1<NT;t+=2){
    STEP(pB0,pB1,pA0,pA1,t,(t+3<NT),(t+1<NT),(t+1<NT));       ENDW(t);   RESC(); ROT();
    STEP(pA0,pA1,pB0,pB1,t+1,(t+4<NT),(t+2<NT),(t+2<NT));     ENDW(t+1); RESC(); ROT();
  }
  STEP(pB0,pB1,pA0,pA1,NT-1,false,false,false); RESC();
  { float sacc=pB0[0]+pB0[1]; _Pragma("unroll") for(int r=2;r<16;++r)sacc+=pB0[r]; _Pragma("unroll") for(int r=0;r<16;++r)sacc+=pB1[r]; l_reg+=sacc;
    pw0=(u32x4){PKW(pB0,0),PKW(pB0,2),PKW(pB0,4),PKW(pB0,6)};pw1=(u32x4){PKW(pB0,8),PKW(pB0,10),PKW(pB0,12),PKW(pB0,14)};pw2=(u32x4){PKW(pB1,0),PKW(pB1,2),PKW(pB1,4),PKW(pB1,6)};pw3=(u32x4){PKW(pB1,8),PKW(pB1,10),PKW(pB1,12),PKW(pB1,14)};
    SBAR(); pv(o,vb0+sl_cur,PAF(0),PAF(1),PAF(2),PAF(3)); }
  #undef PKW
  #undef PAF
  #undef VFR
  #undef PIN
  #undef MX3
  #undef GAPA
  #undef GAPB
  #undef EX
  #undef VRD
  #undef KRD
  #undef STEP
  #undef ENDW
  {auto rr=__builtin_amdgcn_permlane32_swap(__float_as_uint(l_reg),__float_as_uint(l_reg),false,false);l_reg=__uint_as_float(rr[0])+__uint_as_float(rr[1]);}
  if(hi==0)wsf[32+r32]=l_reg;asm volatile("s_waitcnt lgkmcnt(0)":::"memory");
  float rli[16];
  #pragma unroll
  for(int r=0;r<16;++r)rli[r]=__builtin_amdgcn_rcpf(wsf[32+crow(r,hi)]);
  bf16*Ow=Ou+(long)(wid*QBLK)*OP;
  { bf16*stg=(bf16*)(shm+LDS_OST)+wid*2048;
    #pragma unroll
    for(int r=0;r<16;++r){const int orow=crow(r,hi);
      #pragma unroll
      for(int d0=0;d0<2;++d0)stg[orow*64+d0*32+r32]=__float2bfloat16(o[d0][r]*rli[r]);}
    asm volatile("s_waitcnt lgkmcnt(0)":::"memory");
    #pragma unroll
    for(int i=0;i<4;++i){const int row=i*8+(lane>>3),ch=lane&7; const u32x4 v=*(const u32x4*)(stg+row*64+ch*8); ATTN_STORE16(Ow+(long)row*OP+ch*8,v);} }
  asm volatile("s_waitcnt lgkmcnt(0)\n\ts_barrier":::"memory");
  #undef DMA_K
  #undef DMA_V
  #undef CMASK
  #undef START
  #undef RESC
  #undef ROT
}
constexpr int ATTN_LDS_BYTES=LDS_BYTES;
#undef SBAR
#undef WAIT_BAR
}
#define GAS __attribute__((address_space(1)))
#define LAS __attribute__((address_space(3)))
typedef unsigned short bf16;
typedef unsigned v4u __attribute__((ext_vector_type(4)));
typedef unsigned v2u __attribute__((ext_vector_type(2)));
typedef float f32x4 __attribute__((ext_vector_type(4)));
typedef short bf16x8 __attribute__((ext_vector_type(8)));
constexpr int NWAVES = 8, NTHREADS = 512;
constexpr int RING_BYTES = 131072, LDS_BYTES = 147456;
#define LDS_WAIT() asm volatile("s_waitcnt lgkmcnt(0)" ::: "memory")
#define VM_WAIT() asm volatile("s_waitcnt vmcnt(0)" ::: "memory")
__device__ __forceinline__ unsigned f2bf(float f) { unsigned u = __builtin_bit_cast(unsigned, f); return (u + 0x7fffu + ((u >> 16) & 1u)) >> 16; }
__device__ __forceinline__ unsigned pk2(float lo, float hi) { return f2bf(lo) | (f2bf(hi) << 16); }
__device__ __forceinline__ float bf2f(unsigned short b) { return __builtin_bit_cast(float, ((unsigned)b) << 16); }
__device__ __forceinline__ float sigmoidf_(float x) { return 1.0f / (1.0f + __expf(-x)); }
__device__ __forceinline__ float siluf_(float x) { return x * sigmoidf_(x); }
__device__ __forceinline__ float wave_sum(float v) {
#pragma unroll
    for (int o = 1; o < 64; o <<= 1) v += __shfl_xor(v, o);
    return v;
}

constexpr size_t MiB = 1u << 20;
constexpr size_t WS_CTL = 0, WS_MOD = 1 * MiB;
constexpr size_t WS_WIN = 2 * MiB, WIN_BYTES = (size_t)PP * D * 2;
constexpr size_t WS_WOUT = WS_WIN + 2 * WIN_BYTES, WOUT_BYTES = (size_t)D * D * 2;
constexpr size_t WS_WUP = WS_WOUT + 2 * WOUT_BYTES, WUP_BYTES = (size_t)DFF * D * 2;
constexpr size_t WS_WDN = WS_WUP + 2 * WUP_BYTES, WDN_BYTES = (size_t)D * DFF * 2;
constexpr size_t WS_WPW = WS_WDN + 2 * WDN_BYTES, WPW_BYTES = (size_t)256 * 256 * 2;
static_assert(WS_WPW + 2 * WPW_BYTES <= 50 * MiB, "weights");
constexpr size_t WS_XC = 50 * MiB;
constexpr size_t WS_ACT = 54 * MiB;
constexpr size_t WS_P = 88 * MiB;
constexpr size_t WS_H = 88 * MiB;
constexpr size_t WS_QA = 182 * MiB;
constexpr size_t WS_KA = 191 * MiB, WS_VA = 196 * MiB;
constexpr size_t WS_KV = 201 * MiB;
constexpr size_t WS_DEC = 235 * MiB;
constexpr size_t WS_END = 256 * MiB;
static_assert(WS_P + (size_t)M * PP * 2 <= WS_QA && WS_H + (size_t)M * DFF * 2 <= WS_END && WS_ACT + (size_t)M * D * 2 <= WS_P, "ws map");

struct Args { const float* in[27]; float* out; unsigned char* ws; int ph_lo, ph_hi, layer, pad; };

template <class Map> __device__ __forceinline__ void transpose_item(const float* W, int K, int N, bf16* WT, LAS float* scr, int kb, int nb, int lane, Map srcc) {
    const int k0 = 64 * kb, n0 = 32 * nb; const int sc = srcc(n0 + (lane & 31));
#pragma unroll 8
    for (int i = 0; i < 32; ++i) { const int kk = 2 * i + (lane >> 5); scr[kk * 33 + (lane & 31)] = sc >= 0 ? W[(size_t)(k0 + kk) * N + sc] : 0.f; }
    LDS_WAIT(); asm volatile("" ::: "memory");
    const int c = lane & 7;
#pragma unroll
    for (int j = 0; j < 4; ++j) { const int n = (lane >> 3) + 8 * j; const LAS float* s = scr + (8 * c) * 33 + n;
        v4u o; o.x = pk2(s[0 * 33], s[1 * 33]); o.y = pk2(s[2 * 33], s[3 * 33]); o.z = pk2(s[4 * 33], s[5 * 33]); o.w = pk2(s[6 * 33], s[7 * 33]);
        *(GAS v4u*)(WT + (size_t)(n0 + n) * K + k0 + 8 * c) = o; }
    LDS_WAIT(); asm volatile("" ::: "memory");
}
struct MapId { __device__ __forceinline__ int operator()(int n) const { return n; } };
struct MapWin { __device__ __forceinline__ int operator()(int n) const { return n < 1280 ? n : (n < 2560 ? n + 16 : (n < 2576 ? n - 1280 : -1)); } };

__device__ __forceinline__ void ph_prologue(const Args& a, LAS unsigned char* lds, int tid, int lane, int wave, int bid, int G) {
    unsigned char* ws = a.ws;
    LAS float* scr = (LAS float*)(lds + wave * 16384);
    const int gw = bid * NWAVES + wave, NGW = G * NWAVES;
    constexpr int I_IN = (D / 64) * (PP / 32), I_OUT = (D / 64) * (D / 32), I_UP = (D / 64) * (DFF / 32), I_DN = (DFF / 64) * (D / 32), I_PW = (256 / 64) * (256 / 32);
    constexpr int I_L = I_IN + I_OUT + I_UP + I_DN + I_PW;
    for (int it = gw; it < DEPTH * I_L; it += NGW) {
        const int l = it / I_L; int r = it % I_L;
        if (r < I_IN) { transpose_item(a.in[8] + (size_t)l * D * PIN, D, PIN, (bf16*)(ws + WS_WIN + l * WIN_BYTES), scr, r / (PP / 32), r % (PP / 32), lane, MapWin()); continue; } r -= I_IN;
        if (r < I_OUT) { transpose_item(a.in[23] + (size_t)l * D * D, D, D, (bf16*)(ws + WS_WOUT + l * WOUT_BYTES), scr, r / (D / 32), r % (D / 32), lane, MapId()); continue; } r -= I_OUT;
        if (r < I_UP) { transpose_item(a.in[24] + (size_t)l * D * DFF, D, DFF, (bf16*)(ws + WS_WUP + l * WUP_BYTES), scr, r / (DFF / 32), r % (DFF / 32), lane, MapId()); continue; } r -= I_UP;
        if (r < I_DN) { transpose_item(a.in[25] + (size_t)l * DFF * D, DFF, D, (bf16*)(ws + WS_WDN + l * WDN_BYTES), scr, r / (D / 32), r % (D / 32), lane, MapId()); continue; } r -= I_DN;
        transpose_item(a.in[13] + (size_t)l * 256 * 256, 256, 256, (bf16*)(ws + WS_WPW + l * WPW_BYTES), scr, r / 8, r % 8, lane, MapId());
    }
    __syncthreads();
    LAS float* sil = (LAS float*)lds;
    LAS float* part = (LAS float*)(lds + NS * D * 4);
    float* MOD = (float*)(ws + WS_MOD);
    const float* c = a.in[1]; const float* cc = a.in[3]; const float* w_mod = a.in[4]; const float* b_mod = a.in[5];
    bool staged = false;
    for (int task = bid; task < DEPTH * (NMOD / 64); task += G) {
        if (!staged) { for (int i = tid; i < NS * D; i += NTHREADS) { const int s = i / D, k = i % D; const float v = s < NB ? c[s * D + k] : cc[k]; sil[i] = siluf_(v); } staged = true; __syncthreads(); }
        const int l = task / (NMOD / 64), c0 = (task % (NMOD / 64)) * 64;
        float acc[NS];
#pragma unroll
        for (int s = 0; s < NS; ++s) acc[s] = 0.f;
        const float* wp = w_mod + (size_t)l * D * NMOD + (size_t)(wave * 128) * NMOD + c0 + lane;
#pragma unroll 4
        for (int k = 0; k < 128; ++k) { const float wv = wp[(size_t)k * NMOD];
#pragma unroll
            for (int s = 0; s < NS; ++s) acc[s] += sil[s * D + wave * 128 + k] * wv; }
#pragma unroll
        for (int s = 0; s < NS; ++s) part[(wave * NS + s) * 64 + lane] = acc[s];
        __syncthreads();
        if (tid < NS * 64) { const int s = tid / 64, ln = tid % 64; float v = 0.f;
#pragma unroll
            for (int w = 0; w < 8; ++w) v += part[(w * NS + s) * 64 + ln];
            MOD[((size_t)l * NS + s) * NMOD + c0 + ln] = v + b_mod[(size_t)l * NMOD + c0 + ln]; }
        __syncthreads();
    }
}
__device__ __forceinline__ void ph_normmod(const float* xl, const float* xc, const float* g, const float* mod, int i_shift, int i_scale, bf16* XN, int nrows, int lane, int gw, int NGW) {
    constexpr int RN = 4;
    for (int rb = gw; rb < nrows; rb += NGW * RN) {
        f32x4 v[RN][4];
#pragma unroll
        for (int q = 0; q < RN; ++q) { const int r = rb + q * NGW;
            if (r < nrows) { const float* xr = r < ML ? xl + (size_t)r * D : xc + (size_t)(r - ML) * D;
#pragma unroll
                for (int j = 0; j < 4; ++j) v[q][j] = *(const f32x4*)(xr + 4 * lane + 256 * j); } }
#pragma unroll
        for (int q = 0; q < RN; ++q) { const int r = rb + q * NGW;
            if (r < nrows) {
                const float* m = mod + (size_t)(r < ML ? r / SEQ : NB) * NMOD;
                float s = 0.f;
#pragma unroll
                for (int j = 0; j < 4; ++j) s += (v[q][j].x * v[q][j].x + v[q][j].y * v[q][j].y) + (v[q][j].z * v[q][j].z + v[q][j].w * v[q][j].w);
                const float rs = 1.0f / sqrtf(wave_sum(s) * (1.0f / D) + EPS);
#pragma unroll
                for (int j = 0; j < 4; ++j) { const int c0 = 4 * lane + 256 * j;
                    const f32x4 gg = *(const f32x4*)(g + c0), sc = *(const f32x4*)(m + i_scale * D + c0), sh = *(const f32x4*)(m + i_shift * D + c0);
                    const f32x4 o = v[q][j] * rs * gg * (sc + 1.0f) + sh;
                    v2u w; w.x = pk2(o.x, o.y); w.y = pk2(o.z, o.w); *(v2u*)(XN + (size_t)r * D + c0) = w; } } }
    }
}
__device__ __forceinline__ void ph_final(float* x, const float* g, int lane, int gw, int NGW) {
    constexpr int RN = 4;
    for (int rb = gw; rb < ML; rb += NGW * RN) {
        f32x4 v[RN][4];
#pragma unroll
        for (int q = 0; q < RN; ++q) { const int r = rb + q * NGW;
            if (r < ML) {
#pragma unroll
                for (int j = 0; j < 4; ++j) v[q][j] = *(const f32x4*)(x + (size_t)r * D + 4 * lane + 256 * j); } }
#pragma unroll
        for (int q = 0; q < RN; ++q) { const int r = rb + q * NGW;
            if (r < ML) { float s = 0.f;
#pragma unroll
                for (int j = 0; j < 4; ++j) s += (v[q][j].x * v[q][j].x + v[q][j].y * v[q][j].y) + (v[q][j].z * v[q][j].z + v[q][j].w * v[q][j].w);
                const float rs = 1.0f / sqrtf(wave_sum(s) * (1.0f / D) + EPS);
#pragma unroll
                for (int j = 0; j < 4; ++j) { const int c0 = 4 * lane + 256 * j; *(f32x4*)(x + (size_t)r * D + c0) = v[q][j] * rs * *(const f32x4*)(g + c0); } } }
    }
}
#define XB_TMO      128
#define XB_XCNT(j)  (256  + 64 * (j))
#define XB_XSUB(j)  (1280 + 64 * (j))
#define XB_XGEN(j)  (2304 + 64 * (j))
#define XB_TOP      3328
#define XB_TOPGEN   3392
#define XCD_BAR_WORDS 3456
#define XB_SPIN_CAP (1u << 18)

__device__ __forceinline__ unsigned xb_ld(unsigned* p)              { return __hip_atomic_load(p, __ATOMIC_RELAXED, __HIP_MEMORY_SCOPE_AGENT); }
__device__ __forceinline__ unsigned xb_add(unsigned* p, unsigned v) { return __hip_atomic_fetch_add(p, v, __ATOMIC_RELAXED, __HIP_MEMORY_SCOPE_AGENT); }
__device__ __forceinline__ unsigned xb_xcc_id() { return (unsigned)__builtin_amdgcn_s_getreg((3 << 11) | 20) & 0xFu; }
#define XB_SPIN(cond, bar) do { unsigned _sp = 0; while (cond) { __builtin_amdgcn_s_sleep(1); \
    if ((++_sp & 255u) == 0u) { if (xb_ld(&(bar)[XB_TMO])) break; if (_sp > XB_SPIN_CAP) { atomicAdd(&(bar)[XB_TMO], 1u); break; } } } } while (0)

struct XcdBarrier {
    unsigned* bar; unsigned x;
    volatile LAS unsigned* st;
};

__device__ __forceinline__ XcdBarrier xcd_barrier_post(unsigned* bar, volatile LAS unsigned* st) {
    XcdBarrier b; b.bar = bar; b.x = xb_xcc_id(); b.st = st;
    if (threadIdx.x == 0) (void)xb_add(&bar[XB_XCNT(b.x)], 1u);
    return b;
}
__device__ __forceinline__ void xcd_barrier_complete(unsigned* bar, unsigned x, unsigned& nloc, unsigned& nx) {
    const unsigned G = gridDim.x * gridDim.y * gridDim.z;
    unsigned sum, cnt, mine, sp = 0u;
    for (;;) {
        sum = 0u; cnt = 0u; mine = 0u;
#pragma unroll
        for (unsigned j = 0; j < 16; ++j) { const unsigned c = xb_ld(&bar[XB_XCNT(j)]); sum += c; cnt += (c > 0u) ? 1u : 0u; mine = (j == x) ? c : mine; }
        if (sum == G) break;
        __builtin_amdgcn_s_sleep(1);
        if ((++sp & 255u) == 0u) { if (xb_ld(&bar[XB_TMO])) break; if (sp > XB_SPIN_CAP) { atomicAdd(&bar[XB_TMO], 1u); break; } }
    }
    nloc = mine > 0u ? mine : 1u; nx = cnt > 0u ? cnt : 1u;
}

__device__ __forceinline__ void xcd_barrier(const XcdBarrier& b) {
    asm volatile("s_waitcnt vmcnt(0)" ::: "memory");
    __syncthreads();
    if (threadIdx.x == 0) {
        unsigned* bar = b.bar;
        __builtin_amdgcn_s_waitcnt(0);
        unsigned nloc = b.st[0], nx = b.st[1];
        if (nloc == 0u) { xcd_barrier_complete(bar, b.x, nloc, nx); b.st[0] = nloc; b.st[1] = nx; }
        const unsigned old = xb_add(&bar[XB_XSUB(b.x)], 1u);
        const unsigned gen = old / nloc;
        if (old + 1u == (gen + 1u) * nloc) {
            __builtin_amdgcn_fence(__ATOMIC_RELEASE, "agent");
            asm volatile("s_waitcnt vmcnt(0)" ::: "memory");
            const unsigned og = xb_add(&bar[XB_TOP], 1u);
            const unsigned tg = og / nx;
            if (og + 1u == (tg + 1u) * nx) xb_add(&bar[XB_TOPGEN], 1u);
            else XB_SPIN(xb_ld(&bar[XB_TOPGEN]) == tg, bar);
            __builtin_amdgcn_fence(__ATOMIC_ACQUIRE, "agent");
            xb_add(&bar[XB_XGEN(b.x)], 1u);
            asm volatile("s_waitcnt vmcnt(0)" ::: "memory");
        } else {
            XB_SPIN(xb_ld(&bar[XB_XGEN(b.x)]) == gen, bar);
            __builtin_amdgcn_fence(__ATOMIC_ACQUIRE, "agent");
            asm volatile("s_waitcnt vmcnt(0)" ::: "memory");
        }
    }
    __syncthreads();
}
__device__ __forceinline__ void ph_attprep(const bf16* P, const float* qg, const float* kg, bf16* QA, bf16* KA, bf16* VA, int lane, int gw, int NGW) {
    const float gq = qg[lane], gk = kg[lane];
    const int kk = lane & 31; const float inv = exp2f(-(float)(kk & 15) * (13.287712379549449f / 16.0f));
    const float sgn = lane < 32 ? -1.f : 1.f;
    constexpr int RU = 4;
    for (int rb = gw; rb < M; rb += NGW * RU) {
        unsigned short xin[RU][6], vin[RU][2];
#pragma unroll
        for (int q = 0; q < RU; ++q) { const int r = rb + q * NGW;
            if (r < M) { const bf16* pr = P + (size_t)r * PP;
#pragma unroll
                for (int h = 0; h < 6; ++h) xin[q][h] = pr[(h < 4 ? OFF_AQ + h * 64 : OFF_AK + (h - 4) * 64) + lane];
                vin[q][0] = pr[OFF_AV + lane]; vin[q][1] = pr[OFF_AV + 64 + lane]; } }
#pragma unroll
        for (int q = 0; q < RU; ++q) { const int r = rb + q * NGW;
            if (r < M) {
                const bool lat = r < ML; const int b = lat ? r / SEQ : (r - ML) / CTX, t = lat ? r % SEQ : (r - ML) % CTX;
                float cs = 1.f, sn = 0.f;
                if (lat) { const float ang = (float)(kk < 16 ? t / GRIDW : t % GRIDW) * inv; sincosf(ang, &sn, &cs); }
                const size_t krow = (size_t)b * KEYS + (lat ? CTX + t : t);
#pragma unroll
                for (int h = 0; h < 6; ++h) {
                    const float x = bf2f(xin[q][h]);
                    const float rs = 1.0f / sqrtf(wave_sum(x * x) * (1.0f / 64) + EPS);
                    const float v = x * rs * (h < 4 ? gq : gk);
                    const float o = v * cs + sgn * __shfl_xor(v, 32) * sn;
                    if (h < 4) QA[(size_t)r * 256 + h * 64 + lane] = (bf16)f2bf(o * (0.125f * 1.4426950408889634f));
                    else KA[krow * 128 + (h - 4) * 64 + lane] = (bf16)f2bf(o);
                }
                VA[krow * 128 + lane] = vin[q][0]; VA[krow * 128 + 64 + lane] = vin[q][1]; } }
    }
}
__device__ __forceinline__ void ph_attention(const bf16* QA, const bf16* KA, const bf16* VA, bf16* Y, bool need_ctx, char* lds, int bid, int G, int tid) {
    const int vcu = (G % 8 == 0) ? (bid % 8) * (G / 8) + bid / 8 : bid;
    const int NU = 256 + (need_ctx ? 16 : 0);
    for (int u = vcu; u < NU; u += G) {
        if (u < 256) { const int b = u >> 6, h = (u >> 4) & 3, qb = u & 15; const size_t row = (size_t)b * SEQ + qb * 256;
            attn_body::attn_unit<8>((const attn_body::bf16*)(QA + row * 256 + h * 64), (const attn_body::bf16*)(KA + (size_t)b * KEYS * 128 + (h >> 1) * 64), (const attn_body::bf16*)(VA + (size_t)b * KEYS * 128 + (h >> 1) * 64),
                                    (attn_body::bf16*)(Y + row * D + 512 + h * 64), KEYS / 64, lds, tid); }
        else { const int b = (u - 256) >> 2, h = (u - 256) & 3; const size_t row = (size_t)ML + b * CTX;
            attn_body::attn_unit<8>((const attn_body::bf16*)(QA + row * 256 + h * 64), (const attn_body::bf16*)(KA + (size_t)b * KEYS * 128 + (h >> 1) * 64), (const attn_body::bf16*)(VA + (size_t)b * KEYS * 128 + (h >> 1) * 64),
                                    (attn_body::bf16*)(Y + row * D + 512 + h * 64), CTX / 64, lds, tid); }
    }
}
__device__ __forceinline__ void ph_conv(const bf16* P, const float* w_dw, const float* b_dw, const float* ln_g, const float* ln_b, const bf16* PwT, const float* b_pw, bf16* Y, int nrows,
                                        LAS unsigned char* lds, int tid, int lane, int wave, int bid, int G) {
    typedef float f32x4_t __attribute__((ext_vector_type(4)));
    LAS float* U = (LAS float*)lds; LAS unsigned char* Zb = lds + 96256; constexpr int ZS = 528;
    const int nunits = nrows / 64;
    if (bid >= nunits) return;
    const int ch = tid & 255, half = tid >> 8;
    float wreg[31];
#pragma unroll
    for (int j = 0; j < 31; ++j) wreg[j] = w_dw[j * 256 + ch];
    const float bdw = b_dw[ch];
    const f32x4_t lg = *(const f32x4_t*)(ln_g + 4 * lane), lb = *(const f32x4_t*)(ln_b + 4 * lane);
    bf16x8 wf[2][8];
#pragma unroll
    for (int nt = 0; nt < 2; ++nt)
#pragma unroll
        for (int ks = 0; ks < 8; ++ks) wf[nt][ks] = *(const bf16x8*)(PwT + (size_t)(32 * wave + 16 * nt + (lane & 15)) * 256 + 32 * ks + 8 * (lane >> 4));
    const f32x4_t bp0 = *(const f32x4_t*)(b_pw + 32 * wave + 4 * (lane >> 4)), bp1 = *(const f32x4_t*)(b_pw + 32 * wave + 16 + 4 * (lane >> 4));
    for (int u = bid; u < nunits; u += G) {
        const int r0 = u * 64; int base, t0, T;
        if (r0 < ML) { base = (r0 / SEQ) * SEQ; t0 = r0 % SEQ; T = SEQ; } else { const int rc = r0 - ML; base = ML + (rc / CTX) * CTX; t0 = rc % CTX; T = CTX; }
        for (int i = tid >> 5; i < 94; i += 16) {
            const int tt = t0 - 15 + i, c8 = (tid & 31) * 8;
            f32x4_t o0 = {0.f, 0.f, 0.f, 0.f}, o1 = {0.f, 0.f, 0.f, 0.f};
            if (tt >= 0 && tt < T) {
                const bf16* pr = P + (size_t)(base + tt) * PP;
                const bf16x8 av = *(const bf16x8*)(pr + OFF_CA + c8), gv = *(const bf16x8*)(pr + OFF_CG + c8);
#pragma unroll
                for (int e = 0; e < 4; ++e) { o0[e] = bf2f((unsigned short)av[e]) * sigmoidf_(bf2f((unsigned short)gv[e])); o1[e] = bf2f((unsigned short)av[4 + e]) * sigmoidf_(bf2f((unsigned short)gv[4 + e])); }
            }
            *(LAS f32x4_t*)(U + i * 256 + c8) = o0; *(LAS f32x4_t*)(U + i * 256 + c8 + 4) = o1;
        }
        __syncthreads();
        float y[32];
        {
            float uu[62];
#pragma unroll
            for (int i = 0; i < 62; ++i) uu[i] = U[(32 * half + i) * 256 + ch];
#pragma unroll
            for (int t = 0; t < 32; ++t) { float acc = bdw;
#pragma unroll
                for (int j = 0; j < 31; ++j) acc += uu[t + j] * wreg[j];
                y[t] = acc; }
        }
        __syncthreads();
#pragma unroll
        for (int t = 0; t < 32; ++t) U[(32 * half + t) * 256 + ch] = y[t];
        __syncthreads();
#pragma unroll 2
        for (int q = 0; q < 8; ++q) { const int tok = 8 * wave + q;
            const f32x4_t v = *(LAS f32x4_t*)(U + tok * 256 + 4 * lane);
            const float mu = wave_sum((v.x + v.y) + (v.z + v.w)) * (1.0f / 256);
            const f32x4_t dv = v - mu;
            const float var = wave_sum((dv.x * dv.x + dv.y * dv.y) + (dv.z * dv.z + dv.w * dv.w)) * (1.0f / 256);
            const float rs = 1.0f / sqrtf(var + EPS);
            f32x4_t o = dv * rs * lg + lb;
#pragma unroll
            for (int e = 0; e < 4; ++e) o[e] = siluf_(o[e]);
            v2u w; w.x = pk2(o.x, o.y); w.y = pk2(o.z, o.w);
            *(LAS v2u*)(Zb + tok * ZS + 8 * lane) = w; }
        __syncthreads();
        f32x4_t acc[2][4];
#pragma unroll
        for (int nt = 0; nt < 2; ++nt)
#pragma unroll
            for (int tt = 0; tt < 4; ++tt) acc[nt][tt] = (f32x4_t){0.f, 0.f, 0.f, 0.f};
#pragma unroll
        for (int ks = 0; ks < 8; ++ks) {
            bf16x8 zf[4];
#pragma unroll
            for (int tt = 0; tt < 4; ++tt) zf[tt] = *(LAS bf16x8*)(Zb + (16 * tt + (lane & 15)) * ZS + 64 * ks + 16 * (lane >> 4));
#pragma unroll
            for (int nt = 0; nt < 2; ++nt)
#pragma unroll
                for (int tt = 0; tt < 4; ++tt) acc[nt][tt] = __builtin_amdgcn_mfma_f32_16x16x32_bf16(wf[nt][ks], zf[tt], acc[nt][tt], 0, 0, 0);
        }
#pragma unroll
        for (int tt = 0; tt < 4; ++tt) { bf16* yr = Y + (size_t)(r0 + 16 * tt + (lane & 15)) * D + 32 * wave + 4 * (lane >> 4);
            const f32x4_t a0 = acc[0][tt] + bp0, a1 = acc[1][tt] + bp1;
            v2u w0, w1; w0.x = pk2(a0.x, a0.y); w0.y = pk2(a0.z, a0.w); w1.x = pk2(a1.x, a1.y); w1.y = pk2(a1.z, a1.w);
            *(v2u*)yr = w0; *(v2u*)(yr + 16) = w1; }
        __syncthreads();
    }
}
constexpr int NSLOT = (CTX + SEQ) / 64, NCHAIN = 2 * 2 * NB * 4;
constexpr size_t WS_ROPE = 256 * 1024;
constexpr int SL_QD = 0, SL_KI = 10240, SL_SC = 20480, SL_VT = 38912, SL_ST = 48128, SL_TOT = 58368, SL_ZS = 60416, SL_OX = 64512, SL_END = 80896;
template <int MODE> __device__ __forceinline__ void scan_units(const Args& a, int l, bool need_ctx, LAS unsigned char* lds, int tid, int lane, int wave, int bid, int G) {
    typedef float f32x4_t __attribute__((ext_vector_type(4)));
    typedef float f32x2_t __attribute__((ext_vector_type(2)));
    unsigned char* ws = a.ws;
    const bf16* P = (const bf16*)(ws + WS_P); bf16* Y = (bf16*)(ws + WS_ACT);
    float* KV = (float*)(ws + WS_KV); float* DEC = (float*)(ws + WS_DEC);
    const f32x2_t* ROPE = (const f32x2_t*)(ws + WS_ROPE);
    const int slot_lo = (MODE == 3 && !need_ctx) ? 4 : 0, nsl = NSLOT - slot_lo, nunits = 2 * NB * 4 * nsl;
    const int col = lane, dir = col >> 5, d = col & 31, seg = wave, g = lane >> 4, li = lane & 15;
    for (int u = bid; u < nunits; u += G) {
        const int mixer = u / (NB * 4 * nsl), rem = u % (NB * 4 * nsl), b = rem / (4 * nsl), h = (rem / nsl) & 3, slot = slot_lo + rem % nsl;
        const bool lat = slot >= 4; const int t0 = lat ? (slot - 4) * 64 : slot * 64; const int r0 = lat ? b * SEQ + t0 : ML + b * CTX + t0;
        const int oq = mixer ? OFF_RQ : OFF_GQ, ok = mixer ? OFF_RK : OFF_GK, ov = mixer ? OFF_RV : OFF_GV, og = mixer ? OFF_RG : OFF_GR;
        float la[8];
        if (mixer == 0) {
            LAS float* zs = (LAS float*)(lds + SL_ZS) + wave * 128;
            zs[lane] = bf2f(P[(size_t)(r0 + 8 * seg + (lane >> 4)) * PP + OFF_Z + (lane & 15)]);
            zs[64 + lane] = bf2f(P[(size_t)(r0 + 8 * seg + 4 + (lane >> 4)) * PP + OFF_Z + (lane & 15)]);
            const float* wa = (dir ? a.in[17] : a.in[15]) + (size_t)l * 16 * 128 + h * 32 + d; const float ba = (dir ? a.in[18] : a.in[16])[l * 128 + h * 32 + d];
            float wv[16];
#pragma unroll
            for (int j = 0; j < 16; ++j) wv[j] = wa[j * 128];
            LDS_WAIT();
#pragma unroll
            for (int i = 0; i < 8; ++i) { float pre = ba;
#pragma unroll
                for (int j = 0; j < 16; ++j) pre += zs[i * 16 + j] * wv[j];
                la[i] = (fminf(pre, 0.f) - log1pf(expf(-fabsf(pre)))) * (1.0f / 16.0f); }
        } else {
            const float lg = log1pf(-exp2f(-5.0f - (float)h));
#pragma unroll
            for (int i = 0; i < 8; ++i) la[i] = lg;
        }
        float cum[8];
        if (dir == 0) { float r = 0.f;
#pragma unroll
            for (int i = 0; i < 8; ++i) { r += la[i]; cum[i] = r; } ((LAS float*)(lds + SL_TOT))[seg * 64 + col] = r; }
        else { float r = 0.f;
#pragma unroll
            for (int i = 7; i >= 0; --i) { r += la[i]; cum[i] = r; } ((LAS float*)(lds + SL_TOT))[seg * 64 + col] = r; }
        float qv[8], kv[8];
#pragma unroll
        for (int i = 0; i < 8; ++i) { const bf16* pr = P + (size_t)(r0 + 8 * seg + i) * PP;
            float q = bf2f(pr[oq + h * 32 + d]), k = bf2f(pr[ok + h * 32 + d]);
            if (mixer == 0) q *= 0.17677669529663687f;
            else { k *= 0.17677669529663687f;
                if (lat) { const float qp = bf2f(pr[oq + h * 32 + (d ^ 16)]), kp = bf2f(pr[ok + h * 32 + (d ^ 16)]) * 0.17677669529663687f;
                    const f32x2_t cs = ROPE[(size_t)(t0 + 8 * seg + i) * 16 + (d & 15)]; const float sg = d < 16 ? -1.f : 1.f;
                    q = q * cs.x + sg * qp * cs.y; k = k * cs.x + sg * kp * cs.y; } }
            qv[i] = q; kv[i] = k; }
        { v4u w; unsigned short vv[8];
#pragma unroll
            for (int i = 0; i < 8; ++i) vv[i] = P[(size_t)(r0 + 8 * wave + i) * PP + ov + h * 64 + lane];
            w.x = vv[0] | ((unsigned)vv[1] << 16); w.y = vv[2] | ((unsigned)vv[3] << 16); w.z = vv[4] | ((unsigned)vv[5] << 16); w.w = vv[6] | ((unsigned)vv[7] << 16);
            *(LAS v4u*)(lds + SL_VT + lane * 144 + wave * 16) = w; }
        const int chain_f = ((mixer * 2 + 0) * NB + b) * 4 + h, chain_b = ((mixer * 2 + 1) * NB + b) * 4 + h;
        if (MODE == 3) {
#pragma unroll
            for (int dd = 0; dd < 2; ++dd) { const float* S = KV + ((size_t)(dd ? chain_b : chain_f) * NSLOT + slot) * 2048;
                const f32x4_t s4 = *(const f32x4_t*)(S + tid * 4); v2u w; w.x = pk2(s4.x, s4.y); w.y = pk2(s4.z, s4.w);
                *(LAS v2u*)(lds + SL_ST + dd * 5120 + (tid >> 3) * 80 + (tid & 7) * 8) = w; }
        }
        __syncthreads();
        {
            const LAS float* tot = (const LAS float*)(lds + SL_TOT); float off = 0.f, total = 0.f;
#pragma unroll
            for (int s2 = 0; s2 < 8; ++s2) { const float tv = tot[s2 * 64 + col]; total += tv; if (dir == 0 ? (s2 < seg) : (s2 > seg)) off += tv; }
            if (MODE == 3) {
#pragma unroll
                for (int i = 0; i < 8; ++i) { const float c = cum[i] + off; const int s = 8 * seg + i;
                    *(LAS unsigned short*)(lds + SL_QD + dir * 5120 + s * 80 + d * 2) = (unsigned short)f2bf(qv[i] * expf(c));
                    *(LAS unsigned short*)(lds + SL_KI + dir * 5120 + s * 80 + d * 2) = (unsigned short)f2bf(kv[i] * expf(-c)); }
            } else {
                v4u w; unsigned short ke[8];
#pragma unroll
                for (int i = 0; i < 8; ++i) ke[i] = (unsigned short)f2bf(kv[i] * expf(total - (cum[i] + off)));
                w.x = ke[0] | ((unsigned)ke[1] << 16); w.y = ke[2] | ((unsigned)ke[3] << 16); w.z = ke[4] | ((unsigned)ke[5] << 16); w.w = ke[6] | ((unsigned)ke[7] << 16);
                *(LAS v4u*)(lds + SL_KI + dir * 4608 + d * 144 + seg * 16) = w;
                if (seg == 0) DEC[((size_t)(dir ? chain_b : chain_f) * NSLOT + slot) * 32 + d] = expf(total);
            }
        }
        __syncthreads();
        const int wdir = wave >> 2, wt = wave & 3;
        if (MODE == 1) {
            f32x4_t acc[2] = {(f32x4_t){0.f, 0.f, 0.f, 0.f}, (f32x4_t){0.f, 0.f, 0.f, 0.f}};
#pragma unroll
            for (int ks = 0; ks < 2; ++ks) { const bf16x8 af = *(LAS bf16x8*)(lds + SL_VT + (16 * wt + li) * 144 + 64 * ks + 16 * g);
#pragma unroll
                for (int dt = 0; dt < 2; ++dt) { const bf16x8 bfr = *(LAS bf16x8*)(lds + SL_KI + wdir * 4608 + (16 * dt + li) * 144 + 64 * ks + 16 * g);
                    acc[dt] = __builtin_amdgcn_mfma_f32_16x16x32_bf16(af, bfr, acc[dt], 0, 0, 0); } }
            float* dst = KV + ((size_t)(wdir ? chain_b : chain_f) * NSLOT + slot) * 2048;
#pragma unroll
            for (int dt = 0; dt < 2; ++dt)
#pragma unroll
                for (int r = 0; r < 4; ++r) dst[(16 * wt + 4 * g + r) * 32 + 16 * dt + li] = acc[dt][r];
        } else {
            const int ct = wt;
            const bf16x8 qf = *(LAS bf16x8*)(lds + SL_QD + wdir * 5120 + (16 * ct + li) * 80 + 16 * g);
#pragma unroll
            for (int st = 0; st < 4; ++st) {
                f32x4_t sc = {0.f, 0.f, 0.f, 0.f};
                const bool live = wdir == 0 ? (st <= ct) : (st >= ct);
                if (live) { const bf16x8 kf = *(LAS bf16x8*)(lds + SL_KI + wdir * 5120 + (16 * st + li) * 80 + 16 * g);
                    sc = __builtin_amdgcn_mfma_f32_16x16x32_bf16(kf, qf, sc, 0, 0, 0);
                    if (st == ct) {
#pragma unroll
                        for (int r = 0; r < 4; ++r) { const int s = 4 * g + r, c = li; if (wdir == 0 ? (s > c) : (s < c)) sc[r] = 0.f; } } }
                v2u w; w.x = pk2(sc[0], sc[1]); w.y = pk2(sc[2], sc[3]);
                *(LAS v2u*)(lds + SL_SC + wdir * 9216 + (16 * ct + li) * 144 + (16 * st + 4 * g) * 2) = w; }
            LDS_WAIT();
            f32x4_t acc[4];
#pragma unroll
            for (int et = 0; et < 4; ++et) acc[et] = (f32x4_t){0.f, 0.f, 0.f, 0.f};
            const bf16x8 s0 = *(LAS bf16x8*)(lds + SL_SC + wdir * 9216 + (16 * ct + li) * 144 + 16 * g), s1 = *(LAS bf16x8*)(lds + SL_SC + wdir * 9216 + (16 * ct + li) * 144 + 64 + 16 * g);
#pragma unroll
            for (int et = 0; et < 4; ++et) {
                const bf16x8 v0 = *(LAS bf16x8*)(lds + SL_VT + (16 * et + li) * 144 + 16 * g), v1 = *(LAS bf16x8*)(lds + SL_VT + (16 * et + li) * 144 + 64 + 16 * g);
                const bf16x8 stf = *(LAS bf16x8*)(lds + SL_ST + wdir * 5120 + (16 * et + li) * 80 + 16 * g);
                acc[et] = __builtin_amdgcn_mfma_f32_16x16x32_bf16(v0, s0, acc[et], 0, 0, 0);
                acc[et] = __builtin_amdgcn_mfma_f32_16x16x32_bf16(v1, s1, acc[et], 0, 0, 0);
                acc[et] = __builtin_amdgcn_mfma_f32_16x16x32_bf16(stf, qf, acc[et], 0, 0, 0); }
            LAS float* ox = (LAS float*)(lds + SL_OX) + ct * 1024;
            if (wdir == 1) {
#pragma unroll
                for (int et = 0; et < 4; ++et)
#pragma unroll
                    for (int r = 0; r < 4; ++r) ox[(et * 4 + r) * 64 + lane] = acc[et][r]; }
            __syncthreads();
            if (wdir == 0) {
                float ss = 0.f;
#pragma unroll
                for (int et = 0; et < 4; ++et)
#pragma unroll
                    for (int r = 0; r < 4; ++r) { acc[et][r] += ox[(et * 4 + r) * 64 + lane]; ss += acc[et][r] * acc[et][r]; }
                ss += __shfl_xor(ss, 16); ss += __shfl_xor(ss, 32);
                const float rs = 1.0f / sqrtf(ss * (1.0f / 64) + EPS);
                const int row = r0 + 16 * ct + li; const float* ng = (mixer ? a.in[22] : a.in[19]) + l * 256 + h * 64;
#pragma unroll
                for (int et = 0; et < 4; ++et) { const int e0 = 16 * et + 4 * g;
                    const v2u gt = *(const v2u*)(P + (size_t)row * PP + og + h * 64 + e0); const f32x4_t gn = *(const f32x4_t*)(ng + e0);
                    const float g0 = bf2f((unsigned short)(gt.x & 0xffff)), g1 = bf2f((unsigned short)(gt.x >> 16)), g2 = bf2f((unsigned short)(gt.y & 0xffff)), g3 = bf2f((unsigned short)(gt.y >> 16));
                    v2u w; w.x = pk2(acc[et][0] * rs * gn.x * siluf_(g0), acc[et][1] * rs * gn.y * siluf_(g1)); w.y = pk2(acc[et][2] * rs * gn.z * siluf_(g2), acc[et][3] * rs * gn.w * siluf_(g3));
                    *(v2u*)(Y + (size_t)row * D + (mixer ? 768 : 256) + h * 64 + e0) = w; }
            }
        }
        __syncthreads();
    }
}
__device__ __forceinline__ void ph_scan_state(unsigned char* ws, int tid, int bid, int G) {
    float* KV = (float*)(ws + WS_KV); const float* DEC = (const float*)(ws + WS_DEC);
    static_assert(NSLOT % 17 == 0, "slot batches of 17");
    for (int gid = bid * NTHREADS + tid; gid < NCHAIN * 2048; gid += G * NTHREADS) {
        const int chain = gid >> 11, idx = gid & 2047, d = idx & 31, dir = (chain / (NB * 4)) & 1;
        float* kv = KV + (size_t)chain * NSLOT * 2048 + idx; const float* dc = DEC + (size_t)chain * NSLOT * 32 + d;
        float S = 0.f;
#pragma unroll 1
        for (int i0 = 0; i0 < NSLOT; i0 += 17) {
            float kvv[17], dv[17];
#pragma unroll
            for (int j = 0; j < 17; ++j) { const int i = i0 + j; const int slot = dir == 0 ? i : (i < 4 ? 3 - i : NSLOT + 3 - i); kvv[j] = kv[(size_t)slot * 2048]; dv[j] = dc[slot * 32]; }
#pragma unroll
            for (int j = 0; j < 17; ++j) { const int i = i0 + j; const int slot = dir == 0 ? i : (i < 4 ? 3 - i : NSLOT + 3 - i); kv[(size_t)slot * 2048] = S; S = dv[j] * S + kvv[j]; }
        }
    }
}
__device__ __forceinline__ void ph_rope_table(unsigned char* ws, int tid, int bid, int G) {
    typedef float f32x2_t __attribute__((ext_vector_type(2)));
    f32x2_t* ROPE = (f32x2_t*)(ws + WS_ROPE);
    for (int i = bid * NTHREADS + tid; i < SEQ * 16; i += G * NTHREADS) { const int t = i >> 4, k = i & 15;
        const float inv = exp2f(-(float)(k & 7) * (13.287712379549449f / 8.0f)); const float ang = (float)(k < 8 ? t / GRIDW : t % GRIDW) * inv;
        float s, c; sincosf(ang, &s, &c); ROPE[i] = (f32x2_t){c, s}; }
}
__global__ void __launch_bounds__(NTHREADS, 2) mk(Args a) {
    extern __shared__ __attribute__((aligned(16))) unsigned char lds_raw[];
    LAS unsigned char* lds = (LAS unsigned char*)lds_raw;
    cg::grid_group grid = cg::this_grid();
    volatile LAS unsigned* MISC = (volatile LAS unsigned*)(lds + RING_BYTES + 64);
    if (threadIdx.x < 16) MISC[threadIdx.x] = 0u;
    __syncthreads();
    XcdBarrier xbar = xcd_barrier_post((unsigned*)(a.ws + WS_CTL), MISC + 8);
    int tid = threadIdx.x, lane = tid & 63, wave = __builtin_amdgcn_readfirstlane(tid >> 6);
    const int bid = blockIdx.x, G = gridDim.x, NGW = G * NWAVES; int gw = bid * NWAVES + wave;
#define FRESH() do { tid = threadIdx.x; asm volatile("" : "+v"(tid)); lane = tid & 63; wave = __builtin_amdgcn_readfirstlane(tid >> 6); gw = bid * NWAVES + wave; } while (0)
    unsigned char* ws = a.ws;
    float* XC = (float*)(ws + WS_XC);
    bf16* ACT = (bf16*)(ws + WS_ACT); bf16* P = (bf16*)(ws + WS_P); bf16* H = (bf16*)(ws + WS_H);
#define GSYNC() do { xcd_barrier(xbar); FRESH(); } while (0)
    REPEAT(REP_PRO) { ph_rope_table(ws, tid, bid, G); ph_prologue(a, lds, tid, lane, wave, bid, G); __syncthreads(); FRESH(); }
    grid.sync(); FRESH();
    for (int l = 0; l < DEPTH; ++l) {
        const bool need_ctx = l < DEPTH - 1; const int nro = need_ctx ? M : ML;
        const float* mod = (const float*)(ws + WS_MOD) + (size_t)l * NS * NMOD;
        const float* xl = l == 0 ? a.in[0] : a.out; const float* xc = l == 0 ? a.in[2] : (const float*)(ws + WS_XC);
        REPEAT(REP_NORM) { ph_normmod(xl, xc, a.in[6] + l * D, mod, 0, 1, ACT, M, lane, gw, NGW); FRESH(); }
        GSYNC();
        REPEAT(REP_INPROJ) { pg8::Gemm g{ACT, (const bf16*)(ws + WS_WIN + l * WIN_BYTES), M, PP, D}; pg8::StaticOrder S; S.init(M, PP, G, bid);
          pg8::EpiStore<0> E{P, PP}; pg8::gemm_phase<pg8::EpiStore<0>, pg8::StaticOrder, true, true>(lds, g, S, E, tid); FRESH(); }
        GSYNC();
        REPEAT(REP_CONV) { ph_conv(P, a.in[9] + l * 31 * 256, a.in[10] + l * 256, a.in[11] + l * 256, a.in[12] + l * 256, (const bf16*)(ws + WS_WPW + l * WPW_BYTES), a.in[14] + l * 256, ACT, nro, lds, tid, lane, wave, bid, G);
        __syncthreads(); FRESH(); }
        REPEAT(REP_ATTPREP) { ph_attprep(P, a.in[20] + l * 64, a.in[21] + l * 64, (bf16*)(ws + WS_QA), (bf16*)(ws + WS_KA), (bf16*)(ws + WS_VA), lane, gw, NGW);
        FRESH(); }
        REPEAT(REP_SCAN1) { scan_units<1>(a, l, need_ctx, lds, tid, lane, wave, bid, G);
        FRESH(); }
        GSYNC();
        ph_scan_state(ws, tid, bid, G);
        FRESH();
        REPEAT(REP_ATT) { ph_attention((const bf16*)(ws + WS_QA), (const bf16*)(ws + WS_KA), (const bf16*)(ws + WS_VA), ACT, need_ctx, (char*)lds_raw, bid, G, tid); FRESH(); }
        GSYNC();
        REPEAT(REP_B3) { scan_units<3>(a, l, need_ctx, lds, tid, lane, wave, bid, G); FRESH(); }
        GSYNC();
        REPEAT(REP_WOUT) { pg8::Gemm g{ACT, (const bf16*)(ws + WS_WOUT + l * WOUT_BYTES), nro, D, D}; pg8::StaticOrder S; S.init(nro, D, G, bid);
          pg8::EpiResid E{xl, xc, a.out, XC, mod + 2 * D, rep_}; pg8::gemm_phase<pg8::EpiResid, pg8::StaticOrder, true, true>(lds, g, S, E, tid); FRESH(); }
        GSYNC();
        REPEAT(REP_NORM) { ph_normmod(a.out, XC, a.in[7] + l * D, mod, 3, 4, ACT, nro, lane, gw, NGW); FRESH(); }
        GSYNC();
        REPEAT(REP_UP) { pg8::Gemm g{ACT, (const bf16*)(ws + WS_WUP + l * WUP_BYTES), nro, DFF, D}; pg8::StaticOrder S; S.init(nro, DFF, G, bid);
          pg8::EpiStore<2> E{H, DFF}; pg8::gemm_phase<pg8::EpiStore<2>, pg8::StaticOrder, true, true>(lds, g, S, E, tid); FRESH(); }
        GSYNC();
        REPEAT(REP_DOWN) { pg8::Gemm g{H, (const bf16*)(ws + WS_WDN + l * WDN_BYTES), nro, D, DFF}; pg8::StaticOrder S; S.init(nro, D, G, bid);
          pg8::EpiResid E{a.out, XC, a.out, XC, mod + 5 * D, rep_}; pg8::gemm_phase<pg8::EpiResid, pg8::StaticOrder, true, true>(lds, g, S, E, tid); FRESH(); }
        GSYNC();
    }
    ph_final(a.out, a.in[26], lane, gw, NGW);
}
extern "C" void kernel_launch(void* const* d_in, const int* in_sizes, int n_in, void* d_out, int out_size, void* d_ws, size_t ws_size, hipStream_t stream) {
    static int grid = 0;
    if (grid == 0) {
        if (n_in != 27 || in_sizes[0] != ML * D || out_size != ML * D || ws_size < WS_END) { fprintf(stderr, "kernel_launch: unexpected shapes / workspace (n_in %d, ws %zu)\n", n_in, ws_size); grid = -1; return; }
        int dev = 0, cus = 0, per_cu = 0;
        if (hipGetDevice(&dev) != hipSuccess || hipDeviceGetAttribute(&cus, hipDeviceAttributeMultiprocessorCount, dev) != hipSuccess) { grid = -1; return; }
        if (hipFuncSetAttribute((const void*)mk, hipFuncAttributeMaxDynamicSharedMemorySize, LDS_BYTES) != hipSuccess) { fprintf(stderr, "kernel_launch: hipFuncSetAttribute failed\n"); grid = -1; return; }
        if (hipOccupancyMaxActiveBlocksPerMultiprocessor(&per_cu, (const void*)mk, NTHREADS, LDS_BYTES) != hipSuccess || per_cu < 1) { fprintf(stderr, "kernel_launch: occupancy query says %d blocks per CU\n", per_cu); (void)hipGetLastError(); per_cu = 1; }
        grid = cus * (per_cu > 1 ? 1 : per_cu);
    }
    if (grid < 0) return;
    Args a{};
    for (int i = 0; i < 27; ++i) a.in[i] = (const float*)d_in[i];
    a.out = (float*)d_out; a.ws = (unsigned char*)d_ws;
    if (hipMemsetAsync((char*)d_ws + WS_CTL, 0, 16384, stream) != hipSuccess) { fprintf(stderr, "kernel_launch: memset failed\n"); return; }
    void* args[] = {&a};
    hipError_t e = hipLaunchCooperativeKernel((const void*)mk, dim3(grid), dim3(NTHREADS), args, LDS_BYTES, stream);
    if (e != hipSuccess) fprintf(stderr, "kernel_launch: cooperative launch failed: %s (grid %d)\n", hipGetErrorString(e), grid);
}
```
